# Optimizing an MI355X kernel written in HIP

```python
import math
import jax, jax.numpy as jnp
from jax import lax
import numpy as np

D_MODEL = 1024
BATCH = 32
SEQ = 2048
DEPTH = 1

CHUNK = 64
D_CONV = 1024
CONV_WIDTH = 3
HEAD_DIM = 64
N_HEADS = 16
D_ATT = N_HEADS * HEAD_DIM
Q_BLOCK = 128
N_GROUPS = 4
EXPERTS_PER_GROUP = 8
N_EXPERTS = N_GROUPS * EXPERTS_PER_GROUP
TOP_K = 2
D_EXPERT = 512
MOE_BLOCK = 256
EPS = 1e-6

SPLITS = (D_CONV, D_CONV, D_CONV, D_ATT, D_ATT, D_ATT, N_HEADS, D_MODEL, D_MODEL)
D_IN_PROJ = sum(SPLITS)

kernel_name = "hybrid_conv_fox_hiermoe_block"


def rmsnorm(x, g):
    xf = x.astype(jnp.float32)
    y = xf * lax.rsqrt(jnp.mean(xf * xf, axis=-1, keepdims=True) + EPS)
    return (y * g.astype(jnp.float32)).astype(x.dtype)


def split_cols(p):
    idx = np.cumsum(np.array(SPLITS))[:-1].tolist()
    return jnp.split(p, idx, axis=-1)


def short_conv(b, c, u, conv_w, conv_b):
    S = u.shape[1]
    z = c * u
    zp = jnp.pad(z, ((0, 0), (CONV_WIDTH - 1, 0), (0, 0)))
    acc = conv_b
    for i in range(CONV_WIDTH):
        acc = acc + conv_w[i] * zp[:, i:i + S]
    return b * acc


def forgetting_attention(q, k, v, f_logit, b_forget):
    B, S, H, dh = q.shape
    log_f = jax.nn.log_sigmoid(f_logit.astype(jnp.float32) + b_forget.astype(jnp.float32))
    cum = jnp.transpose(jnp.cumsum(log_f, axis=1), (0, 2, 1))
    scale = 1.0 / math.sqrt(dh)
    outs = []
    for qb in range(S // Q_BLOCK):
        qs, qe = qb * Q_BLOCK, (qb + 1) * Q_BLOCK
        qblk = q[:, qs:qe]
        kp, vp = k[:, :qe], v[:, :qe]
        s = jnp.einsum('bqhd,bkhd->bhqk', qblk, kp).astype(jnp.float32) * scale
        s = s + (cum[:, :, qs:qe, None] - cum[:, :, None, :qe])
        t_pos = jnp.arange(qs, qe)[:, None]
        s_pos = jnp.arange(qe)[None, :]
        s = jnp.where(s_pos <= t_pos, s, -jnp.inf)
        p = jax.nn.softmax(s, axis=-1).astype(v.dtype)
        outs.append(jnp.einsum('bhqk,bkhd->bqhd', p, vp))
    return jnp.concatenate(outs, axis=1)


def token_mixer(h, w_in, conv_w, conv_b, b_forget, w_conv_out, w_att_out, w_out):
    B, S, _ = h.shape
    proj = h @ w_in
    cb, cc, cu, q, k, v, f_logit, g_conv, g_att = split_cols(proj)
    y_conv = short_conv(cb, cc, cu, conv_w, conv_b) @ w_conv_out
    o = forgetting_attention(q.reshape(B, S, N_HEADS, HEAD_DIM),
                             k.reshape(B, S, N_HEADS, HEAD_DIM),
                             v.reshape(B, S, N_HEADS, HEAD_DIM),
                             f_logit, b_forget)
    y_att = o.reshape(B, S, D_ATT) @ w_att_out
    m = jax.nn.sigmoid(g_conv) * y_conv + jax.nn.sigmoid(g_att) * y_att
    return m @ w_out


def hier_moe(h, w_router_group, w_router_expert, w_e_gate, w_e_up, w_e_down):
    B, S, D = h.shape
    T = B * S
    hf = h.reshape(T, D)
    pg = jax.nn.softmax((hf @ w_router_group).astype(jnp.float32), axis=-1)
    g_val, g_idx = lax.top_k(pg, 1)
    le = jnp.einsum('td,gde->tge', hf, w_router_expert).astype(jnp.float32)
    le_sel = jnp.take_along_axis(le, g_idx[:, :, None], axis=1)[:, 0]
    pe = jax.nn.softmax(le_sel, axis=-1)
    e_val, e_idx = lax.top_k(pe, TOP_K)
    e_val = e_val / jnp.sum(e_val, axis=-1, keepdims=True)
    w_tok = (g_val * e_val).astype(h.dtype)
    expert = (g_idx * EXPERTS_PER_GROUP + e_idx).astype(jnp.int32)

    A = T * TOP_K
    flat_e = expert.reshape(A)
    flat_w = w_tok.reshape(A)
    flat_tok = jnp.arange(A, dtype=jnp.int32) // TOP_K
    order = jnp.argsort(flat_e)
    sorted_e = flat_e[order]
    counts = jnp.bincount(flat_e, length=N_EXPERTS)
    padded = (counts + MOE_BLOCK - 1) // MOE_BLOCK * MOE_BLOCK
    start_sorted = jnp.cumsum(counts) - counts
    end_padded = jnp.cumsum(padded)
    start_padded = end_padded - padded
    rank = jnp.arange(A, dtype=jnp.int32) - start_sorted[sorted_e]
    dest = start_padded[sorted_e] + rank
    n_rows = A + N_EXPERTS * MOE_BLOCK
    n_blocks = n_rows // MOE_BLOCK
    row_tok = jnp.zeros((n_rows,), jnp.int32).at[dest].set(flat_tok[order])
    row_w = jnp.zeros((n_rows,), h.dtype).at[dest].set(flat_w[order])
    block_e = jnp.minimum(
        jnp.searchsorted(end_padded, jnp.arange(n_blocks) * MOE_BLOCK, side='right'),
        N_EXPERTS - 1).astype(jnp.int32)
    x_rows = hf[row_tok].reshape(n_blocks, MOE_BLOCK, D)

    def expert_block(args):
        xb, e = args
        a = xb @ w_e_gate[e]
        u = xb @ w_e_up[e]
        return (jax.nn.silu(a) * u) @ w_e_down[e]

    y_rows = lax.map(expert_block, (x_rows, block_e)).reshape(n_rows, D)
    y = jax.ops.segment_sum(y_rows * row_w[:, None], row_tok, num_segments=T)
    return y.reshape(B, S, D)


def setup_inputs(seed: int = 0) -> dict:
    key = jax.random.key(seed)
    ks = jax.random.split(key, 20)
    f32 = jnp.float32
    nrm = lambda k, shape, fan: jax.random.normal(k, shape, f32) * (fan ** -0.5)
    return {
        "x": jax.random.normal(ks[0], (BATCH, SEQ, D_MODEL), f32),
        "norm_mix_g": 1.0 + 0.02 * jax.random.normal(ks[1], (D_MODEL,), f32),
        "w_in": nrm(ks[2], (D_MODEL, D_IN_PROJ), D_MODEL),
        "conv_w": nrm(ks[3], (CONV_WIDTH, D_CONV), CONV_WIDTH),
        "conv_b": 0.01 * jax.random.normal(ks[4], (D_CONV,), f32),
        "b_forget": jax.random.uniform(ks[5], (N_HEADS,), f32, 1.0, 6.0),
        "w_conv_out": nrm(ks[6], (D_CONV, D_MODEL), D_CONV),
        "w_att_out": nrm(ks[7], (D_ATT, D_MODEL), D_ATT),
        "w_out": nrm(ks[8], (D_MODEL, D_MODEL), D_MODEL),
        "norm_ffn_g": 1.0 + 0.02 * jax.random.normal(ks[9], (D_MODEL,), f32),
        "w_router_group": nrm(ks[10], (D_MODEL, N_GROUPS), D_MODEL),
        "w_router_expert": nrm(ks[11], (N_GROUPS, D_MODEL, EXPERTS_PER_GROUP), D_MODEL),
        "w_e_gate": nrm(ks[12], (N_EXPERTS, D_MODEL, D_EXPERT), D_MODEL),
        "w_e_up": nrm(ks[13], (N_EXPERTS, D_MODEL, D_EXPERT), D_MODEL),
        "w_e_down": nrm(ks[14], (N_EXPERTS, D_EXPERT, D_MODEL), D_EXPERT),
        "norm_final_g": 1.0 + 0.02 * jax.random.normal(ks[15], (D_MODEL,), f32),
    }


def reference(x, norm_mix_g, w_in, conv_w, conv_b, b_forget, w_conv_out, w_att_out, w_out,
              norm_ffn_g, w_router_group, w_router_expert, w_e_gate, w_e_up, w_e_down,
              norm_final_g):
    for _ in range(DEPTH):
        x = x + token_mixer(rmsnorm(x, norm_mix_g), w_in, conv_w, conv_b, b_forget,
                            w_conv_out, w_att_out, w_out)
        x = x + hier_moe(rmsnorm(x, norm_ffn_g), w_router_group, w_router_expert,
                         w_e_gate, w_e_up, w_e_down)
    return rmsnorm(x, norm_final_g)
```

```cpp
#include <hip/hip_runtime.h>
#include <hip/hip_bf16.h>
#include <cstdio>
#include <cstdint>
#include <cmath>
namespace pg8 {
#define PG8_LAS __attribute__((address_space(3)))
typedef unsigned short bf16_t;
typedef short bf16x8 __attribute__((ext_vector_type(8)));
typedef float f32x4 __attribute__((ext_vector_type(4)));
typedef unsigned u32x4 __attribute__((ext_vector_type(4)));
typedef int i32x4 __attribute__((ext_vector_type(4)));
constexpr int BM = 256, BK = 64, HALF = 128, HTB = HALF * BK * 2  , STAGE_BYTES = 8 * HTB, NXCD = 8, WGM = 8;

__host__ __device__ __forceinline__ int lds_byte(int r, int c) { const int st = (r >> 4) * 2 + (c >> 5), rr = r & 15, cc = c & 31, ob = rr * 64 + cc * 2; return st * 1024 + (ob ^ (((ob >> 9) & 1) << 5)); }
__host__ __device__ __forceinline__ void stage_rc(int b, int& R, int& C) { const int st = b / 1024, sb = b % 1024, swz = sb ^ (((sb >> 9) & 1) << 5); R = (st >> 1) * 16 + swz / 64; C = (st & 1) * 32 + (swz % 64) / 2; }
__host__ __device__ __forceinline__ int perm32(int rho) { const int n = rho >> 4, i = rho & 15; return 8 * (i >> 2) + 4 * n + (i & 3); }

struct Unit { int pm, pn, e, rt, slot, nvalid; };

struct StaticOrder {
    const bf16_t* A; const bf16_t* Bt; int K;
    int nM, nN, nwg, G, c;
    __device__ __forceinline__ void init(const bf16_t* A_, const bf16_t* Bt_, int M, int N, int K_, int G_, int c_) { A = A_; Bt = Bt_; K = K_; nM = M / BM; nN = N / BM; nwg = nM * nN; G = G_; c = c_; }
    __device__ __forceinline__ bool next(int i, Unit& u) const {
        const long L = (long)i * G + c; if (L >= nwg) return false;
        int wgid = (int)L; { const int q = nwg / NXCD, r = nwg % NXCD, xcd = wgid % NXCD, off = wgid / NXCD; wgid = (xcd < r ? xcd * (q + 1) : r * (q + 1) + (xcd - r) * q) + off; }
        const int nig = WGM * nN, gid = wgid / nig, fm = gid * WGM, gsz = (nM - fm) < WGM ? (nM - fm) : WGM;
        u.pm = fm + ((wgid % nig) % gsz); u.pn = (wgid % nig) / gsz; u.e = 0; u.rt = 0; u.slot = i; u.nvalid = BM; return true;
    }
    __device__ __forceinline__ const char* a_tile(const Unit& u) const { return (const char*)A + (size_t)u.pm * ((size_t)BM * K * 2); }
    __device__ __forceinline__ const char* b_tile(const Unit& u) const { return (const char*)Bt + (size_t)u.pn * ((size_t)BM * K * 2); }
    __device__ __forceinline__ void a_rows(int, const int (&)[2], const int (&)[2], unsigned (&)[2][2]) const {}
};

constexpr int MOE_SLOTS = 10;
struct MoeOrder {
    const bf16_t* A; const bf16_t* Bt; int K; size_t bexp;
    const PG8_LAS i32x4* desc; const PG8_LAS int* rstart; const PG8_LAS unsigned* idx; bool gather;
    __device__ __forceinline__ bool next(int i, Unit& u) const {
        if (i >= MOE_SLOTS) return false;
        const i32x4 d = desc[i]; const int nv = __builtin_amdgcn_readfirstlane(d.w); if (nv <= 0) return false;
        u.e = __builtin_amdgcn_readfirstlane(d.x); u.rt = __builtin_amdgcn_readfirstlane(d.y); u.pn = __builtin_amdgcn_readfirstlane(d.z); u.nvalid = nv; u.slot = i; u.pm = 0; return true;
    }
    __device__ __forceinline__ const char* a_tile(const Unit& u) const {
        if (gather) return (const char*)A;
        const int r0 = __builtin_amdgcn_readfirstlane(rstart[u.e]) + BM * u.rt; return (const char*)A + (size_t)r0 * ((size_t)K * 2); }
    __device__ __forceinline__ const char* b_tile(const Unit& u) const { return (const char*)Bt + (size_t)u.e * bexp + (size_t)u.pn * ((size_t)BM * K * 2); }
    __device__ __forceinline__ void a_rows(int slot, const int (&Rp)[2], const int (&Cp)[2], unsigned (&voff)[2][2]) const {
#pragma unroll
        for (int h = 0; h < 2; ++h)
#pragma unroll
            for (int p = 0; p < 2; ++p) { const unsigned ent = idx[slot * BM + h * HALF + Rp[p]]; voff[h][p] = (ent >> 1) * (unsigned)(K * 2) + (unsigned)(Cp[p] * 2); }
    }
};

__device__ __forceinline__ unsigned cvt_pk_bf16(float lo, float hi) { unsigned r; asm volatile("v_cvt_pk_bf16_f32 %0, %1, %2" : "=v"(r) : "v"(lo), "v"(hi)); return r; }
__device__ __forceinline__ float bf_lo(unsigned w) { return __uint_as_float(w << 16); }
__device__ __forceinline__ float bf_hi(unsigned w) { return __uint_as_float(w & 0xffff0000u); }
__device__ __forceinline__ float sigmoid_f(float x) { return __builtin_amdgcn_rcpf(1.0f + __builtin_amdgcn_exp2f(-1.4426950408889634f * x)); }
__device__ __forceinline__ u32x4 pack8(const f32x4 v0, const f32x4 v1) { u32x4 w; w.x = cvt_pk_bf16(v0[0], v0[1]); w.y = cvt_pk_bf16(v0[2], v0[3]); w.z = cvt_pk_bf16(v1[0], v1[1]); w.w = cvt_pk_bf16(v1[2], v1[3]); return w; }

struct EpiProj {
    static constexpr bool PERM = true, AFTER_DRAIN = false;
    bf16_t *Z, *Bb, *Q, *Kk, *V, *SGC, *SGA; float qscale;
    __device__ __forceinline__ void operator()(const f32x4 (&acc)[2][2][4][2], const Unit& u, int wr, int wc, int fr, int fq) const {
        const int row0 = u.pm * BM + wr * 64 + fr;
        if (u.pn < 8) {
            const int col0 = u.pn * HALF + wc * 32 + 8 * fq;
#pragma unroll
            for (int ai = 0; ai < 2; ++ai)
#pragma unroll
                for (int m = 0; m < 4; ++m) { bf16_t* rowp = Z + (size_t)(row0 + ai * HALF + m * 16) * 1024 + col0;
                    *(u32x4*)rowp = pack8(acc[ai][0][m][0] * acc[ai][1][m][0], acc[ai][0][m][1] * acc[ai][1][m][1]); }
        } else {
            const int t = (u.pn - 8) >> 2; bf16_t* base = t == 0 ? Bb : t == 1 ? Q : t == 2 ? Kk : t == 3 ? V : t == 4 ? SGC : SGA;
            const int col0 = ((u.pn - 8) & 3) * BM + wc * 32 + 8 * fq; const float sc = (t == 1) ? qscale : 1.0f;
#pragma unroll
            for (int ai = 0; ai < 2; ++ai)
#pragma unroll
                for (int m = 0; m < 4; ++m) { bf16_t* rowp = base + (size_t)(row0 + ai * HALF + m * 16) * 1024 + col0;
#pragma unroll
                    for (int bj = 0; bj < 2; ++bj) { f32x4 v0 = acc[ai][bj][m][0], v1 = acc[ai][bj][m][1];
                        if (t >= 4) {
#pragma unroll
                            for (int j = 0; j < 4; ++j) { v0[j] = sigmoid_f(v0[j]); v1[j] = sigmoid_f(v1[j]); } }
                        else { v0 = v0 * sc; v1 = v1 * sc; }
                        *(u32x4*)(rowp + bj * HALF) = pack8(v0, v1); } }
        }
    }
};
template <bool ADD> struct EpiGate {
    static constexpr bool PERM = true, AFTER_DRAIN = false;
    const bf16_t* G; bf16_t* Mo;
    __device__ __forceinline__ void operator()(const f32x4 (&acc)[2][2][4][2], const Unit& u, int wr, int wc, int fr, int fq) const {
        const int row0 = u.pm * BM + wr * 64 + fr, col0 = u.pn * BM + wc * 32 + 8 * fq;
#pragma unroll
        for (int ai = 0; ai < 2; ++ai)
#pragma unroll
            for (int m = 0; m < 4; ++m) { const size_t off = (size_t)(row0 + ai * HALF + m * 16) * 1024 + col0;
#pragma unroll
                for (int bj = 0; bj < 2; ++bj) { const u32x4 g = *(const u32x4*)(G + off + bj * HALF); f32x4 v0 = acc[ai][bj][m][0], v1 = acc[ai][bj][m][1];
                    v0[0] *= bf_lo(g.x); v0[1] *= bf_hi(g.x); v0[2] *= bf_lo(g.y); v0[3] *= bf_hi(g.y); v1[0] *= bf_lo(g.z); v1[1] *= bf_hi(g.z); v1[2] *= bf_lo(g.w); v1[3] *= bf_hi(g.w);
                    if (ADD) { const u32x4 o = *(const u32x4*)(Mo + off + bj * HALF);
                        v0[0] += bf_lo(o.x); v0[1] += bf_hi(o.x); v0[2] += bf_lo(o.y); v0[3] += bf_hi(o.y); v1[0] += bf_lo(o.z); v1[1] += bf_hi(o.z); v1[2] += bf_lo(o.w); v1[3] += bf_hi(o.w); }
                    *(u32x4*)(Mo + off + bj * HALF) = pack8(v0, v1); } }
    }
};
struct EpiRes {
    static constexpr bool PERM = false, AFTER_DRAIN = false;
    const float* R; float* C;
    __device__ __forceinline__ void operator()(const f32x4 (&acc)[2][2][4][2], const Unit& u, int wr, int wc, int fr, int fq) const {
        const int row0 = u.pm * BM + wr * 64 + fr, col0 = u.pn * BM + wc * 32 + 4 * fq;
#pragma unroll
        for (int ai = 0; ai < 2; ++ai)
#pragma unroll
            for (int m = 0; m < 4; ++m) { const size_t off = (size_t)(row0 + ai * HALF + m * 16) * 1024 + col0;
#pragma unroll
                for (int bj = 0; bj < 2; ++bj)
#pragma unroll
                    for (int n = 0; n < 2; ++n) *(f32x4*)(C + off + bj * HALF + n * 16) = *(const f32x4*)(R + off + bj * HALF + n * 16) + acc[ai][bj][m][n]; }
    }
};
struct EpiSilu {
    static constexpr bool PERM = true, AFTER_DRAIN = false;
    bf16_t* ACT; const PG8_LAS int* rstart;
    __device__ __forceinline__ void operator()(const f32x4 (&acc)[2][2][4][2], const Unit& u, int wr, int wc, int fr, int fq) const {
        const int rbase = __builtin_amdgcn_readfirstlane(rstart[u.e]) + BM * u.rt, col0 = u.pn * HALF + wc * 32 + 8 * fq;
#pragma unroll
        for (int ai = 0; ai < 2; ++ai)
#pragma unroll
            for (int m = 0; m < 4; ++m) { const int r = ai * HALF + wr * 64 + m * 16 + fr;
                if (r < u.nvalid) { f32x4 v0, v1;
#pragma unroll
                    for (int j = 0; j < 4; ++j) { const float a0 = acc[ai][0][m][0][j], a1 = acc[ai][0][m][1][j]; v0[j] = a0 * sigmoid_f(a0) * acc[ai][1][m][0][j]; v1[j] = a1 * sigmoid_f(a1) * acc[ai][1][m][1][j]; }
                    *(u32x4*)(ACT + (size_t)(rbase + r) * 512 + col0) = pack8(v0, v1); } }
    }
};
struct EpiDown {
    static constexpr bool PERM = true, AFTER_DRAIN = false;
    bf16_t* Y; const PG8_LAS unsigned* idx; const PG8_LAS float* wt;
    __device__ __forceinline__ void operator()(const f32x4 (&acc)[2][2][4][2], const Unit& u, int wr, int wc, int fr, int fq) const {
        const int col0 = u.pn * BM + wc * 32 + 8 * fq;
#pragma unroll
        for (int ai = 0; ai < 2; ++ai)
#pragma unroll
            for (int m = 0; m < 4; ++m) { const int r = ai * HALF + wr * 64 + m * 16 + fr;
                if (r < u.nvalid) { const unsigned ent = idx[u.slot * BM + r]; const float w = wt[u.slot * BM + r]; bf16_t* rowp = Y + (size_t)ent * 1024 + col0;
#pragma unroll
                    for (int bj = 0; bj < 2; ++bj) *(u32x4*)(rowp + bj * HALF) = pack8(acc[ai][bj][m][0] * w, acc[ai][bj][m][1] * w); } }
    }
};

template <class Epi, class Sched, bool ALIGN_EPI, bool GATHER>
__device__ __forceinline__ void gemm_phase(PG8_LAS unsigned char* lds, const int K, const Sched& S, const Epi& E) {
    int tid_ = threadIdx.x; asm volatile("" : "+v"(tid_));
    const int tid = tid_, wid = __builtin_amdgcn_readfirstlane(tid >> 6), lane = tid & 63, wr = wid >> 2, wc = wid & 3, fr = lane & 15, fq = lane >> 4;
    const int nt = K / BK;
    unsigned voffB[2], voffC[2][2], voffN[2][2]; int Rp[2], Cp[2];
#pragma unroll
    for (int i = 0; i < 2; ++i) { int R, C; stage_rc(tid * 16 + i * 8192, R, C); const int Rb = Epi::PERM ? ((R & ~31) + perm32(R & 31)) : R; Rp[i] = R; Cp[i] = C;
        voffB[i] = (unsigned)(Rb * K + C) * 2u; voffC[0][i] = (unsigned)(R * K + C) * 2u; voffC[1][i] = (unsigned)((R + HALF) * K + C) * 2u; voffN[0][i] = voffC[0][i]; voffN[1][i] = voffC[1][i]; }
    const size_t kstep = (size_t)(BK * 2);
    const size_t hstep = (size_t)HALF * K * 2;
    const unsigned ldsw = (unsigned)wid * 1024u;
    const int aoff = lds_byte(wr * 64 + fr, fq * 8), boff = lds_byte(wc * 32 + fr, fq * 8);
#define PG8_SA(b, h) (((b) * 2 + (h)) * HTB)
#define PG8_SB(b, h) ((4 + (b) * 2 + (h)) * HTB)
#define PG8_STAGE(bufoff, gbase, voff) do { _Pragma("unroll") for (int _i = 0; _i < 2; ++_i) \
        __builtin_amdgcn_global_load_lds((const unsigned*)((const char*)(gbase) + (voff)[_i]), (PG8_LAS unsigned*)(lds + (bufoff) + ldsw + _i * 8192), 16, 0, 0); } while (0)
#define PG8_LDA(dst, b, h) do { _Pragma("unroll") for (int m = 0; m < 4; ++m) _Pragma("unroll") for (int k = 0; k < 2; ++k) dst[m][k] = *(const PG8_LAS bf16x8*)(lds + PG8_SA(b, h) + aoff + m * 2048 + k * 1024); } while (0)
#define PG8_LDB(dst, b, h) do { _Pragma("unroll") for (int n = 0; n < 2; ++n) _Pragma("unroll") for (int k = 0; k < 2; ++k) dst[n][k] = *(const PG8_LAS bf16x8*)(lds + PG8_SB(b, h) + boff + n * 2048 + k * 1024); } while (0)
#define PG8_MMA(ai, bj, At, Bt) do { __builtin_amdgcn_s_setprio(1); _Pragma("unroll") for (int m = 0; m < 4; ++m) _Pragma("unroll") for (int n = 0; n < 2; ++n) _Pragma("unroll") for (int k = 0; k < 2; ++k) \
        acc[ai][bj][m][n] = __builtin_amdgcn_mfma_f32_16x16x32_bf16(Bt[n][k], At[m][k], acc[ai][bj][m][n], 0, 0, 0); __builtin_amdgcn_s_setprio(0); } while (0)
#define PG8_WAIT_V(n) asm volatile("s_waitcnt vmcnt(" #n ")" ::: "memory")
#define PG8_WAIT_L(n) asm volatile("s_waitcnt lgkmcnt(" #n ")" ::: "memory")
#define PG8_BAR __builtin_amdgcn_s_barrier()
#define PG8_SCHED __builtin_amdgcn_sched_barrier(0)
    Unit cur, nxt; int ui = 0;
    if (!S.next(0, cur)) return;
    if constexpr (GATHER) S.a_rows(0, Rp, Cp, voffC);
    f32x4 acc[2][2][4][2];
#pragma unroll
    for (int a = 0; a < 2; ++a)
#pragma unroll
        for (int b = 0; b < 2; ++b)
#pragma unroll
            for (int m = 0; m < 4; ++m)
#pragma unroll
                for (int n = 0; n < 2; ++n) acc[a][b][m][n] = (f32x4){0.f, 0.f, 0.f, 0.f};
    bf16x8 At[4][2], B0[2][2], B1[2][2];
    const char* cA = S.a_tile(cur); const char* cB = S.b_tile(cur);
    PG8_STAGE(PG8_SB(0, 0), cB, voffB); PG8_STAGE(PG8_SB(0, 1), cB + hstep, voffB); PG8_STAGE(PG8_SA(0, 0), cA, voffC[0]); PG8_STAGE(PG8_SA(0, 1), cA, voffC[1]);
    if (wr == 1) PG8_BAR;
    PG8_WAIT_V(2); PG8_BAR;
    PG8_STAGE(PG8_SB(1, 0), cB + kstep, voffB); PG8_STAGE(PG8_SA(1, 0), cA + kstep, voffC[0]); PG8_STAGE(PG8_SB(1, 1), cB + hstep + kstep, voffB);
    PG8_WAIT_V(6); PG8_BAR;
    for (;;) {
        const bool has_next = S.next(ui + 1, nxt);
        const char* nA = has_next ? S.a_tile(nxt) : cA; const char* nB = has_next ? S.b_tile(nxt) : cB;
        if constexpr (GATHER) { if (has_next) S.a_rows(ui + 1, Rp, Cp, voffN); else {
#pragma unroll
                for (int h = 0; h < 2; ++h)
#pragma unroll
                    for (int p = 0; p < 2; ++p) voffN[h][p] = voffC[h][p]; } }
        for (int t = 0; t < nt; t += 2) {
            const bool last = (t == nt - 2);
            const char* a1 = cA + (size_t)(t + 1) * kstep;
            const char* a2 = last ? nA : cA + (size_t)(t + 2) * kstep; const char* b2 = last ? nB : cB + (size_t)(t + 2) * kstep;
            const char* a3 = a2 + kstep; const char* b3 = b2 + kstep;
            unsigned vo2[2][2];
#pragma unroll
            for (int h = 0; h < 2; ++h)
#pragma unroll
                for (int p = 0; p < 2; ++p) vo2[h][p] = (GATHER && last) ? voffN[h][p] : voffC[h][p];
            PG8_LDB(B0, 0, 0); PG8_LDB(B1, 0, 1); PG8_SCHED; PG8_LDA(At, 0, 0); PG8_STAGE(PG8_SA(1, 1), a1, voffC[1]);
            PG8_WAIT_V(8); PG8_WAIT_L(0); PG8_BAR; PG8_MMA(0, 0, At, B0); PG8_MMA(0, 1, At, B1); PG8_BAR; PG8_SCHED;
            PG8_LDA(At, 0, 1); PG8_STAGE(PG8_SB(0, 0), b2, voffB); PG8_STAGE(PG8_SB(0, 1), b2 + hstep, voffB); PG8_STAGE(PG8_SA(0, 0), a2, vo2[0]);
            PG8_WAIT_V(8); PG8_WAIT_L(0); PG8_BAR; PG8_MMA(1, 0, At, B0); PG8_MMA(1, 1, At, B1); PG8_BAR; PG8_SCHED;
            PG8_LDB(B0, 1, 0); PG8_LDB(B1, 1, 1); PG8_SCHED; PG8_LDA(At, 1, 0); PG8_STAGE(PG8_SA(0, 1), a2, vo2[1]);
            PG8_WAIT_V(8); PG8_WAIT_L(0); PG8_BAR; PG8_MMA(0, 0, At, B0); PG8_MMA(0, 1, At, B1); PG8_BAR; PG8_SCHED;
            PG8_LDA(At, 1, 1); PG8_STAGE(PG8_SB(1, 0), b3, voffB); PG8_STAGE(PG8_SB(1, 1), b3 + hstep, voffB); PG8_STAGE(PG8_SA(1, 0), a3, vo2[0]);
            PG8_WAIT_V(8); PG8_WAIT_L(0); PG8_BAR; PG8_MMA(1, 0, At, B0); PG8_MMA(1, 1, At, B1); PG8_BAR; PG8_SCHED;
        }
        if constexpr (ALIGN_EPI) { if (wr == 0) PG8_BAR; }
        E(acc, cur, wr, wc, fr, fq);
        if (!has_next) break;
#pragma unroll
        for (int a = 0; a < 2; ++a)
#pragma unroll
            for (int b = 0; b < 2; ++b)
#pragma unroll
                for (int m = 0; m < 4; ++m)
#pragma unroll
                    for (int n = 0; n < 2; ++n) acc[a][b][m][n] = (f32x4){0.f, 0.f, 0.f, 0.f};
        cur = nxt; cA = nA; cB = nB; ++ui;
        if constexpr (GATHER) {
#pragma unroll
            for (int h = 0; h < 2; ++h)
#pragma unroll
                for (int p = 0; p < 2; ++p) voffC[h][p] = voffN[h][p]; }
        if constexpr (ALIGN_EPI) { if (wr == 1) PG8_BAR; }
    }
    PG8_WAIT_V(0);
    if constexpr (!ALIGN_EPI) { if (wr == 0) PG8_BAR; }
    PG8_BAR;
#undef PG8_SA
#undef PG8_SB
#undef PG8_STAGE
#undef PG8_LDA
#undef PG8_LDB
#undef PG8_MMA
#undef PG8_WAIT_V
#undef PG8_WAIT_L
#undef PG8_BAR
#undef PG8_SCHED
}
}

#include <hip/hip_bf16.h>
#include <cmath>
namespace attn_body {
using bf16=__hip_bfloat16;
using bf16x8=__attribute__((ext_vector_type(8)))short;
using s16x4=__attribute__((ext_vector_type(4)))short;
using f32x16=__attribute__((ext_vector_type(16)))float;
using u32x4=__attribute__((ext_vector_type(4)))unsigned;
constexpr int BATCH=32,NHEAD=16,SEQ=2048,D=64,DM=NHEAD*D;
constexpr int NW=8,QBLK=32,QB=QBLK*NW,KVBLK=64,NQB=SEQ/QB;
constexpr int ATTN_PITCH=DM, ATTN_UNIT_ROWS=QB;
__device__ __forceinline__ int crow(int r,int hi){return (r&3)+8*(r>>2)+4*hi;}
#define SBAR() __builtin_amdgcn_sched_barrier(0)
__device__ __forceinline__ void cmask(f32x16&p0,f32x16&p1,int jb,int qrel,int hi){
  const float NEG=-INFINITY; int kb=64*jb+4*hi;
  #pragma unroll
  for(int r=0;r<16;++r){int kv=kb+(r&3)+8*(r>>2); if(kv>qrel)p0[r]=NEG; if(kv+32>qrel)p1[r]=NEG;}
}

constexpr int NSLOT=3, SLOTB=8192;
constexpr int LDS_K=0, LDS_V=NSLOT*SLOTB, LDS_WS=2*NSLOT*SLOTB, LDS_OST=LDS_WS+NW*64*4, LDS_REC=LDS_OST+NW*4096, LDS_BYTES=LDS_REC+SEQ*8;
constexpr float C2=0.125f*1.4426950408889634f;
__device__ __forceinline__ void glds16(const void*gsrc,unsigned lds_dst){unsigned keep;
  asm volatile("s_mov_b32 %0, m0\n\ts_mov_b32 m0, %2\n\ts_nop 0\n\tglobal_load_lds_dwordx4 %1, off\n\ts_mov_b32 m0, %0":"=&s"(keep):"v"(gsrc),"s"(lds_dst):"memory");}
__device__ __forceinline__ float max3f(float a,float b,float c){float r;asm("v_max3_f32 %0, %1, %2, %3":"=v"(r):"v"(a),"v"(b),"v"(c));return r;}
__device__ __forceinline__ float max2f(float a,float b){float r;asm("v_max_f32_e32 %0, %1, %2":"=v"(r):"v"(a),"v"(b));return r;}
__device__ __forceinline__ float fadd_s(float a,float b){float r;asm("v_add_f32_e32 %0, %1, %2":"=v"(r):"v"(a),"v"(b));return r;}
__device__ __forceinline__ float fsub_s(float a,float b){float r;asm("v_sub_f32_e32 %0, %1, %2":"=v"(r):"v"(a),"v"(b));return r;}
typedef float f32x2_t __attribute__((ext_vector_type(2))); typedef __bf16 bf16x2_t __attribute__((ext_vector_type(2)));
__device__ __forceinline__ unsigned cvtpk_s(float lo,float hi){f32x2_t v={lo,hi};bf16x2_t b=__builtin_convertvector(v,bf16x2_t);return __builtin_bit_cast(unsigned,b);}
#define WAIT_BAR(N) asm volatile("s_waitcnt vmcnt(" #N ") lgkmcnt(0)\n\ts_barrier":::"memory")

__device__ __forceinline__ void qkt(f32x16&p0,f32x16&p1,const char*Kslot,const bf16x8*qr,bf16x8 ab0,bf16x8 ab1,bf16x8 bq,int r32,int hi){
  const char*kb=Kslot+hi*1024+r32*16;
  p0=__builtin_amdgcn_mfma_f32_32x32x16_bf16(ab0,bq,f32x16{},0,0,0);p1=__builtin_amdgcn_mfma_f32_32x32x16_bf16(ab1,bq,f32x16{},0,0,0);
  #pragma unroll
  for(int d0=0;d0<4;++d0){
    const bf16x8 b0=*reinterpret_cast<const bf16x8*>(kb+d0*2048);
    const bf16x8 b1=*reinterpret_cast<const bf16x8*>(kb+d0*2048+512);
    p0=__builtin_amdgcn_mfma_f32_32x32x16_bf16(b0,qr[d0],p0,0,0,0);p1=__builtin_amdgcn_mfma_f32_32x32x16_bf16(b1,qr[d0],p1,0,0,0);}
}
__device__ __forceinline__ u32x4 make_bq(float mhat,int hi){
  const float nm=-mhat; const unsigned h1=cvtpk_s(nm,0.f)&0xffffu; const float r1=nm-__uint_as_float(h1<<16);
  const unsigned h2=cvtpk_s(r1,0.f)&0xffffu; const float r2=r1-__uint_as_float(h2<<16); const unsigned h3=cvtpk_s(r2,0.f)&0xffffu;
  u32x4 b; b.x=hi?0u:0x3f803f80u; b.y=hi?0u:(0x3f80u|(h1<<16)); b.z=hi?0u:(h2|(h3<<16)); b.w=0u; return b;
}
typedef unsigned u32x2_t __attribute__((ext_vector_type(2)));
#define ABF(rc) __builtin_bit_cast(bf16x8,(u32x4){(rc).x,(rc).y,0x3f803f80u,0u})
typedef __attribute__((address_space(3))) const char* lds_cptr;
typedef short v4i16_t __attribute__((ext_vector_type(4)));
__device__ __forceinline__ void kload8(bf16x8*kf,lds_cptr kp){
  kf[0]=*(const __attribute__((address_space(3))) bf16x8*)(kp);      kf[1]=*(const __attribute__((address_space(3))) bf16x8*)(kp+512);
  kf[2]=*(const __attribute__((address_space(3))) bf16x8*)(kp+2048); kf[3]=*(const __attribute__((address_space(3))) bf16x8*)(kp+2560);
  kf[4]=*(const __attribute__((address_space(3))) bf16x8*)(kp+4096); kf[5]=*(const __attribute__((address_space(3))) bf16x8*)(kp+4608);
  kf[6]=*(const __attribute__((address_space(3))) bf16x8*)(kp+6144); kf[7]=*(const __attribute__((address_space(3))) bf16x8*)(kp+6656);
}
__device__ __forceinline__ void kload2(bf16x8*kf,lds_cptr kp,int j){ kf[2*j]=*(const __attribute__((address_space(3))) bf16x8*)(kp+j*2048); kf[2*j+1]=*(const __attribute__((address_space(3))) bf16x8*)(kp+j*2048+512); }
__device__ __forceinline__ s16x4 vtr(lds_cptr p){ return __builtin_bit_cast(s16x4,__builtin_amdgcn_ds_read_tr16_b64_v4i16((__attribute__((address_space(3))) v4i16_t*)p)); }
__device__ __forceinline__ float rowmax(const f32x16&p0,const f32x16&p1){
  float a=max3f(p0[0],p0[1],p1[0]),b=max3f(p0[2],p0[3],p1[1]);a=max3f(a,p1[2],p1[3]);
  #pragma unroll
  for(int r=4;r<16;r+=4){a=max3f(a,p0[r],p0[r+1]);b=max3f(b,p0[r+2],p0[r+3]);a=max3f(a,p1[r],p1[r+1]);b=max3f(b,p1[r+2],p1[r+3]);}
  const float m=max2f(a,b);
  auto rr=__builtin_amdgcn_permlane32_swap(__float_as_uint(m),__float_as_uint(m),false,false);
  return max2f(__uint_as_float(rr[0]),__uint_as_float(rr[1]));
}
__device__ __forceinline__ void pv(f32x16*o,int vb,bf16x8 pa0,bf16x8 pa1,bf16x8 pa2,bf16x8 pa3){
  #pragma unroll
  for(int d0=0;d0<2;++d0){s16x4 lo[4],hi[4];
    #pragma unroll
    for(int ks=0;ks<4;++ks){
      asm volatile("ds_read_b64_tr_b16 %0,%1 offset:%c2":"=&v"(lo[ks]):"v"(vb),"i"(d0*4096+ks*1024):"memory");
      asm volatile("ds_read_b64_tr_b16 %0,%1 offset:%c2":"=&v"(hi[ks]):"v"(vb),"i"(d0*4096+ks*1024+512):"memory");}
    asm volatile("s_waitcnt lgkmcnt(0)":::"memory");SBAR();
    #define PK(k) (bf16x8){lo[k][0],lo[k][1],lo[k][2],lo[k][3],hi[k][0],hi[k][1],hi[k][2],hi[k][3]}
    o[d0]=__builtin_amdgcn_mfma_f32_32x32x16_bf16(pa0,PK(0),o[d0],0,0,0);
    o[d0]=__builtin_amdgcn_mfma_f32_32x32x16_bf16(pa1,PK(1),o[d0],0,0,0);
    o[d0]=__builtin_amdgcn_mfma_f32_32x32x16_bf16(pa2,PK(2),o[d0],0,0,0);
    o[d0]=__builtin_amdgcn_mfma_f32_32x32x16_bf16(pa3,PK(3),o[d0],0,0,0);
    #undef PK
  }
}

#ifndef ATTN_STORE16
#define ATTN_STORE16(p,v) (*(u32x4*)(p)=(v))
#endif
template<int THRL> __device__ __forceinline__ void attn_unit(int b,int h,int qb,const bf16*Q,const bf16*__restrict__ K,const bf16*__restrict__ V,bf16*O,const u32x2_t*__restrict__ REC,char*shm){
  int tid_=threadIdx.x; asm volatile("":"+v"(tid_)); const int tid=tid_,lane=tid&63,r32=lane&31,hi=lane>>5; const int wid=__builtin_amdgcn_readfirstlane(tid>>6);
  const long rowbase=(long)b*SEQ; const int q0=qb*QB;
  const bf16*Qw=Q+(rowbase+q0+wid*QBLK)*DM+h*D;
  const bf16*Kh=K+rowbase*DM+h*D,*Vh=V+rowbase*DM+h*D;
  const unsigned lds0=(unsigned)(uintptr_t)shm;
  float*wsf=(float*)(shm+LDS_WS)+wid*64;
  const bf16*ksrc=Kh+(long)lane*DM+wid*8;
  const bf16*vsrc=Vh+(long)(16*(wid&3)+(lane>>2))*DM+(wid>>2)*32+(lane&3)*8;
  const unsigned kdst=lds0+LDS_K+wid*1024, vdst=lds0+LDS_V+wid*1024;
  #define DMA_K(t,slot) glds16(ksrc+(long)(t)*KVBLK*DM,(unsigned)__builtin_amdgcn_readfirstlane(kdst+(slot)))
  #define DMA_V(t,slot) glds16(vsrc+(long)(t)*KVBLK*DM,(unsigned)__builtin_amdgcn_readfirstlane(vdst+(slot)))
  const int vb0=(int)(lds0+LDS_V)+((lane>>4)&1)*32+(lane&3)*8+(4*hi+((lane&15)>>2))*64;
  const char*Kbase=shm+LDS_K; bf16x8 kf[8];
  const lds_cptr shm3=(lds_cptr)shm; const lds_cptr kp0=shm3+LDS_K+hi*1024+r32*16; const lds_cptr vp0=shm3+LDS_V+((lane>>4)&1)*32+(lane&3)*8+(4*hi+((lane&15)>>2))*64;
  const int NT=(q0+QB)/KVBLK;
  const u32x2_t*RECh=REC+(long)(b*NHEAD+h)*SEQ; const int nkeys=q0+QB; const int rk=2*tid;
  u32x4 rv0=u32x4{},rv1=u32x4{};
  if(rk<nkeys)rv0=*reinterpret_cast<const u32x4*>(RECh+rk);
  if(rk+1024<nkeys)rv1=*reinterpret_cast<const u32x4*>(RECh+rk+1024);
  const lds_cptr recp=(lds_cptr)shm+LDS_REC+r32*8;
  DMA_K(0,0);DMA_V(0,0);DMA_K(1,SLOTB);
  bf16x8 qr[4];
  #pragma unroll
  for(int d0=0;d0<4;++d0)qr[d0]=*reinterpret_cast<const bf16x8*>(&Qw[(long)r32*DM+d0*16+hi*8]);
  float mhat=0.f,l_reg=0.f;f32x16 o[2];o[0]=f32x16{};o[1]=f32x16{};
  { __attribute__((address_space(3))) u32x4*rl=(__attribute__((address_space(3))) u32x4*)((lds_cptr)shm+LDS_REC);
    if(rk<nkeys)rl[tid]=rv0; if(rk+1024<nkeys)rl[tid+512]=rv1; }
  u32x4 bq=make_bq(0.f,hi);
  u32x2_t rcA,rcB;
  #define RECLD(t_) do{ rcA=*(const __attribute__((address_space(3))) u32x2_t*)(recp+(t_)*512); rcB=*(const __attribute__((address_space(3))) u32x2_t*)(recp+(t_)*512+256); }while(0)
  const int qrel=wid*QBLK+r32;
  #define CMASK(P0,P1,t) do{int jb_=(t)-(NT-4); if(jb_>=0)cmask(P0,P1,jb_,qrel,hi);}while(0)
  bool resc=false;
  #define START(P0,P1) do{ const float rm=rowmax(P0,P1); resc=false; \
    { const float dl=rm; mhat=fadd_s(mhat,dl); \
      _Pragma("unroll") for(int r=0;r<16;++r){P0[r]=fsub_s(P0[r],dl);P1[r]=fsub_s(P1[r],dl);} \
      bq=make_bq(mhat,hi); } \
    _Pragma("unroll") for(int r=0;r<16;++r)P0[r]=__builtin_amdgcn_exp2f(P0[r]); }while(0)
  #define RESC() do{ if(resc){ asm volatile("s_waitcnt lgkmcnt(0)":::"memory"); \
      _Pragma("unroll") for(int d_=0;d_<2;++d_) _Pragma("unroll") for(int r=0;r<16;++r)o[d_][r]*=wsf[crow(r,hi)]; } }while(0)
  f32x16 pA0,pA1,pB0,pB1;
  int sl_prev=0,sl_cur=0,sl_next=SLOTB;
  #define ROT() do{sl_prev=sl_cur;sl_cur=sl_next;sl_next=(sl_next==(NSLOT-1)*SLOTB)?0:sl_next+SLOTB;}while(0)
  DMA_K(2,2*SLOTB);
  WAIT_BAR(3);
  RECLD(0);
  qkt(pA0,pA1,Kbase,qr,ABF(rcA),ABF(rcB),__builtin_bit_cast(bf16x8,bq),r32,hi);asm volatile("s_nop 15\n\ts_nop 7":"+v"(pA0),"+v"(pA1));CMASK(pA0,pA1,0);
  START(pA0,pA1);
  _Pragma("unroll") for(int r=0;r<16;++r)pA1[r]=__builtin_amdgcn_exp2f(pA1[r]);
  WAIT_BAR(0);
  DMA_K(3,0);DMA_V(1,SLOTB);
  ROT();
  kload8(kf,kp0+sl_cur);
  WAIT_BAR(2);
  s16x4 vlo[8],vhi[8]; u32x4 pw0,pw1,pw2,pw3;
  #define PKW(P,B) cvtpk_s(P[B],P[B+1])
  #define PAF(k) __builtin_bit_cast(bf16x8,pw##k)
  #define VFR(i) (bf16x8){vlo[i][0],vlo[i][1],vlo[i][2],vlo[i][3],vhi[i][0],vhi[i][1],vhi[i][2],vhi[i][3]}
  #define PIN(x) asm volatile("":"+v"(x))
  #define MX3(a,b,c) __builtin_fmaxf(__builtin_fmaxf((a),(b)),(c))
  #define GAPA(MF,A0,A1,A2,A3,W0,W1,PW) do{ MF; sacc+=A0; sacc+=A1; sacc+=A2; sacc+=A3; PIN(sacc); W0; W1; PIN(PW); SBAR(); }while(0)
  #define EX(v) __builtin_amdgcn_exp2f(v)
  #define GAPB(MF,X,B) do{ MF; X[B]=EX(X[B]); X[B+1]=EX(X[B+1]); X[B+2]=EX(X[B+2]); X[B+3]=EX(X[B+3]); PIN(X); SBAR(); }while(0)
  #define VRD(i) do{ vlo[i]=vtr(vp_+(((i)>>2)*4096+((i)&3)*1024)); vhi[i]=vtr(vp_+(((i)>>2)*4096+((i)&3)*1024+512)); }while(0)
  #define KRD(G,j) do{ if(G){ kload2(kf,kp0+sl_next,j); SBAR(); } }while(0)
  #define STEP(C0,C1,P0,P1,t,GK,GV,GL) do{ SBAR(); \
    const lds_cptr vp_=vp0+sl_prev; \
    RECLD(t); VRD(0); SBAR(); float sacc=(P0[0]+P0[1]); \
    C0=__builtin_amdgcn_mfma_f32_32x32x16_bf16(ABF(rcA),__builtin_bit_cast(bf16x8,bq),f32x16{},0,0,0); C1=__builtin_amdgcn_mfma_f32_32x32x16_bf16(ABF(rcB),__builtin_bit_cast(bf16x8,bq),f32x16{},0,0,0); SBAR(); \
    GAPA(C0=__builtin_amdgcn_mfma_f32_32x32x16_bf16(kf[0],qr[0],C0,0,0,0), P0[2],P0[3],P0[4],P0[5],     pw0[0]=PKW(P0,0), pw0[1]=PKW(P0,2), pw0); \
    VRD(4); SBAR(); GAPA(C1=__builtin_amdgcn_mfma_f32_32x32x16_bf16(kf[1],qr[0],C1,0,0,0), P0[6],P0[7],P0[8],P0[9],     pw0[2]=PKW(P0,4), pw0[3]=PKW(P0,6), pw0); \
    VRD(1); SBAR(); GAPA(C0=__builtin_amdgcn_mfma_f32_32x32x16_bf16(kf[2],qr[1],C0,0,0,0),   P0[10],P0[11],P0[12],P0[13], pw1[0]=PKW(P0,8), pw1[1]=PKW(P0,10), pw1); \
    VRD(5); SBAR(); GAPA(C1=__builtin_amdgcn_mfma_f32_32x32x16_bf16(kf[3],qr[1],C1,0,0,0),   P0[14],P0[15],P1[0],P1[1],   pw1[2]=PKW(P0,12),pw1[3]=PKW(P0,14), pw1); \
    VRD(2); SBAR(); GAPA(C0=__builtin_amdgcn_mfma_f32_32x32x16_bf16(kf[4],qr[2],C0,0,0,0),   P1[2],P1[3],P1[4],P1[5],     pw2[0]=PKW(P1,0), pw2[1]=PKW(P1,2), pw2); \
    VRD(6); SBAR(); GAPA(C1=__builtin_amdgcn_mfma_f32_32x32x16_bf16(kf[5],qr[2],C1,0,0,0),   P1[6],P1[7],P1[8],P1[9],     pw2[2]=PKW(P1,4), pw2[3]=PKW(P1,6), pw2); \
    VRD(3); SBAR(); GAPA(C0=__builtin_amdgcn_mfma_f32_32x32x16_bf16(kf[6],qr[3],C0,0,0,0),   P1[10],P1[11],P1[12],P1[13], pw3[0]=PKW(P1,8), pw3[1]=PKW(P1,10), pw3); \
    VRD(7); SBAR(); GAPA(C1=__builtin_amdgcn_mfma_f32_32x32x16_bf16(kf[7],qr[3],C1,0,0,0),   P1[14],P1[15],0.f,0.f,       pw3[2]=PKW(P1,12),pw3[3]=PKW(P1,14), pw3); \
    l_reg+=sacc; \
    if(GK){DMA_K((t)+3,sl_cur);} if(GV){DMA_V((t)+1,sl_next);} \
    CMASK(C0,C1,t); \
    { float a=MX3(C0[0],C0[1],C1[0]),b=MX3(C0[2],C0[3],C1[1]); a=MX3(a,C1[2],C1[3]); \
      _Pragma("unroll") for(int r=4;r<16;r+=4){a=MX3(a,C0[r],C0[r+1]);b=MX3(b,C0[r+2],C0[r+3]);a=MX3(a,C1[r],C1[r+1]);b=MX3(b,C1[r+2],C1[r+3]);} \
      float rm=__builtin_fmaxf(a,b); { auto rr=__builtin_amdgcn_permlane32_swap(__float_as_uint(rm),__float_as_uint(rm),false,false); rm=__builtin_fmaxf(__uint_as_float(rr[0]),__uint_as_float(rr[1])); } \
      resc=false; \
      if(__builtin_expect(__any(rm>(float)THRL),0)){ const float dl=__builtin_fmaxf(rm,0.f); mhat+=dl; \
        _Pragma("unroll") for(int r=0;r<16;++r){C0[r]-=dl;C1[r]-=dl;} \
        bq=make_bq(mhat,hi); \
        const float f=__builtin_amdgcn_exp2f(-dl); l_reg*=f; if(hi==0)wsf[r32]=f; resc=true; } } \
    SBAR(); \
    GAPB(o[0]=__builtin_amdgcn_mfma_f32_32x32x16_bf16(PAF(0),VFR(0),o[0],0,0,0), C0,0); \
    GAPB(o[1]=__builtin_amdgcn_mfma_f32_32x32x16_bf16(PAF(0),VFR(4),o[1],0,0,0), C0,4); \
    KRD(GL,0); GAPB(o[0]=__builtin_amdgcn_mfma_f32_32x32x16_bf16(PAF(1),VFR(1),o[0],0,0,0), C0,8); \
    KRD(GL,1); GAPB(o[1]=__builtin_amdgcn_mfma_f32_32x32x16_bf16(PAF(1),VFR(5),o[1],0,0,0), C0,12); \
    KRD(GL,2); GAPB(o[0]=__builtin_amdgcn_mfma_f32_32x32x16_bf16(PAF(2),VFR(2),o[0],0,0,0), C1,0); \
    KRD(GL,3); GAPB(o[1]=__builtin_amdgcn_mfma_f32_32x32x16_bf16(PAF(2),VFR(6),o[1],0,0,0), C1,4); \
    GAPB(o[0]=__builtin_amdgcn_mfma_f32_32x32x16_bf16(PAF(3),VFR(3),o[0],0,0,0), C1,8); \
    GAPB(o[1]=__builtin_amdgcn_mfma_f32_32x32x16_bf16(PAF(3),VFR(7),o[1],0,0,0), C1,12); \
    }while(0)
  int t=1;
  #undef CMASK
  #define CMASK(P0,P1,t) do{}while(0)
  for(;t+5<NT;t+=2){
    STEP(pB0,pB1,pA0,pA1,t,true,true,true);     WAIT_BAR(2); RESC(); ROT();
    STEP(pA0,pA1,pB0,pB1,t+1,true,true,true);   WAIT_BAR(2); RESC(); ROT();
  }
  #undef CMASK
  #define CMASK(P0,P1,t) do{int jb_=(t)-(NT-4); if(jb_>=0)cmask(P0,P1,jb_,qrel,hi);}while(0)
  #define ENDW(tt) do{ if((tt)+3<NT){WAIT_BAR(2);} else if((tt)+2<NT){WAIT_BAR(1);} else {WAIT_BAR(0);} }while(0)
  for(;t+1<NT;t+=2){
    STEP(pB0,pB1,pA0,pA1,t,(t+3<NT),(t+1<NT),(t+1<NT));       ENDW(t);   RESC(); ROT();
    STEP(pA0,pA1,pB0,pB1,t+1,(t+4<NT),(t+2<NT),(t+2<NT));     ENDW(t+1); RESC(); ROT();
  }
  STEP(pB0,pB1,pA0,pA1,NT-1,false,false,false); RESC();
  { float sacc=pB0[0]+pB0[1]; _Pragma("unroll") for(int r=2;r<16;++r)sacc+=pB0[r]; _Pragma("unroll") for(int r=0;r<16;++r)sacc+=pB1[r]; l_reg+=sacc;
    pw0=(u32x4){PKW(pB0,0),PKW(pB0,2),PKW(pB0,4),PKW(pB0,6)};pw1=(u32x4){PKW(pB0,8),PKW(pB0,10),PKW(pB0,12),PKW(pB0,14)};pw2=(u32x4){PKW(pB1,0),PKW(pB1,2),PKW(pB1,4),PKW(pB1,6)};pw3=(u32x4){PKW(pB1,8),PKW(pB1,10),PKW(pB1,12),PKW(pB1,14)};
    SBAR(); pv(o,vb0+sl_cur,PAF(0),PAF(1),PAF(2),PAF(3)); }
  #undef PKW
  #undef PAF
  #undef VFR
  #undef PIN
  #undef MX3
  #undef GAPA
  #undef GAPB
  #undef EX
  #undef VRD
  #undef KRD
  #undef STEP
  #undef ENDW
  {auto rr=__builtin_amdgcn_permlane32_swap(__float_as_uint(l_reg),__float_as_uint(l_reg),false,false);l_reg=__uint_as_float(rr[0])+__uint_as_float(rr[1]);}
  if(hi==0)wsf[32+r32]=l_reg;asm volatile("s_waitcnt lgkmcnt(0)":::"memory");
  float rli[16];
  #pragma unroll
  for(int r=0;r<16;++r)rli[r]=__builtin_amdgcn_rcpf(wsf[32+crow(r,hi)]);
  bf16*Ow=O+(rowbase+q0+wid*QBLK)*DM+h*D;
  { bf16*stg=(bf16*)(shm+LDS_OST)+wid*2048;
    #pragma unroll
    for(int r=0;r<16;++r){const int orow=crow(r,hi);
      #pragma unroll
      for(int d0=0;d0<2;++d0)stg[orow*64+d0*32+r32]=__float2bfloat16(o[d0][r]*rli[r]);}
    asm volatile("s_waitcnt lgkmcnt(0)":::"memory");
    #pragma unroll
    for(int i=0;i<4;++i){const int row=i*8+(lane>>3),ch=lane&7; const u32x4 v=*(const u32x4*)(stg+row*64+ch*8); ATTN_STORE16(Ow+(long)row*DM+ch*8,v);} }
  asm volatile("s_waitcnt lgkmcnt(0)\n\ts_barrier":::"memory");
  #undef DMA_K
  #undef DMA_V
  #undef RECLD
  #undef CMASK
  #undef START
  #undef RESC
  #undef ROT
}
constexpr int ATTN_LDS_BYTES=LDS_BYTES;
struct AttnTensors { const bf16* Q; const bf16* K; const bf16* V; bf16* O; const u32x2_t* REC; };
struct AttnUnit { int bh; int qb; };
struct StaticOrder {
  int vcu,ngrp;
  __device__ __forceinline__ explicit StaticOrder(int grid,int block):vcu((grid%8==0)?(block%8)*(grid/8)+block/8:block),ngrp(grid/8){}
  __device__ __forceinline__ bool next(int i,AttnUnit&u)const{ const int per=(BATCH*NHEAD+ngrp-1)/ngrp; if(i>=per)return false; const int s=vcu&7,g=vcu>>3; u.bh=g*per+i; if(u.bh>=BATCH*NHEAD)return false; u.qb=(i&1)?7-s:s; return true; }
  __device__ __forceinline__ void a_ready(const AttnUnit&)const{}
  __device__ __forceinline__ void done(const AttnUnit&)const{}
};
template<class Sched,int THRL=8> __device__ __forceinline__ void attn_phase(char*lds,const AttnTensors&T,const Sched&S){
  AttnUnit u;
  for(int i=0;S.next(i,u);++i){ S.a_ready(u); attn_unit<THRL>(u.bh/NHEAD,u.bh%NHEAD,u.qb,T.Q,T.K,T.V,T.O,T.REC,lds); S.done(u); }
}
#undef SBAR
#undef WAIT_BAR
}
#define GAS __attribute__((address_space(1)))
#define LAS __attribute__((address_space(3)))
typedef unsigned short bf16;
typedef unsigned v4u __attribute__((ext_vector_type(4)));
typedef float f32x4 __attribute__((ext_vector_type(4)));
typedef short bf16x8 __attribute__((ext_vector_type(8)));
typedef GAS unsigned gu32;
typedef GAS unsigned long long gu64;
#define RLX_AGENT __ATOMIC_RELAXED, __HIP_MEMORY_SCOPE_AGENT
#define LDS_WAIT() asm volatile("s_waitcnt lgkmcnt(0)" ::: "memory")
#define VM_WAIT() asm volatile("s_waitcnt vmcnt(0)" ::: "memory")
__device__ __forceinline__ unsigned long long rt() { return __builtin_amdgcn_s_memrealtime(); }
__device__ __forceinline__ unsigned f2bf(float f) { unsigned u = __builtin_bit_cast(unsigned, f); return (u + 0x7fffu + ((u >> 16) & 1u)) >> 16; }
__device__ __forceinline__ unsigned pk2(float lo, float hi) { return f2bf(lo) | (f2bf(hi) << 16); }

#define XB_TMO      128
#define XB_XCNT(j)  (256  + 64 * (j))
#define XB_XSUB(j)  (1280 + 64 * (j))
#define XB_XGEN(j)  (2304 + 64 * (j))
#define XB_TOP      3328
#define XB_TOPGEN   3392
#define XCD_BAR_WORDS 3456
#define XB_SPIN_CAP (1u << 18)

__device__ __forceinline__ unsigned xb_ld(unsigned* p)              { return __hip_atomic_load(p, __ATOMIC_RELAXED, __HIP_MEMORY_SCOPE_AGENT); }
__device__ __forceinline__ unsigned xb_add(unsigned* p, unsigned v) { return __hip_atomic_fetch_add(p, v, __ATOMIC_RELAXED, __HIP_MEMORY_SCOPE_AGENT); }
__device__ __forceinline__ unsigned xb_xcc_id() { return (unsigned)__builtin_amdgcn_s_getreg((3 << 11) | 20) & 0xFu; }
#define XB_SPIN(cond, bar) do { unsigned _sp = 0; while (cond) { __builtin_amdgcn_s_sleep(1); \
    if ((++_sp & 255u) == 0u) { if (xb_ld(&(bar)[XB_TMO])) break; if (_sp > XB_SPIN_CAP) { atomicAdd(&(bar)[XB_TMO], 1u); break; } } } } while (0)

struct XcdBarrier {
    unsigned* bar; unsigned x;
    volatile LAS unsigned* st;
};

__device__ __forceinline__ XcdBarrier xcd_barrier_post(unsigned* bar, volatile LAS unsigned* st) {
    XcdBarrier b; b.bar = bar; b.x = xb_xcc_id(); b.st = st;
    if (threadIdx.x == 0) (void)xb_add(&bar[XB_XCNT(b.x)], 1u);
    return b;
}
__device__ __forceinline__ void xcd_barrier_complete(unsigned* bar, unsigned x, unsigned& nloc, unsigned& nx) {
    const unsigned G = gridDim.x * gridDim.y * gridDim.z;
    unsigned sum, cnt, mine, sp = 0u;
    for (;;) {
        sum = 0u; cnt = 0u; mine = 0u;
#pragma unroll
        for (unsigned j = 0; j < 16; ++j) { const unsigned c = xb_ld(&bar[XB_XCNT(j)]); sum += c; cnt += (c > 0u) ? 1u : 0u; mine = (j == x) ? c : mine; }
        if (sum == G) break;
        __builtin_amdgcn_s_sleep(1);
        if ((++sp & 255u) == 0u) { if (xb_ld(&bar[XB_TMO])) break; if (sp > XB_SPIN_CAP) { atomicAdd(&bar[XB_TMO], 1u); break; } }
    }
    nloc = mine > 0u ? mine : 1u; nx = cnt > 0u ? cnt : 1u;
}

__device__ __forceinline__ void xcd_barrier(const XcdBarrier& b) {
    asm volatile("s_waitcnt vmcnt(0)" ::: "memory");
    __syncthreads();
    if (threadIdx.x == 0) {
        unsigned* bar = b.bar;
        __builtin_amdgcn_s_waitcnt(0);
        unsigned nloc = b.st[0], nx = b.st[1];
        if (nloc == 0u) { xcd_barrier_complete(bar, b.x, nloc, nx); b.st[0] = nloc; b.st[1] = nx; }
        const unsigned old = xb_add(&bar[XB_XSUB(b.x)], 1u);
        const unsigned gen = old / nloc;
        if (old + 1u == (gen + 1u) * nloc) {
            __builtin_amdgcn_fence(__ATOMIC_RELEASE, "agent");
            asm volatile("s_waitcnt vmcnt(0)" ::: "memory");
            const unsigned og = xb_add(&bar[XB_TOP], 1u);
            const unsigned tg = og / nx;
            if (og + 1u == (tg + 1u) * nx) xb_add(&bar[XB_TOPGEN], 1u);
            else XB_SPIN(xb_ld(&bar[XB_TOPGEN]) == tg, bar);
            __builtin_amdgcn_fence(__ATOMIC_ACQUIRE, "agent");
            xb_add(&bar[XB_XGEN(b.x)], 1u);
            asm volatile("s_waitcnt vmcnt(0)" ::: "memory");
        } else {
            XB_SPIN(xb_ld(&bar[XB_XGEN(b.x)]) == gen, bar);
            __builtin_amdgcn_fence(__ATOMIC_ACQUIRE, "agent");
            asm volatile("s_waitcnt vmcnt(0)" ::: "memory");
        }
    }
    __syncthreads();
}

constexpr int NWAVES = 8;
constexpr int NB = 32, SEQ = 2048, D = 1024, NH = 16, T = NB * SEQ;
constexpr int NPROJ = 8192, LDW_IN = 8208, FCOL0 = 6144;
constexpr int NEXP = 32, DE = 512, NLOG = 36, LCAP = 65536;
constexpr float RMS_EPS = 1e-6f, LOG2E = 1.4426950408889634f;
constexpr size_t MiB = 1u << 20;
constexpr size_t WS_CTL = 0, CTL_ZERO_BYTES = 64 * 1024;
constexpr size_t WS_FLOG = 1 * MiB;
constexpr size_t WS_REC = 5 * MiB;
constexpr size_t WS_LIST = 13 * MiB;
constexpr size_t WS_LWT = 21 * MiB;
constexpr size_t WS_WRT = 29 * MiB;
constexpr size_t WS_WIN = 32 * MiB;
constexpr size_t WS_WC = 48 * MiB, WS_WA = 50 * MiB, WS_WO = 52 * MiB;
constexpr size_t WS_WE1 = 56 * MiB;
constexpr size_t WS_WE2 = 120 * MiB;
constexpr size_t WS_XN = 160 * MiB;
constexpr size_t WS_B = 288 * MiB;
constexpr size_t WS_Z = 416 * MiB;
constexpr size_t WS_Q = 544 * MiB;
constexpr size_t WS_K = 672 * MiB, WS_V = 800 * MiB;
constexpr size_t WS_END = 928 * MiB;
constexpr int CW_BAR = 4096;
constexpr int CW_CNT = 8192;
static_assert((CW_CNT + 64 * NEXP) * 4 <= (int)CTL_ZERO_BYTES, "CTL words inside the memset region");
constexpr int RING_OFF = 0, RING_BYTES = 131072;
constexpr int TAB_OFF = 131072;
constexpr int TAB_CNT = TAB_OFF, TAB_TSTART = TAB_OFF + 128, TAB_RSTART = TAB_OFF + 384, TAB_DESC = TAB_OFF + 640, TAB_IDX = TAB_OFF + 1024, TAB_WT = TAB_IDX + pg8::MOE_SLOTS * 1024, TAB_END = TAB_WT + pg8::MOE_SLOTS * 1024;
constexpr int P5_W = 0, P5_ROUTE = NLOG * 1024 * 4, P5_LCNT = P5_ROUTE + 4096, P5_LBASE = P5_LCNT + 128, P5_END = P5_LBASE + 128;
constexpr int LDS_BYTES = 163840, LDSCTL_OFF = LDS_BYTES - 1024;
static_assert(TAB_END <= LDSCTL_OFF && P5_END <= LDSCTL_OFF && attn_body::ATTN_LDS_BYTES <= RING_BYTES, "LDS map");

typedef unsigned u32x2 __attribute__((ext_vector_type(2)));
typedef int i32x4 __attribute__((ext_vector_type(4)));

__device__ __forceinline__ float wave_sum(float v) {
#pragma unroll
    for (int o = 1; o < 64; o <<= 1) v += __shfl_xor(v, o);
    return v;
}
__device__ __forceinline__ float dpp_row_shr(float v, int n) {
    const int iv = __builtin_bit_cast(int, v); int r;
    switch (n) { case 1: r = __builtin_amdgcn_update_dpp(0, iv, 0x111, 0xf, 0xf, true); break; case 2: r = __builtin_amdgcn_update_dpp(0, iv, 0x112, 0xf, 0xf, true); break;
                 case 4: r = __builtin_amdgcn_update_dpp(0, iv, 0x114, 0xf, 0xf, true); break; default: r = __builtin_amdgcn_update_dpp(0, iv, 0x118, 0xf, 0xf, true); break; }
    return __builtin_bit_cast(float, r);
}
__device__ __forceinline__ float wave_total(float v) {
    v += dpp_row_shr(v, 1); v += dpp_row_shr(v, 2); v += dpp_row_shr(v, 4); v += dpp_row_shr(v, 8);
    v += __builtin_bit_cast(float, __builtin_amdgcn_update_dpp(0, __builtin_bit_cast(int, v), 0x142, 0xa, 0xf, false));
    v += __builtin_bit_cast(float, __builtin_amdgcn_update_dpp(0, __builtin_bit_cast(int, v), 0x143, 0xc, 0xf, false));
    return __builtin_bit_cast(float, __builtin_amdgcn_readlane(__builtin_bit_cast(int, v), 63));
}
__device__ __forceinline__ float dot4(const f32x4 a, const f32x4 b) { return (a.x * b.x + a.y * b.y) + (a.z * b.z + a.w * b.w); }

#ifndef PH_MASK
#define PH_MASK 0x1ff
#endif
#define PH(k) (((PH_MASK) >> (k)) & 1)
struct Args { const float* in[16]; float* out; unsigned char* ws; };

__device__ __forceinline__ void p0_transpose_item(const float* W, int ldw, int k0, int src_n0, bf16* WT, int ldk, int dst_row0, LAS float* scr, int lane) {
#pragma unroll 8
    for (int i = 0; i < 32; ++i) { const int kk = 2 * i + (lane >> 5); scr[kk * 33 + (lane & 31)] = W[(size_t)(k0 + kk) * ldw + src_n0 + (lane & 31)]; }
    LDS_WAIT(); asm volatile("" ::: "memory");
    const int c = lane & 7;
#pragma unroll
    for (int j = 0; j < 4; ++j) { const int n = (lane >> 3) + 8 * j; const LAS float* s = scr + (8 * c) * 33 + n;
        v4u o; o.x = pk2(s[0 * 33], s[1 * 33]); o.y = pk2(s[2 * 33], s[3 * 33]); o.z = pk2(s[4 * 33], s[5 * 33]); o.w = pk2(s[6 * 33], s[7 * 33]);
        *(GAS v4u*)(WT + (size_t)(dst_row0 + n) * ldk + k0 + 8 * c) = o; }
    LDS_WAIT(); asm volatile("" ::: "memory");
}
__device__ __forceinline__ int proj_src_col(int d) {
    if (d < 2048) { const int pn = d >> 8, x = d & 255; return x < 128 ? 1024 + 128 * pn + x : 2048 + 128 * pn + (x - 128); }
    if (d < 3072) return d - 2048;
    if (d < 6144) return d;
    return d + 16;
}

__global__ void __launch_bounds__(NWAVES * 64, 2) fox_moe_fwd(Args args) {
    extern __shared__ __attribute__((aligned(16))) unsigned char lds[];
    LAS unsigned char* const L = (LAS unsigned char*)lds;
    const int tid0 = threadIdx.x, wave = __builtin_amdgcn_readfirstlane(tid0 >> 6);
#define PHASE_IDS() int tid_ = threadIdx.x; asm volatile("" : "+v"(tid_)); const int tid = tid_, lane = tid & 63; (void)lane
    const int G = gridDim.x, bx = blockIdx.x;
    const int vcu = (G % 8 == 0) ? (bx % 8) * (G / 8) + bx / 8 : bx;
    const int gw = vcu * NWAVES + wave, NGW = G * NWAVES;
    typedef __attribute__((address_space(4))) const unsigned char* kargp_t;
    kargp_t kp = (kargp_t)__builtin_amdgcn_kernarg_segment_ptr();
#define KP_PHASE() asm volatile("" : "+s"(kp))
#define KIN(i) (*(const float* const __attribute__((address_space(4)))*)(kp + 8 * (i)))
#define KOUT() (*(float* const __attribute__((address_space(4)))*)(kp + 128))
#define KWS() (*(unsigned char* const __attribute__((address_space(4)))*)(kp + 136))
#define WSP(T_, off) ((T_*)(ws + (off)))
    gu32* const ctl = (gu32*)(KWS() + WS_CTL);
    for (int u = tid0; u < (LDS_BYTES - LDSCTL_OFF) / 4; u += NWAVES * 64) ((LAS unsigned*)(L + LDSCTL_OFF))[u] = 0u;
    __syncthreads();
    XcdBarrier bar = xcd_barrier_post((unsigned*)(ctl + CW_BAR), (volatile LAS unsigned*)(L + LDSCTL_OFF) + 8);

    if constexpr (PH(0)) {
        KP_PHASE(); PHASE_IDS(); unsigned char* const ws = KWS();
        const float* const x = KIN(0); const float* const g_mix = KIN(1); const float* const w_in = KIN(2); const float* const w_conv_out = KIN(6); const float* const w_att_out = KIN(7); const float* const w_out = KIN(8);
        const float* const w_rg = KIN(10); const float* const w_re = KIN(11); const float* const w_eg = KIN(12); const float* const w_eu = KIN(13); const float* const w_ed = KIN(14);
        bf16* const WIN = WSP(bf16, WS_WIN); bf16* const WC = WSP(bf16, WS_WC); bf16* const WA = WSP(bf16, WS_WA); bf16* const WO = WSP(bf16, WS_WO); bf16* const WE1 = WSP(bf16, WS_WE1); bf16* const WE2 = WSP(bf16, WS_WE2);
        float* const WRT = WSP(float, WS_WRT); bf16* const XN = WSP(bf16, WS_XN); float* const FLOG = WSP(float, WS_FLOG);
        LAS float* scr = (LAS float*)(L + RING_OFF + wave * 16384);
        constexpr int I_IN = 16 * 256, I_SQ = 16 * 32, I_E1 = NEXP * 512, I_E2 = NEXP * 256, NITEMS = I_IN + 3 * I_SQ + I_E1 + I_E2;
        for (int it = gw; it < NITEMS; it += NGW) {
            int r = it;
            if (r < I_IN) { const int kb = r >> 8, d0 = (r & 255) * 32; p0_transpose_item(w_in, LDW_IN, 64 * kb, proj_src_col(d0), WIN, D, d0, scr, lane); continue; } r -= I_IN;
            if (r < 3 * I_SQ) { const int w = r / I_SQ, rr = r % I_SQ, kb = rr >> 5, d0 = (rr & 31) * 32; p0_transpose_item(w == 0 ? w_conv_out : w == 1 ? w_att_out : w_out, D, 64 * kb, d0, w == 0 ? WC : w == 1 ? WA : WO, D, d0, scr, lane); continue; } r -= 3 * I_SQ;
            if (r < I_E1) { const int e = r >> 9, rr = r & 511, kb = rr >> 5, d0 = (rr & 31) * 32, pn = d0 >> 8, xx = d0 & 255;
                const float* src = (xx < 128 ? w_eg : w_eu) + (size_t)e * D * DE; const int sc = 128 * pn + (xx & 127);
                p0_transpose_item(src, DE, 64 * kb, sc, WE1 + (size_t)e * 1024 * D, D, d0, scr, lane); continue; } r -= I_E1;
            { const int e = r >> 8, rr = r & 255, kb = rr >> 5, d0 = (rr & 31) * 32; p0_transpose_item(w_ed + (size_t)e * DE * D, D, 64 * kb, d0, WE2 + (size_t)e * 1024 * DE, DE, d0, scr, lane); }
        }
        for (int i = bx * (NWAVES * 64) + tid; i < NLOG * D; i += G * NWAVES * 64) { const int e = i >> 10, k = i & 1023; WRT[i] = e < 4 ? w_rg[k * 4 + e] : w_re[(size_t)((e - 4) >> 3) * D * 8 + k * 8 + ((e - 4) & 7)]; }
        __syncthreads();
        LAS float* wfT = (LAS float*)(L + RING_OFF);
#pragma unroll
        for (int i = 0; i < 2; ++i) { const int k = tid + 512 * i; const GAS f32x4* src = (const GAS f32x4*)(w_in + (size_t)k * LDW_IN + FCOL0);
#pragma unroll
            for (int q = 0; q < 4; ++q) { const f32x4 v = src[q]; wfT[(4 * q + 0) * 1024 + k] = v.x; wfT[(4 * q + 1) * 1024 + k] = v.y; wfT[(4 * q + 2) * 1024 + k] = v.z; wfT[(4 * q + 3) * 1024 + k] = v.w; } }
        __syncthreads();
        f32x4 gv[4];
#pragma unroll
        for (int j = 0; j < 4; ++j) gv[j] = ((const GAS f32x4*)g_mix)[lane + 64 * j];
        for (int m = gw; m < T; m += NGW) {
            const GAS f32x4* xr = (const GAS f32x4*)(x + (size_t)m * D) + lane;
            f32x4 v[4]; float s2 = 0.f;
#pragma unroll
            for (int j = 0; j < 4; ++j) { v[j] = xr[64 * j]; s2 += dot4(v[j], v[j]); }
            const float rstd = 1.0f / sqrtf(wave_total(s2) * (1.f / D) + RMS_EPS);
#pragma unroll
            for (int j = 0; j < 4; ++j) v[j] = (v[j] * rstd) * gv[j];
            GAS unsigned long long* o8 = (GAS unsigned long long*)(XN + (size_t)m * D) + lane;
#pragma unroll
            for (int j = 0; j < 4; ++j) o8[64 * j] = (unsigned long long)pk2(v[j].x, v[j].y) | ((unsigned long long)pk2(v[j].z, v[j].w) << 32);
            float mine = 0.f;
#pragma unroll 2
            for (int e = 0; e < 16; ++e) { float p = 0.f;
#pragma unroll
                for (int j = 0; j < 4; ++j) p += dot4(v[j], *(const LAS f32x4*)(wfT + e * 1024 + 256 * j + 4 * lane));
                const float tot = wave_total(p); mine = (lane == e) ? tot : mine; }
            if (lane < 16) FLOG[(size_t)m * 16 + lane] = mine;
        }
    }
    xcd_barrier(bar);

    if constexpr (PH(1)) {
        KP_PHASE(); PHASE_IDS(); unsigned char* const ws = KWS(); const float* const b_forget = KIN(5); float* const out = KOUT();
        float* const FLOG = WSP(float, WS_FLOG); u32x2* const REC = WSP(u32x2, WS_REC); bf16* const XN = WSP(bf16, WS_XN); bf16* const WIN = WSP(bf16, WS_WIN);
        bf16* const ZB = WSP(bf16, WS_Z); bf16* const BB = WSP(bf16, WS_B); bf16* const QO = WSP(bf16, WS_Q); bf16* const KB = WSP(bf16, WS_K); bf16* const VB = WSP(bf16, WS_V);
        bf16* const SGC = (bf16*)out; bf16* const SGA = (bf16*)out + (size_t)T * D;
        LAS float* red = (LAS float*)(L + RING_OFF);
        for (int bh = bx; bh < NB * NH; bh += G) {
            const int b = bh >> 4, h = bh & 15; const float bf = b_forget[h];
            float c[4];
#pragma unroll
            for (int i = 0; i < 4; ++i) { const float xv = FLOG[((size_t)b * SEQ + 4 * tid + i) * 16 + h] + bf; const float ls = fminf(xv, 0.f) - log1pf(expf(-fabsf(xv))); c[i] = ls * LOG2E; }
            c[1] += c[0]; c[2] += c[1]; c[3] += c[2];
            const float tot = c[3]; float sc = tot;
#pragma unroll
            for (int o = 1; o < 64; o <<= 1) { const float tv = __shfl_up(sc, o); if (lane >= o) sc += tv; }
            if (lane == 63) red[wave] = sc;
            __syncthreads();
            float off = 0.f;
            for (int w = 0; w < wave; ++w) off += red[w];
            const float excl = off + (sc - tot);
            unsigned rw[8];
#pragma unroll
            for (int i = 0; i < 4; ++i) { const float bias = -(excl + c[i]);
                const unsigned h1 = f2bf(bias); const float r1 = bias - __uint_as_float(h1 << 16); const unsigned h2 = f2bf(r1); const float r2 = r1 - __uint_as_float(h2 << 16); const unsigned h3 = f2bf(r2);
                rw[2 * i] = h1 | (h2 << 16); rw[2 * i + 1] = h3 | (0x3f80u << 16); }
            GAS v4u* dst = (GAS v4u*)(REC + (size_t)bh * SEQ + 4 * tid);
            dst[0] = (v4u){rw[0], rw[1], rw[2], rw[3]}; dst[1] = (v4u){rw[4], rw[5], rw[6], rw[7]};
            __syncthreads();
        }
        pg8::StaticOrder S; S.init(XN, WIN, T, NPROJ, D, G, bx);
        pg8::EpiProj E{ZB, BB, QO, KB, VB, SGC, SGA, attn_body::C2};
        pg8::gemm_phase<pg8::EpiProj, pg8::StaticOrder, true, false>(L + RING_OFF, D, S, E);
    }
    xcd_barrier(bar);

    if constexpr (PH(2)) {
        KP_PHASE(); PHASE_IDS(); unsigned char* const ws = KWS(); const float* const conv_w = KIN(3); const float* const conv_b = KIN(4);
        bf16* const ZB = WSP(bf16, WS_Z); bf16* const BB = WSP(bf16, WS_B); bf16* const QO = WSP(bf16, WS_Q); bf16* const KB = WSP(bf16, WS_K); bf16* const VB = WSP(bf16, WS_V); u32x2* const REC = WSP(u32x2, WS_REC);
        const int cg = tid & 127;
        float w0[8], w1[8], w2[8], cb[8];
#pragma unroll
        for (int j = 0; j < 8; ++j) { w0[j] = conv_w[8 * cg + j]; w1[j] = conv_w[D + 8 * cg + j]; w2[j] = conv_w[2 * D + 8 * cg + j]; cb[j] = conv_b[8 * cg + j]; }
        for (int task = bx * (NWAVES * 64) + tid; task < (T / 32) * 128; task += G * NWAVES * 64) {
            const int t0 = (task >> 7) * 32;
            float z1[8], z2[8];
            if ((t0 & (SEQ - 1)) == 0) {
#pragma unroll
                for (int j = 0; j < 8; ++j) { z1[j] = 0.f; z2[j] = 0.f; }
            } else {
                const v4u a = *(const GAS v4u*)(ZB + (size_t)(t0 - 2) * D + 8 * cg), bq = *(const GAS v4u*)(ZB + (size_t)(t0 - 1) * D + 8 * cg);
                z2[0] = pg8::bf_lo(a.x); z2[1] = pg8::bf_hi(a.x); z2[2] = pg8::bf_lo(a.y); z2[3] = pg8::bf_hi(a.y); z2[4] = pg8::bf_lo(a.z); z2[5] = pg8::bf_hi(a.z); z2[6] = pg8::bf_lo(a.w); z2[7] = pg8::bf_hi(a.w);
                z1[0] = pg8::bf_lo(bq.x); z1[1] = pg8::bf_hi(bq.x); z1[2] = pg8::bf_lo(bq.y); z1[3] = pg8::bf_hi(bq.y); z1[4] = pg8::bf_lo(bq.z); z1[5] = pg8::bf_hi(bq.z); z1[6] = pg8::bf_lo(bq.w); z1[7] = pg8::bf_hi(bq.w);
            }
#pragma unroll 4
            for (int r = 0; r < 32; ++r) {
                const size_t off = (size_t)(t0 + r) * D + 8 * cg;
                const v4u zc = *(const GAS v4u*)(ZB + off), bv = *(const GAS v4u*)(BB + off);
                float z0[8], bb[8], y[8];
                z0[0] = pg8::bf_lo(zc.x); z0[1] = pg8::bf_hi(zc.x); z0[2] = pg8::bf_lo(zc.y); z0[3] = pg8::bf_hi(zc.y); z0[4] = pg8::bf_lo(zc.z); z0[5] = pg8::bf_hi(zc.z); z0[6] = pg8::bf_lo(zc.w); z0[7] = pg8::bf_hi(zc.w);
                bb[0] = pg8::bf_lo(bv.x); bb[1] = pg8::bf_hi(bv.x); bb[2] = pg8::bf_lo(bv.y); bb[3] = pg8::bf_hi(bv.y); bb[4] = pg8::bf_lo(bv.z); bb[5] = pg8::bf_hi(bv.z); bb[6] = pg8::bf_lo(bv.w); bb[7] = pg8::bf_hi(bv.w);
#pragma unroll
                for (int j = 0; j < 8; ++j) { y[j] = bb[j] * (cb[j] + w0[j] * z2[j] + w1[j] * z1[j] + w2[j] * z0[j]); z2[j] = z1[j]; z1[j] = z0[j]; }
                *(GAS v4u*)(BB + off) = (v4u){pk2(y[0], y[1]), pk2(y[2], y[3]), pk2(y[4], y[5]), pk2(y[6], y[7])};
            }
        }
        VM_WAIT(); __syncthreads();
        const attn_body::AttnTensors AT{(const attn_body::bf16*)QO, (const attn_body::bf16*)KB, (const attn_body::bf16*)VB, (attn_body::bf16*)QO, (const attn_body::u32x2_t*)REC};
        const attn_body::StaticOrder S(G, bx);
        attn_body::attn_phase<attn_body::StaticOrder>((char*)lds + RING_OFF, AT, S);
    }
    xcd_barrier(bar);

    if constexpr (PH(3)) {
        KP_PHASE(); PHASE_IDS(); unsigned char* const ws = KWS(); float* const out = KOUT();
        bf16* const BB = WSP(bf16, WS_B); bf16* const QO = WSP(bf16, WS_Q); bf16* const MB = WSP(bf16, WS_XN); bf16* const WC = WSP(bf16, WS_WC); bf16* const WA = WSP(bf16, WS_WA);
        bf16* const SGC = (bf16*)out; bf16* const SGA = (bf16*)out + (size_t)T * D;
        { pg8::StaticOrder S; S.init(BB, WC, T, D, D, G, bx); pg8::EpiGate<false> E{SGC, MB}; pg8::gemm_phase<pg8::EpiGate<false>, pg8::StaticOrder, true, false>(L + RING_OFF, D, S, E); }
        VM_WAIT(); __syncthreads();
        { pg8::StaticOrder S; S.init(QO, WA, T, D, D, G, bx); pg8::EpiGate<true> E{SGA, MB}; pg8::gemm_phase<pg8::EpiGate<true>, pg8::StaticOrder, true, false>(L + RING_OFF, D, S, E); }
    }
    xcd_barrier(bar);

    if constexpr (PH(4)) {
        KP_PHASE(); PHASE_IDS(); unsigned char* const ws = KWS(); float* const out = KOUT(); const float* const x = KIN(0); bf16* const MB = WSP(bf16, WS_XN); bf16* const WO = WSP(bf16, WS_WO);
        pg8::StaticOrder S; S.init(MB, WO, T, D, D, G, bx); pg8::EpiRes E{x, out};
        pg8::gemm_phase<pg8::EpiRes, pg8::StaticOrder, true, false>(L + RING_OFF, D, S, E);
    }
    xcd_barrier(bar);

    if constexpr (PH(5)) {
        KP_PHASE(); PHASE_IDS(); unsigned char* const ws = KWS(); float* const out = KOUT(); const float* const g_ffn = KIN(9);
        float* const WRT = WSP(float, WS_WRT); bf16* const H2 = WSP(bf16, WS_B); unsigned* const LIST = WSP(unsigned, WS_LIST); float* const LWT = WSP(float, WS_LWT);
        LAS float* Wl = (LAS float*)(L + P5_W); LAS i32x4* route = (LAS i32x4*)(L + P5_ROUTE); LAS int* lcnt = (LAS int*)(L + P5_LCNT); LAS int* lbase = (LAS int*)(L + P5_LBASE);
        for (int i = tid; i < NLOG * D / 4; i += NWAVES * 64) ((LAS f32x4*)Wl)[i] = ((const GAS f32x4*)WRT)[i];
        if (tid < 32) lcnt[tid] = 0;
        __syncthreads();
        f32x4 gv[4];
#pragma unroll
        for (int j = 0; j < 4; ++j) gv[j] = ((const GAS f32x4*)g_ffn)[lane + 64 * j];
        for (int rb = bx; rb < T / 256; rb += G) {
            for (int jr = 0; jr < 32; ++jr) {
                const int m = rb * 256 + wave * 32 + jr;
                const GAS f32x4* xr = (const GAS f32x4*)(out + (size_t)m * D) + lane;
                f32x4 v[4]; float s2 = 0.f;
#pragma unroll
                for (int j = 0; j < 4; ++j) { v[j] = xr[64 * j]; s2 += dot4(v[j], v[j]); }
                const float rstd = 1.0f / sqrtf(wave_total(s2) * (1.f / D) + RMS_EPS);
#pragma unroll
                for (int j = 0; j < 4; ++j) v[j] = (v[j] * rstd) * gv[j];
                GAS unsigned long long* o8 = (GAS unsigned long long*)(H2 + (size_t)m * D) + lane;
#pragma unroll
                for (int j = 0; j < 4; ++j) o8[64 * j] = (unsigned long long)pk2(v[j].x, v[j].y) | ((unsigned long long)pk2(v[j].z, v[j].w) << 32);
                float lg[NLOG];
#pragma unroll
                for (int e = 0; e < NLOG; ++e) { float p = 0.f;
#pragma unroll
                    for (int j = 0; j < 4; ++j) p += dot4(v[j], *(const LAS f32x4*)(Wl + e * 1024 + 256 * j + 4 * lane));
                    lg[e] = wave_total(p); }
                int g = 0; float mg = lg[0];
#pragma unroll
                for (int i = 1; i < 4; ++i) if (lg[i] > mg) { mg = lg[i]; g = i; }
                float sg = 0.f;
#pragma unroll
                for (int i = 0; i < 4; ++i) sg += expf(lg[i] - mg);
                const float gval = 1.0f / sg;
                float le[8];
#pragma unroll
                for (int j = 0; j < 8; ++j) le[j] = g == 0 ? lg[4 + j] : g == 1 ? lg[12 + j] : g == 2 ? lg[20 + j] : lg[28 + j];
                int i1 = 0; float m1 = le[0];
#pragma unroll
                for (int j = 1; j < 8; ++j) if (le[j] > m1) { m1 = le[j]; i1 = j; }
                int i2 = -1; float m2 = -INFINITY;
#pragma unroll
                for (int j = 0; j < 8; ++j) if (j != i1 && le[j] > m2) { m2 = le[j]; i2 = j; }
                const float e2 = expf(m2 - m1), v1 = 1.0f / (1.0f + e2), v2 = e2 / (1.0f + e2);
                if (lane == 0) route[wave * 32 + jr] = (i32x4){8 * g + i1, 8 * g + i2, (int)__float_as_uint(gval * v1), (int)__float_as_uint(gval * v2)};
            }
            __syncthreads();
            i32x4 rt = (i32x4){0, 0, 0, 0}; int rk1 = 0, rk2 = 0;
            if (tid < 256) { rt = route[tid]; rk1 = __hip_atomic_fetch_add(lcnt + rt.x, 1, __ATOMIC_RELAXED, __HIP_MEMORY_SCOPE_WORKGROUP); rk2 = __hip_atomic_fetch_add(lcnt + rt.y, 1, __ATOMIC_RELAXED, __HIP_MEMORY_SCOPE_WORKGROUP); }
            __syncthreads();
            if (tid < 32) lbase[tid] = (int)__hip_atomic_fetch_add(ctl + CW_CNT + 64 * tid, (unsigned)lcnt[tid], RLX_AGENT);
            __syncthreads();
            if (tid < 256) { const unsigned tok = (unsigned)(rb * 256 + tid);
                const size_t p1 = (size_t)rt.x * LCAP + (size_t)(lbase[rt.x] + rk1), p2 = (size_t)rt.y * LCAP + (size_t)(lbase[rt.y] + rk2);
                LIST[p1] = 2u * tok; LWT[p1] = __uint_as_float((unsigned)rt.z); LIST[p2] = 2u * tok + 1u; LWT[p2] = __uint_as_float((unsigned)rt.w); }
            __syncthreads();
            if (tid < 32) lcnt[tid] = 0;
            __syncthreads();
        }
    }
    xcd_barrier(bar);

    LAS int* tcnt = (LAS int*)(L + TAB_CNT); LAS int* tstart = (LAS int*)(L + TAB_TSTART); LAS int* rstart = (LAS int*)(L + TAB_RSTART);
    LAS i32x4* desc = (LAS i32x4*)(L + TAB_DESC); LAS unsigned* tidx = (LAS unsigned*)(L + TAB_IDX); LAS float* twt = (LAS float*)(L + TAB_WT);
    if constexpr (PH(6)) {
        KP_PHASE(); PHASE_IDS(); unsigned char* const ws = KWS(); unsigned* const LIST = WSP(unsigned, WS_LIST); float* const LWT = WSP(float, WS_LWT);
        if (tid < 32) tcnt[tid] = (int)__hip_atomic_load(ctl + CW_CNT + 64 * tid, RLX_AGENT);
        __syncthreads();
        if (tid == 0) { int ts = 0, rs = 0; for (int e = 0; e < NEXP; ++e) { tstart[e] = ts; rstart[e] = rs; ts += (tcnt[e] + 255) >> 8; rs += tcnt[e]; } tstart[NEXP] = ts; rstart[NEXP] = rs; }
        __syncthreads();
        if (tid < pg8::MOE_SLOTS) {
            const int nU = 4 * tstart[NEXP], chunk = (nU + 7) >> 3, per = (G + 7) / 8, s = tid * per + (bx >> 3), U = (bx & 7) * chunk + s;
            i32x4 d = (i32x4){0, 0, 0, 0};
            if (s < chunk && U < nU) { const int rowtile = U >> 2; int e = 0; while (e < NEXP - 1 && tstart[e + 1] <= rowtile) ++e; const int rt = rowtile - tstart[e]; int nv = tcnt[e] - 256 * rt; nv = nv > 256 ? 256 : nv; d = (i32x4){e, rt, U & 3, nv}; }
            desc[tid] = d;
        }
        __syncthreads();
        for (int slot = 0; slot < pg8::MOE_SLOTS; ++slot) { const i32x4 d = desc[slot];
            if (tid < 256) { unsigned ent = 0u; float w = 0.f; if (tid < d.w) { const size_t p = (size_t)d.x * LCAP + (size_t)(256 * d.y + tid); ent = LIST[p]; w = LWT[p]; } tidx[slot * 256 + tid] = ent; twt[slot * 256 + tid] = w; } }
        __syncthreads();
    }
    if constexpr (PH(6)) {
        KP_PHASE(); PHASE_IDS(); unsigned char* const ws = KWS(); bf16* const H2 = WSP(bf16, WS_B); bf16* const WE1 = WSP(bf16, WS_WE1); bf16* const ACT = WSP(bf16, WS_Q);
        pg8::MoeOrder S{H2, WE1, D, (size_t)1024 * D * 2, desc, rstart, tidx, true}; pg8::EpiSilu E{ACT, rstart};
        pg8::gemm_phase<pg8::EpiSilu, pg8::MoeOrder, true, true>(L + RING_OFF, D, S, E);
    }
    xcd_barrier(bar);
    if constexpr (PH(7)) {
        KP_PHASE(); PHASE_IDS(); unsigned char* const ws = KWS(); bf16* const ACT = WSP(bf16, WS_Q); bf16* const WE2 = WSP(bf16, WS_WE2); bf16* const YB = WSP(bf16, WS_K);
        pg8::MoeOrder S{ACT, WE2, DE, (size_t)1024 * DE * 2, desc, rstart, tidx, false}; pg8::EpiDown E{YB, tidx, twt};
        pg8::gemm_phase<pg8::EpiDown, pg8::MoeOrder, true, false>(L + RING_OFF, DE, S, E);
    }
    xcd_barrier(bar);

    if constexpr (PH(8)) {
        KP_PHASE(); PHASE_IDS(); unsigned char* const ws = KWS(); float* const out = KOUT(); const float* const g_fin = KIN(15); bf16* const YB = WSP(bf16, WS_K);
        f32x4 gv[4];
#pragma unroll
        for (int j = 0; j < 4; ++j) gv[j] = ((const GAS f32x4*)g_fin)[lane + 64 * j];
        for (int m = gw; m < T; m += NGW) {
            GAS f32x4* xr = (GAS f32x4*)(out + (size_t)m * D) + lane;
            const GAS u32x2* y0 = (const GAS u32x2*)(YB + (size_t)(2 * m) * D) + lane; const GAS u32x2* y1 = (const GAS u32x2*)(YB + (size_t)(2 * m + 1) * D) + lane;
            f32x4 v[4]; float s2 = 0.f;
#pragma unroll
            for (int j = 0; j < 4; ++j) { v[j] = xr[64 * j]; const u32x2 a = y0[64 * j], b = y1[64 * j];
                v[j].x += pg8::bf_lo(a.x) + pg8::bf_lo(b.x); v[j].y += pg8::bf_hi(a.x) + pg8::bf_hi(b.x); v[j].z += pg8::bf_lo(a.y) + pg8::bf_lo(b.y); v[j].w += pg8::bf_hi(a.y) + pg8::bf_hi(b.y);
                s2 += dot4(v[j], v[j]); }
            const float rstd = 1.0f / sqrtf(wave_total(s2) * (1.f / D) + RMS_EPS);
#pragma unroll
            for (int j = 0; j < 4; ++j) xr[64 * j] = (v[j] * rstd) * gv[j];
        }
    }
}

extern "C" void kernel_launch(void* const* d_in, const int* in_sizes, int n_in, void* d_out, int out_size, void* d_ws, size_t ws_size, hipStream_t stream) {
    static int grid = 0;
    if (grid == 0) {
        if (n_in != 16 || in_sizes[0] != T * D || out_size != T * D || ws_size < WS_END) { fprintf(stderr, "kernel_launch: built for 16 inputs, x/out of %d floats, >= %zu bytes of workspace; got n_in %d, in0 %d, out %d, ws %zu; nothing launched\n", T * D, (size_t)WS_END, n_in, n_in > 0 ? in_sizes[0] : -1, out_size, ws_size); grid = -1; return; }
        int dev = 0, cus = 0, per_cu = 0;
        if (hipGetDevice(&dev) != hipSuccess || hipDeviceGetAttribute(&cus, hipDeviceAttributeMultiprocessorCount, dev) != hipSuccess) { fprintf(stderr, "kernel_launch: hipGetDevice / hipDeviceGetAttribute failed; nothing launched\n"); grid = -1; return; }
        if (hipFuncSetAttribute((const void*)fox_moe_fwd, hipFuncAttributeMaxDynamicSharedMemorySize, LDS_BYTES) != hipSuccess) { fprintf(stderr, "kernel_launch: hipFuncSetAttribute(%d B LDS) failed; nothing launched\n", LDS_BYTES); grid = -1; return; }
        if (hipOccupancyMaxActiveBlocksPerMultiprocessor(&per_cu, (const void*)fox_moe_fwd, NWAVES * 64, LDS_BYTES) != hipSuccess || per_cu < 1)
            fprintf(stderr, "kernel_launch: note: the occupancy query reports %d workgroups per CU\n", per_cu);
        (void)hipGetLastError();
        grid = cus;
        if (grid % 8 != 0 || grid < 8) { fprintf(stderr, "kernel_launch: %d CUs: this kernel wants a multiple of 8\n", grid); grid = (grid / 8) * 8; if (grid == 0) { grid = -1; return; } }
    }
    if (grid < 0) return;
    if (hipMemsetAsync((char*)d_ws + WS_CTL, 0, CTL_ZERO_BYTES, stream) != hipSuccess) { fprintf(stderr, "kernel_launch: hipMemsetAsync of the control words failed; nothing launched\n"); return; }
    Args a{};
    for (int i = 0; i < 16; ++i) a.in[i] = (const float*)d_in[i];
    a.out = (float*)d_out; a.ws = (unsigned char*)d_ws;
    hipLaunchKernelGGL(fox_moe_fwd, dim3(grid), dim3(NWAVES * 64), LDS_BYTES, stream, a);
    const hipError_t le = hipPeekAtLastError();
    if (le != hipSuccess) fprintf(stderr, "kernel_launch: launch failed: %s (grid %d x %d threads, %d B LDS)\n", hipGetErrorName(le), grid, NWAVES * 64, LDS_BYTES);
}
```

```cpp
#include <hip/hip_runtime.h>
#include <hip/hip_bf16.h>
#include <cstdio>
#include <cstdint>
#include <cmath>
namespace pg8 {
#define PG8_LAS __attribute__((address_space(3)))
typedef unsigned short bf16_t;
typedef short bf16x8 __attribute__((ext_vector_type(8)));
typedef float f32x4 __attribute__((ext_vector_type(4)));
typedef unsigned u32x4 __attribute__((ext_vector_type(4)));
typedef unsigned u32x2 __attribute__((ext_vector_type(2)));
typedef int i32x4 __attribute__((ext_vector_type(4)));
constexpr int BM = 256, BK = 64, HALF = 128, HTB = HALF * BK * 2  , STAGE_BYTES = 8 * HTB, NXCD = 8, WGM = 8;

__host__ __device__ __forceinline__ int lds_byte(int r, int c) { const int st = (r >> 4) * 2 + (c >> 5), rr = r & 15, cc = c & 31, ob = rr * 64 + cc * 2; return st * 1024 + (ob ^ (((ob >> 9) & 1) << 5)); }
__host__ __device__ __forceinline__ void stage_rc(int b, int& R, int& C) { const int st = b / 1024, sb = b % 1024, swz = sb ^ (((sb >> 9) & 1) << 5); R = (st >> 1) * 16 + swz / 64; C = (st & 1) * 32 + (swz % 64) / 2; }
__host__ __device__ __forceinline__ int perm32(int rho) { const int n = rho >> 4, i = rho & 15; return 8 * (i >> 2) + 4 * n + (i & 3); }

struct Unit { int pm, pn, e, rt, slot, nvalid; };

struct StaticOrder {
    const bf16_t* A; const bf16_t* Bt; int K;
    int nM, nN, nwg, G, c, wgm;
    __device__ __forceinline__ void init(const bf16_t* A_, const bf16_t* Bt_, int M, int N, int K_, int G_, int c_, int wgm_ = WGM) { A = A_; Bt = Bt_; K = K_; nM = M / BM; nN = N / BM; nwg = nM * nN; G = G_; c = c_; wgm = wgm_; }
    __device__ __forceinline__ bool next(int i, Unit& u) const {
        const long L = (long)i * G + c; if (L >= nwg) return false;
        int wgid = (int)L; { const int q = nwg / NXCD, r = nwg % NXCD, xcd = wgid % NXCD, off = wgid / NXCD; wgid = (xcd < r ? xcd * (q + 1) : r * (q + 1) + (xcd - r) * q) + off; }
        const int nig = wgm * nN, gid = wgid / nig, fm = gid * wgm, gsz = (nM - fm) < wgm ? (nM - fm) : wgm;
        u.pm = fm + ((wgid % nig) % gsz); u.pn = (wgid % nig) / gsz; u.e = 0; u.rt = 0; u.slot = i; u.nvalid = BM; return true;
    }
    __device__ __forceinline__ const char* a_tile(const Unit& u) const { return (const char*)A + (size_t)u.pm * ((size_t)BM * K * 2); }
    __device__ __forceinline__ const char* b_tile(const Unit& u) const { return (const char*)Bt + (size_t)u.pn * ((size_t)BM * K * 2); }
    __device__ __forceinline__ void a_rows(int, const int (&)[2], const int (&)[2], unsigned (&)[2][2]) const {}
};

struct PanelOrder {
    const bf16_t* A; const bf16_t* Bt; int K; int nN, c;
    __device__ __forceinline__ bool next(int i, Unit& u) const { if (i >= nN) return false; u.pm = c; u.pn = i; u.e = 0; u.rt = 0; u.slot = i; u.nvalid = BM; return true; }
    __device__ __forceinline__ const char* a_tile(const Unit& u) const { return (const char*)A + (size_t)u.pm * ((size_t)BM * K * 2); }
    __device__ __forceinline__ const char* b_tile(const Unit& u) const { return (const char*)Bt + (size_t)u.pn * ((size_t)BM * K * 2); }
    __device__ __forceinline__ void a_rows(int, const int (&)[2], const int (&)[2], unsigned (&)[2][2]) const {}
};

struct HotOrder {
    const bf16_t* A; const bf16_t* Bt; int K; int n, c, pn;
    __device__ __forceinline__ bool next(int i, Unit& u) const { if (i >= n) return false; u.pm = c & 7; u.pn = pn; u.e = 0; u.rt = 0; u.slot = i; u.nvalid = BM; return true; }
    __device__ __forceinline__ const char* a_tile(const Unit& u) const { return (const char*)A + (size_t)u.pm * ((size_t)BM * K * 2); }
    __device__ __forceinline__ const char* b_tile(const Unit& u) const { return (const char*)Bt + (size_t)u.pn * ((size_t)BM * K * 2); }
    __device__ __forceinline__ void a_rows(int, const int (&)[2], const int (&)[2], unsigned (&)[2][2]) const {}
};
struct EpiNull {
    static constexpr bool PERM = true, AFTER_DRAIN = false; static constexpr int BMAP = 1;
    float* dump;
    static constexpr int NST = 0;
    __device__ __forceinline__ void operator()(f32x4 (&acc)[2][2][4][2], const Unit& u, int wr, int wc, int fr, int fq) const {
        f32x4 s = (f32x4){0.f, 0.f, 0.f, 0.f};
#pragma unroll
        for (int ai = 0; ai < 2; ++ai)
#pragma unroll
            for (int bj = 0; bj < 2; ++bj)
#pragma unroll
                for (int m = 0; m < 4; ++m)
#pragma unroll
                    for (int n = 0; n < 2; ++n) s += acc[ai][bj][m][n];
        *(f32x4*)(dump + (size_t)(blockIdx.x * 512 + threadIdx.x) * 4) = s;
#pragma unroll
        for (int ai = 0; ai < 2; ++ai)
#pragma unroll
            for (int bj = 0; bj < 2; ++bj)
#pragma unroll
                for (int m = 0; m < 4; ++m) { acc[ai][bj][m][0] = (f32x4){0.f, 0.f, 0.f, 0.f}; acc[ai][bj][m][1] = (f32x4){0.f, 0.f, 0.f, 0.f}; }
    }
};

constexpr int MOE_SLOTS = 10;
struct MoeOrder {
    const bf16_t* A; const bf16_t* Bt; int K; size_t bexp;
    const PG8_LAS i32x4* desc; const PG8_LAS int* rstart; const PG8_LAS unsigned* idx; bool gather;
    __device__ __forceinline__ bool next(int i, Unit& u) const {
        if (i >= MOE_SLOTS) return false;
        const i32x4 d = desc[i]; const int nv = __builtin_amdgcn_readfirstlane(d.w); if (nv <= 0) return false;
        u.e = __builtin_amdgcn_readfirstlane(d.x); u.rt = __builtin_amdgcn_readfirstlane(d.y); u.pn = __builtin_amdgcn_readfirstlane(d.z); u.nvalid = nv; u.slot = i; u.pm = 0; return true;
    }
    __device__ __forceinline__ const char* a_tile(const Unit& u) const {
        if (gather) return (const char*)A;
        const int r0 = __builtin_amdgcn_readfirstlane(rstart[u.e]) + BM * u.rt; return (const char*)A + (size_t)r0 * ((size_t)K * 2); }
    __device__ __forceinline__ const char* b_tile(const Unit& u) const { return (const char*)Bt + (size_t)u.e * bexp + (size_t)u.pn * ((size_t)BM * K * 2); }
    __device__ __forceinline__ void a_rows(int slot, const int (&Rp)[2], const int (&Cp)[2], unsigned (&voff)[2][2]) const {
#pragma unroll
        for (int h = 0; h < 2; ++h)
#pragma unroll
            for (int p = 0; p < 2; ++p) { const unsigned ent = idx[slot * BM + h * HALF + Rp[p]]; voff[h][p] = (ent >> 1) * (unsigned)(K * 2) + (unsigned)(Cp[p] * 2); }
    }
};

__device__ __forceinline__ unsigned cvt_pk_bf16(float lo, float hi) { unsigned r; asm volatile("v_cvt_pk_bf16_f32 %0, %1, %2" : "=v"(r) : "v"(lo), "v"(hi)); return r; }
__device__ __forceinline__ float bf_lo(unsigned w) { return __uint_as_float(w << 16); }
__device__ __forceinline__ float bf_hi(unsigned w) { return __uint_as_float(w & 0xffff0000u); }
__device__ __forceinline__ float sigmoid_f(float x) { return __builtin_amdgcn_rcpf(1.0f + __builtin_amdgcn_exp2f(-1.4426950408889634f * x)); }
__device__ __forceinline__ u32x4 pack8(const f32x4 v0, const f32x4 v1) { u32x4 w; w.x = cvt_pk_bf16(v0[0], v0[1]); w.y = cvt_pk_bf16(v0[2], v0[3]); w.z = cvt_pk_bf16(v1[0], v1[1]); w.w = cvt_pk_bf16(v1[2], v1[3]); return w; }

__device__ __forceinline__ unsigned gate_q(float x) { return __float_as_uint(__builtin_fmaf(sigmoid_f(x), 255.0f, 8388608.0f)); }
__device__ __forceinline__ unsigned gate_pack4(unsigned t0, unsigned t1, unsigned t2, unsigned t3) { return __builtin_amdgcn_perm(t1, t0, 0x0c0c0400u) | __builtin_amdgcn_perm(t3, t2, 0x04000c0cu); }
__device__ __forceinline__ float gate_f(unsigned w, int b) { return (float)((w >> (8 * b)) & 0xffu) * (1.0f / 255.0f); }
struct EpiProj {
    static constexpr bool PERM = true, AFTER_DRAIN = false; static constexpr int BMAP = 2;
    static constexpr int NST = 0;
    bf16_t *Z, *Bb, *Q, *Kk, *V, *SGC, *SGA; float qscale; PG8_LAS unsigned char* stg;
    __device__ __forceinline__ void operator()(f32x4 (&acc)[2][2][4][2], const Unit& u, int wr, int wc, int fr, int fq) const {
        if (u.pn < 8) {
            const int row0 = u.pm * BM + wr * 64 + fr, col0 = u.pn * HALF + wc * 32 + 8 * fq;
#pragma unroll
            for (int ai = 0; ai < 2; ++ai)
#pragma unroll
                for (int m = 0; m < 4; ++m) { bf16_t* rowp = Z + (size_t)(row0 + ai * HALF + m * 16) * 1024 + col0;
                    *(u32x4*)rowp = pack8(acc[ai][0][m][0] * acc[ai][1][m][0], acc[ai][0][m][1] * acc[ai][1][m][1]);
                    acc[ai][0][m][0] = (f32x4){0.f, 0.f, 0.f, 0.f}; acc[ai][0][m][1] = (f32x4){0.f, 0.f, 0.f, 0.f}; acc[ai][1][m][0] = (f32x4){0.f, 0.f, 0.f, 0.f}; acc[ai][1][m][1] = (f32x4){0.f, 0.f, 0.f, 0.f}; }
        } else if (u.pn >= 24) {
            unsigned char* base = (unsigned char*)(u.pn < 28 ? SGC : SGA); const int lane = fq * 16 + fr;
            PG8_LAS unsigned char* wp = stg + fr * 80 + fq * 8;
            const PG8_LAS unsigned char* rp = stg + (lane >> 2) * 80 + (lane & 3) * 16;
            unsigned char* gp = base + (size_t)(u.pm * BM + wr * 64 + (lane >> 2)) * 1024 + (u.pn & 3) * BM + wc * 64 + (lane & 3) * 16;
#pragma unroll
            for (int ai = 0; ai < 2; ++ai)
#pragma unroll
                for (int m = 0; m < 4; ++m) {
#pragma unroll
                    for (int bj = 0; bj < 2; ++bj) { const f32x4 v0 = acc[ai][bj][m][0], v1 = acc[ai][bj][m][1]; u32x2 w;
                        w.x = gate_pack4(gate_q(v0[0]), gate_q(v0[1]), gate_q(v0[2]), gate_q(v0[3])); w.y = gate_pack4(gate_q(v1[0]), gate_q(v1[1]), gate_q(v1[2]), gate_q(v1[3]));
                        *(PG8_LAS u32x2*)(wp + bj * 32) = w; acc[ai][bj][m][0] = (f32x4){0.f, 0.f, 0.f, 0.f}; acc[ai][bj][m][1] = (f32x4){0.f, 0.f, 0.f, 0.f}; }
                    const u32x4 r0 = *(const PG8_LAS u32x4*)rp;
                    *(u32x4*)(gp + (size_t)(ai * HALF + m * 16) * 1024) = r0; }
        } else {
            const int t = (u.pn - 8) >> 2; bf16_t* base = Bb + (t ? (Q - Bb) + (long)(t - 1) * (Kk - Q) : 0L);
            const float sc = (t == 1) ? qscale : 1.0f; const int lane = fq * 16 + fr;
            PG8_LAS unsigned char* wp = stg + fr * 144 + fq * 16;
            const PG8_LAS unsigned char* rp = stg + (lane >> 3) * 144 + (lane & 7) * 16;
            bf16_t* gp = base + (size_t)(u.pm * BM + wr * 64 + (lane >> 3)) * 1024 + ((u.pn - 8) & 3) * BM + wc * 64 + (lane & 7) * 8;
#pragma unroll
            for (int ai = 0; ai < 2; ++ai)
#pragma unroll
                for (int m = 0; m < 4; ++m) {
#pragma unroll
                    for (int bj = 0; bj < 2; ++bj) { f32x4 v0 = acc[ai][bj][m][0], v1 = acc[ai][bj][m][1];
                        v0 = v0 * sc; v1 = v1 * sc;
                        *(PG8_LAS u32x4*)(wp + bj * 64) = pack8(v0, v1); acc[ai][bj][m][0] = (f32x4){0.f, 0.f, 0.f, 0.f}; acc[ai][bj][m][1] = (f32x4){0.f, 0.f, 0.f, 0.f}; }
                    const u32x4 r0 = *(const PG8_LAS u32x4*)rp, r1 = *(const PG8_LAS u32x4*)(rp + 8 * 144);
                    bf16_t* g0 = gp + (size_t)(ai * HALF + m * 16) * 1024;
                    *(u32x4*)g0 = r0; *(u32x4*)(g0 + 8 * 1024) = r1; }
        }
    }
};
template <bool ADD> struct EpiGate {
    static constexpr bool PERM = true, AFTER_DRAIN = false; static constexpr int BMAP = 2;
    const unsigned char* G; bf16_t* Mo; PG8_LAS unsigned char* stg;
    static constexpr int NST = 0;
    __device__ __forceinline__ void operator()(f32x4 (&acc)[2][2][4][2], const Unit& u, int wr, int wc, int fr, int fq) const {
        const int row0 = u.pm * BM + wr * 64 + fr, col0 = u.pn * BM + wc * 64 + 8 * fq, lane = fq * 16 + fr;
        PG8_LAS unsigned char* wp = stg + fr * 144 + fq * 16; const PG8_LAS unsigned char* rp = stg + (lane >> 3) * 144 + (lane & 7) * 16;
        bf16_t* gp = Mo + (size_t)(u.pm * BM + wr * 64 + (lane >> 3)) * 1024 + u.pn * BM + wc * 64 + (lane & 7) * 8;
        u32x2 ga[2][4][2];
#pragma unroll
        for (int ai = 0; ai < 2; ++ai)
#pragma unroll
            for (int m = 0; m < 4; ++m)
#pragma unroll
                for (int bj = 0; bj < 2; ++bj) ga[ai][m][bj] = *(const u32x2*)(G + (size_t)(row0 + ai * HALF + m * 16) * 1024 + col0 + bj * 32);
#pragma unroll
        for (int ai = 0; ai < 2; ++ai) {
            u32x4 o[4][2];
            if (ADD) {
#pragma unroll
                for (int m = 0; m < 4; ++m)
#pragma unroll
                    for (int bj = 0; bj < 2; ++bj) o[m][bj] = *(const u32x4*)(Mo + (size_t)(row0 + ai * HALF + m * 16) * 1024 + col0 + bj * 32); }
            u32x2 (&g)[4][2] = ga[ai];
#pragma unroll
            for (int m = 0; m < 4; ++m) {
#pragma unroll
                for (int bj = 0; bj < 2; ++bj) { const u32x2 gg = g[m][bj]; f32x4 v0 = acc[ai][bj][m][0], v1 = acc[ai][bj][m][1];
                    v0[0] *= gate_f(gg.x, 0); v0[1] *= gate_f(gg.x, 1); v0[2] *= gate_f(gg.x, 2); v0[3] *= gate_f(gg.x, 3); v1[0] *= gate_f(gg.y, 0); v1[1] *= gate_f(gg.y, 1); v1[2] *= gate_f(gg.y, 2); v1[3] *= gate_f(gg.y, 3);
                    if (ADD) { const u32x4 oo = o[m][bj];
                        v0[0] += bf_lo(oo.x); v0[1] += bf_hi(oo.x); v0[2] += bf_lo(oo.y); v0[3] += bf_hi(oo.y); v1[0] += bf_lo(oo.z); v1[1] += bf_hi(oo.z); v1[2] += bf_lo(oo.w); v1[3] += bf_hi(oo.w); }
                    *(PG8_LAS u32x4*)(wp + bj * 64) = pack8(v0, v1); acc[ai][bj][m][0] = (f32x4){0.f, 0.f, 0.f, 0.f}; acc[ai][bj][m][1] = (f32x4){0.f, 0.f, 0.f, 0.f}; }
                const u32x4 r0 = *(const PG8_LAS u32x4*)rp, r1 = *(const PG8_LAS u32x4*)(rp + 8 * 144);
                bf16_t* g0 = gp + (size_t)(ai * HALF + m * 16) * 1024;
                *(u32x4*)g0 = r0; *(u32x4*)(g0 + 8 * 1024) = r1; }
        }
    }
};
struct EpiRes {
    static constexpr bool PERM = true, AFTER_DRAIN = false; static constexpr int BMAP = 2;
    const float* R; bf16_t* C; PG8_LAS unsigned char* stg;
    static constexpr int NST = 0;
    __device__ __forceinline__ void operator()(f32x4 (&acc)[2][2][4][2], const Unit& u, int wr, int wc, int fr, int fq) const {
        const int row0 = u.pm * BM + wr * 64 + fr, col0 = u.pn * BM + wc * 64 + 8 * fq, lane = fq * 16 + fr;
        PG8_LAS unsigned char* wp = stg + fr * 144 + fq * 16; const PG8_LAS unsigned char* rp = stg + (lane >> 3) * 144 + (lane & 7) * 16;
        bf16_t* gp = C + (size_t)(u.pm * BM + wr * 64 + (lane >> 3)) * 1024 + u.pn * BM + wc * 64 + (lane & 7) * 8;
#pragma unroll
        for (int ai = 0; ai < 2; ++ai) {
            f32x4 r[4][2][2];
#pragma unroll
            for (int m = 0; m < 4; ++m)
#pragma unroll
                for (int bj = 0; bj < 2; ++bj)
#pragma unroll
                    for (int n = 0; n < 2; ++n) r[m][bj][n] = *(const f32x4*)(R + (size_t)(row0 + ai * HALF + m * 16) * 1024 + col0 + bj * 32 + n * 4);
#pragma unroll
            for (int m = 0; m < 4; ++m) {
#pragma unroll
                for (int bj = 0; bj < 2; ++bj) { *(PG8_LAS u32x4*)(wp + bj * 64) = pack8(r[m][bj][0] + acc[ai][bj][m][0], r[m][bj][1] + acc[ai][bj][m][1]); acc[ai][bj][m][0] = (f32x4){0.f, 0.f, 0.f, 0.f}; acc[ai][bj][m][1] = (f32x4){0.f, 0.f, 0.f, 0.f}; }
                const u32x4 q0 = *(const PG8_LAS u32x4*)rp, q1 = *(const PG8_LAS u32x4*)(rp + 8 * 144);
                bf16_t* g0 = gp + (size_t)(ai * HALF + m * 16) * 1024;
                *(u32x4*)g0 = q0; *(u32x4*)(g0 + 8 * 1024) = q1; }
        }
    }
};
struct EpiResXN {
    static constexpr bool PERM = true, AFTER_DRAIN = false; static constexpr int BMAP = 2;
    const bf16_t* XNp; const float* RINV; const float* gain; bf16_t* C; PG8_LAS unsigned char* stg;
    static constexpr int NST = 0;
    __device__ __forceinline__ void operator()(f32x4 (&acc)[2][2][4][2], const Unit& u, int wr, int wc, int fr, int fq) const {
        const int row0 = u.pm * BM + wr * 64 + fr, col0 = u.pn * BM + wc * 64 + 8 * fq, lane = fq * 16 + fr;
        PG8_LAS unsigned char* wp = stg + fr * 144 + fq * 16; const PG8_LAS unsigned char* rp = stg + (lane >> 3) * 144 + (lane & 7) * 16;
        bf16_t* gp = C + (size_t)(u.pm * BM + wr * 64 + (lane >> 3)) * 1024 + u.pn * BM + wc * 64 + (lane & 7) * 8;
        f32x4 gi[2][2];
#pragma unroll
        for (int bj = 0; bj < 2; ++bj)
#pragma unroll
            for (int n = 0; n < 2; ++n) { const f32x4 gv = *(const f32x4*)(gain + col0 + bj * 32 + n * 4); gi[bj][n] = (f32x4){1.0f / gv[0], 1.0f / gv[1], 1.0f / gv[2], 1.0f / gv[3]}; }
#pragma unroll
        for (int ai = 0; ai < 2; ++ai) {
            u32x4 xn[4][2]; float ri[4];
#pragma unroll
            for (int m = 0; m < 4; ++m) { ri[m] = RINV[row0 + ai * HALF + m * 16];
#pragma unroll
                for (int bj = 0; bj < 2; ++bj) xn[m][bj] = *(const u32x4*)(XNp + (size_t)(row0 + ai * HALF + m * 16) * 1024 + col0 + bj * 32); }
#pragma unroll
            for (int m = 0; m < 4; ++m) {
#pragma unroll
                for (int bj = 0; bj < 2; ++bj) { const u32x4 q = xn[m][bj]; const float r = ri[m]; f32x4 v0 = acc[ai][bj][m][0], v1 = acc[ai][bj][m][1];
                    v0[0] += bf_lo(q.x) * r * gi[bj][0][0]; v0[1] += bf_hi(q.x) * r * gi[bj][0][1]; v0[2] += bf_lo(q.y) * r * gi[bj][0][2]; v0[3] += bf_hi(q.y) * r * gi[bj][0][3];
                    v1[0] += bf_lo(q.z) * r * gi[bj][1][0]; v1[1] += bf_hi(q.z) * r * gi[bj][1][1]; v1[2] += bf_lo(q.w) * r * gi[bj][1][2]; v1[3] += bf_hi(q.w) * r * gi[bj][1][3];
                    *(PG8_LAS u32x4*)(wp + bj * 64) = pack8(v0, v1); acc[ai][bj][m][0] = (f32x4){0.f, 0.f, 0.f, 0.f}; acc[ai][bj][m][1] = (f32x4){0.f, 0.f, 0.f, 0.f}; }
                const u32x4 q0 = *(const PG8_LAS u32x4*)rp, q1 = *(const PG8_LAS u32x4*)(rp + 8 * 144);
                bf16_t* g0 = gp + (size_t)(ai * HALF + m * 16) * 1024;
                *(u32x4*)g0 = q0; *(u32x4*)(g0 + 8 * 1024) = q1; }
        }
    }
};
struct EpiSilu {
    static constexpr bool PERM = true, AFTER_DRAIN = false; static constexpr int BMAP = 1;
    static constexpr int NST = 0;
    bf16_t* ACT; const PG8_LAS int* rstart; const PG8_LAS float* rs;
    __device__ __forceinline__ void operator()(f32x4 (&acc)[2][2][4][2], const Unit& u, int wr, int wc, int fr, int fq) const {
        const int rbase = __builtin_amdgcn_readfirstlane(rstart[u.e]) + BM * u.rt, col0 = u.pn * HALF + wc * 32 + 8 * fq;
#pragma unroll
        for (int ai = 0; ai < 2; ++ai)
#pragma unroll
            for (int m = 0; m < 4; ++m) { const int r = ai * HALF + wr * 64 + m * 16 + fr;
                if (r < u.nvalid) { f32x4 v0, v1; const float s = rs[u.slot * BM + r];
#pragma unroll
                    for (int j = 0; j < 4; ++j) { const float a0 = s * acc[ai][0][m][0][j], a1 = s * acc[ai][0][m][1][j]; v0[j] = a0 * sigmoid_f(a0) * (s * acc[ai][1][m][0][j]); v1[j] = a1 * sigmoid_f(a1) * (s * acc[ai][1][m][1][j]); }
                    *(u32x4*)(ACT + (size_t)(rbase + r) * 512 + col0) = pack8(v0, v1); }
                acc[ai][0][m][0] = (f32x4){0.f, 0.f, 0.f, 0.f}; acc[ai][0][m][1] = (f32x4){0.f, 0.f, 0.f, 0.f}; acc[ai][1][m][0] = (f32x4){0.f, 0.f, 0.f, 0.f}; acc[ai][1][m][1] = (f32x4){0.f, 0.f, 0.f, 0.f}; }
    }
};
struct EpiDown {
    static constexpr bool PERM = true, AFTER_DRAIN = false; static constexpr int BMAP = 2;
    bf16_t* Y; const PG8_LAS int* rstart; const PG8_LAS float* wt; PG8_LAS unsigned char* stg;
    static constexpr int NST = 0;
    __device__ __forceinline__ void operator()(f32x4 (&acc)[2][2][4][2], const Unit& u, int wr, int wc, int fr, int fq) const {
        const int rbase = __builtin_amdgcn_readfirstlane(rstart[u.e]) + BM * u.rt, lane = fq * 16 + fr;
        PG8_LAS unsigned char* wp = stg + fr * 144 + fq * 16;
        const PG8_LAS unsigned char* rp = stg + (lane >> 3) * 144 + (lane & 7) * 16;
        bf16_t* gp = Y + (size_t)(rbase + wr * 64 + (lane >> 3)) * 1024 + u.pn * BM + wc * 64 + (lane & 7) * 8;
#pragma unroll
        for (int ai = 0; ai < 2; ++ai)
#pragma unroll
            for (int m = 0; m < 4; ++m) { const int r = ai * HALF + wr * 64 + m * 16 + fr; const float w = wt[u.slot * BM + r];
#pragma unroll
                for (int bj = 0; bj < 2; ++bj) { *(PG8_LAS u32x4*)(wp + bj * 64) = pack8(acc[ai][bj][m][0] * w, acc[ai][bj][m][1] * w); acc[ai][bj][m][0] = (f32x4){0.f, 0.f, 0.f, 0.f}; acc[ai][bj][m][1] = (f32x4){0.f, 0.f, 0.f, 0.f}; }
                const u32x4 r0 = *(const PG8_LAS u32x4*)rp, r1 = *(const PG8_LAS u32x4*)(rp + 8 * 144);
                const int rs = ai * HALF + wr * 64 + m * 16 + (lane >> 3); bf16_t* g0 = gp + (size_t)(ai * HALF + m * 16) * 1024;
                const bf16_t* g1 = g0 + 8 * 1024;
                if (rs < u.nvalid) asm volatile("global_store_dwordx4 %0, %1, off nt" :: "v"(g0), "v"(r0) : "memory");
                if (rs + 8 < u.nvalid) asm volatile("global_store_dwordx4 %0, %1, off nt" :: "v"(g1), "v"(r1) : "memory"); }
    }
};

template <class Epi, class Sched, bool ALIGN_EPI, bool GATHER>
__device__ __forceinline__ void gemm_phase(PG8_LAS unsigned char* lds, const int K, const Sched& S, const Epi& E, unsigned char* dump = nullptr) {
    int tid_ = threadIdx.x; asm volatile("" : "+v"(tid_));
    const int tid = tid_, wid = __builtin_amdgcn_readfirstlane(tid >> 6), lane = tid & 63, wr = wid >> 2, wc = wid & 3, fr = lane & 15, fq = lane >> 4;
    const int nt = K / BK;
    unsigned voffB[2][2], voffC[2][2], voffN[2][2]; int Rp[2], Cp[2];
#pragma unroll
    for (int i = 0; i < 2; ++i) { int R, C; stage_rc(tid * 16 + i * 8192, R, C); Rp[i] = R; Cp[i] = C;
#pragma unroll
        for (int hh = 0; hh < 2; ++hh) { const int Rb = Epi::BMAP == 2 ? (64 * (R >> 5) + 32 * hh + perm32(R & 31)) : (HALF * hh + (Epi::PERM ? ((R & ~31) + perm32(R & 31)) : R)); voffB[hh][i] = (unsigned)(Rb * K + C) * 2u; }
        voffC[0][i] = (unsigned)(R * K + C) * 2u; voffC[1][i] = (unsigned)((R + HALF) * K + C) * 2u; voffN[0][i] = voffC[0][i]; voffN[1][i] = voffC[1][i]; }
    const size_t kstep = (size_t)(BK * 2);
    const unsigned ldsw = (unsigned)wid * 1024u;
    const int aoff = lds_byte(wr * 64 + fr, fq * 8), boff = lds_byte(wc * 32 + fr, fq * 8);
#define PG8_SA(b, h) (((b) * 2 + (h)) * HTB)
#define PG8_SB(b, h) ((4 + (b) * 2 + (h)) * HTB)
#define PG8_STAGE(bufoff, gbase, voff) do { _Pragma("unroll") for (int _i = 0; _i < 2; ++_i) \
        __builtin_amdgcn_global_load_lds((const unsigned*)((const char*)(gbase) + (voff)[_i]), (PG8_LAS unsigned*)(lds + (bufoff) + ldsw + _i * 8192), 16, 0, 0); } while (0)
#define PG8_LDA(dst, b, h) do { _Pragma("unroll") for (int m = 0; m < 4; ++m) _Pragma("unroll") for (int k = 0; k < 2; ++k) dst[m][k] = *(const PG8_LAS bf16x8*)(lds + PG8_SA(b, h) + aoff + m * 2048 + k * 1024); } while (0)
#define PG8_LDB(dst, b, h) do { _Pragma("unroll") for (int n = 0; n < 2; ++n) _Pragma("unroll") for (int k = 0; k < 2; ++k) dst[n][k] = *(const PG8_LAS bf16x8*)(lds + PG8_SB(b, h) + boff + n * 2048 + k * 1024); } while (0)
#define PG8_MMA(ai, bj, At, Bt) do { __builtin_amdgcn_s_setprio(1); _Pragma("unroll") for (int m = 0; m < 4; ++m) _Pragma("unroll") for (int n = 0; n < 2; ++n) _Pragma("unroll") for (int k = 0; k < 2; ++k) \
        acc[ai][bj][m][n] = __builtin_amdgcn_mfma_f32_16x16x32_bf16(Bt[n][k], At[m][k], acc[ai][bj][m][n], 0, 0, 0); __builtin_amdgcn_s_setprio(0); } while (0)
#define PG8_WAIT_V(n) asm volatile("s_waitcnt vmcnt(" #n ")" ::: "memory")
#define PG8_WAIT_VR(rlx) do { if constexpr (Epi::NST == 16) asm volatile("s_waitcnt vmcnt(24)\n\ts_cmp_lg_u32 %0, 0\n\ts_cbranch_scc1 .Lrlx_%=\n\ts_waitcnt vmcnt(8)\n.Lrlx_%=:" :: "s"(rlx) : "memory", "scc"); \
        else if constexpr (Epi::NST == 8) asm volatile("s_waitcnt vmcnt(16)\n\ts_cmp_lg_u32 %0, 0\n\ts_cbranch_scc1 .Lrlx_%=\n\ts_waitcnt vmcnt(8)\n.Lrlx_%=:" :: "s"(rlx) : "memory", "scc"); else PG8_WAIT_V(8); } while (0)
#define PG8_WAIT_L(n) asm volatile("s_waitcnt lgkmcnt(" #n ")" ::: "memory")
#define PG8_BAR __builtin_amdgcn_s_barrier()
#define PG8_SCHED __builtin_amdgcn_sched_barrier(0)
    Unit cur, nxt; int ui = 0;
    if (!S.next(0, cur)) return;
    if constexpr (GATHER) S.a_rows(0, Rp, Cp, voffC);
    f32x4 acc[2][2][4][2];
#pragma unroll
    for (int a = 0; a < 2; ++a)
#pragma unroll
        for (int b = 0; b < 2; ++b)
#pragma unroll
            for (int m = 0; m < 4; ++m)
#pragma unroll
                for (int n = 0; n < 2; ++n) acc[a][b][m][n] = (f32x4){0.f, 0.f, 0.f, 0.f};
    bf16x8 At[4][2], B0[2][2], B1[2][2];
    const char* cA = S.a_tile(cur); const char* cB = S.b_tile(cur);
    PG8_STAGE(PG8_SB(0, 0), cB, voffB[0]); PG8_STAGE(PG8_SB(0, 1), cB, voffB[1]); PG8_STAGE(PG8_SA(0, 0), cA, voffC[0]); PG8_STAGE(PG8_SA(0, 1), cA, voffC[1]);
    if (wr == 1) PG8_BAR;
    PG8_WAIT_V(2); PG8_BAR;
    PG8_STAGE(PG8_SB(1, 0), cB + kstep, voffB[0]); PG8_STAGE(PG8_SA(1, 0), cA + kstep, voffC[0]); PG8_STAGE(PG8_SB(1, 1), cB + kstep, voffB[1]);
    PG8_WAIT_V(6); PG8_BAR;
    (void)dump;
    for (;;) {
        const bool has_next = S.next(ui + 1, nxt);
        const char* nA = has_next ? S.a_tile(nxt) : cA; const char* nB = has_next ? S.b_tile(nxt) : cB;
        if constexpr (GATHER) { if (has_next) S.a_rows(ui + 1, Rp, Cp, voffN); else {
#pragma unroll
                for (int h = 0; h < 2; ++h)
#pragma unroll
                    for (int p = 0; p < 2; ++p) voffN[h][p] = voffC[h][p]; } }
#define PG8_KTRIP(FIRST_) do { \
            const bool last = (t == nt - 2); \
            const char* a1 = cA + (size_t)(t + 1) * kstep; \
            const char* a2 = last ? nA : cA + (size_t)(t + 2) * kstep; const char* b2 = last ? nB : cB + (size_t)(t + 2) * kstep; \
            const char* a3 = a2 + kstep; const char* b3 = b2 + kstep; \
            unsigned vo2[2][2]; \
            _Pragma("unroll") \
            for (int h = 0; h < 2; ++h) \
            _Pragma("unroll") \
                for (int p = 0; p < 2; ++p) vo2[h][p] = (GATHER && last) ? voffN[h][p] : voffC[h][p]; \
            PG8_LDB(B0, 0, 0); PG8_LDB(B1, 0, 1); PG8_SCHED; PG8_LDA(At, 0, 0); PG8_STAGE(PG8_SA(1, 1), a1, voffC[1]); \
            PG8_WAIT_VR(FIRST_); PG8_WAIT_L(0); PG8_BAR; PG8_MMA(0, 0, At, B0); PG8_MMA(0, 1, At, B1); PG8_BAR; PG8_SCHED; \
            PG8_LDA(At, 0, 1); PG8_STAGE(PG8_SB(0, 0), b2, voffB[0]); PG8_STAGE(PG8_SB(0, 1), b2, voffB[1]); PG8_STAGE(PG8_SA(0, 0), a2, vo2[0]); \
            PG8_WAIT_VR(FIRST_); PG8_WAIT_L(0); PG8_BAR; PG8_MMA(1, 0, At, B0); PG8_MMA(1, 1, At, B1); PG8_BAR; PG8_SCHED; \
            PG8_LDB(B0, 1, 0); PG8_LDB(B1, 1, 1); PG8_SCHED; PG8_LDA(At, 1, 0); PG8_STAGE(PG8_SA(0, 1), a2, vo2[1]); \
            PG8_WAIT_V(8); PG8_WAIT_L(0); PG8_BAR; PG8_MMA(0, 0, At, B0); PG8_MMA(0, 1, At, B1); PG8_BAR; PG8_SCHED; \
            PG8_LDA(At, 1, 1); PG8_STAGE(PG8_SB(1, 0), b3, voffB[0]); PG8_STAGE(PG8_SB(1, 1), b3, voffB[1]); PG8_STAGE(PG8_SA(1, 0), a3, vo2[0]); \
            PG8_WAIT_V(8); PG8_WAIT_L(0); PG8_BAR; PG8_MMA(1, 0, At, B0); PG8_MMA(1, 1, At, B1); PG8_BAR; PG8_SCHED; \
        } while (0)
        for (int t = 0; t < nt; t += 2) { const int rlx = __builtin_amdgcn_readfirstlane((t == 0 && ui > 0) ? 1 : 0); PG8_KTRIP(rlx); }
#undef PG8_KTRIP
        if constexpr (ALIGN_EPI) { if (wr == 0) PG8_BAR; }
        E(acc, cur, wr, wc, fr, fq);
        if (!has_next) break;
        cur = nxt; cA = nA; cB = nB; ++ui;
        if constexpr (GATHER) {
#pragma unroll
            for (int h = 0; h < 2; ++h)
#pragma unroll
                for (int p = 0; p < 2; ++p) voffC[h][p] = voffN[h][p]; }
        if constexpr (ALIGN_EPI) { if (wr == 1) PG8_BAR; }
    }
    PG8_WAIT_V(0);
    if constexpr (!ALIGN_EPI) { if (wr == 0) PG8_BAR; }
    PG8_BAR;
#undef PG8_SA
#undef PG8_SB
#undef PG8_STAGE
#undef PG8_LDA
#undef PG8_LDB
#undef PG8_MMA
#undef PG8_WAIT_V
#undef PG8_WAIT_VR
#undef PG8_WAIT_L
#undef PG8_BAR
#undef PG8_SCHED
}
}

#include <hip/hip_bf16.h>
#include <cmath>
namespace attn_body {
using bf16=__hip_bfloat16;
using bf16x8=__attribute__((ext_vector_type(8)))short;
using s16x4=__attribute__((ext_vector_type(4)))short;
using f32x16=__attribute__((ext_vector_type(16)))float;
using u32x4=__attribute__((ext_vector_type(4)))unsigned;
using f32x4_t=__attribute__((ext_vector_type(4)))float;
constexpr int BATCH=32,NHEAD=16,SEQ=2048,D=64,DM=NHEAD*D;
constexpr int NW=8,QBLK=32,QB=QBLK*NW,KVBLK=64,NQB=SEQ/QB;
constexpr int ATTN_PITCH=DM, ATTN_UNIT_ROWS=QB;
__device__ __forceinline__ int crow(int r,int hi){return (r&3)+8*(r>>2)+4*hi;}
#define SBAR() __builtin_amdgcn_sched_barrier(0)
__device__ __forceinline__ void cmask(f32x16&p0,f32x16&p1,int jb,int qrel,int hi){
  const float NEG=-INFINITY; int kb=64*jb+4*hi;
  #pragma unroll
  for(int r=0;r<16;++r){int kv=kb+(r&3)+8*(r>>2); if(kv>qrel)p0[r]=NEG; if(kv+32>qrel)p1[r]=NEG;}
}

constexpr int NSLOT=3, SLOTB=8192;
constexpr int LDS_K=0, LDS_V=NSLOT*SLOTB, LDS_WS=2*NSLOT*SLOTB, LDS_OST=LDS_WS+NW*64*4, LDS_REC=LDS_OST+NW*4096, LDS_BYTES=LDS_REC+SEQ*8, LDS_ZR=LDS_BYTES, ZR_ROWS=18, LDS_CW=LDS_ZR+ZR_ROWS*2048, LDS_SIDE_END=LDS_CW+16384;
constexpr float C2=0.125f*1.4426950408889634f;
__device__ __forceinline__ void glds16(const void*gsrc,unsigned lds_dst){unsigned keep;
  asm volatile("s_mov_b32 %0, m0\n\ts_mov_b32 m0, %2\n\ts_nop 0\n\tglobal_load_lds_dwordx4 %1, off\n\ts_mov_b32 m0, %0":"=&s"(keep):"v"(gsrc),"s"(lds_dst):"memory");}
__device__ __forceinline__ float max3f(float a,float b,float c){float r;asm("v_max3_f32 %0, %1, %2, %3":"=v"(r):"v"(a),"v"(b),"v"(c));return r;}
__device__ __forceinline__ float max2f(float a,float b){float r;asm("v_max_f32_e32 %0, %1, %2":"=v"(r):"v"(a),"v"(b));return r;}
__device__ __forceinline__ float fadd_s(float a,float b){float r;asm("v_add_f32_e32 %0, %1, %2":"=v"(r):"v"(a),"v"(b));return r;}
__device__ __forceinline__ float fsub_s(float a,float b){float r;asm("v_sub_f32_e32 %0, %1, %2":"=v"(r):"v"(a),"v"(b));return r;}
typedef float f32x2_t __attribute__((ext_vector_type(2))); typedef __bf16 bf16x2_t __attribute__((ext_vector_type(2)));
__device__ __forceinline__ unsigned cvtpk_s(float lo,float hi){f32x2_t v={lo,hi};bf16x2_t b=__builtin_convertvector(v,bf16x2_t);return __builtin_bit_cast(unsigned,b);}
#define WAIT_BAR(N) asm volatile("s_waitcnt vmcnt(" #N ") lgkmcnt(0)\n\ts_barrier":::"memory")

__device__ __forceinline__ void qkt(f32x16&p0,f32x16&p1,const char*Kslot,const bf16x8*qr,bf16x8 ab0,bf16x8 ab1,bf16x8 bq,int r32,int hi){
  const char*kb=Kslot+hi*1024+r32*16;
  p0=__builtin_amdgcn_mfma_f32_32x32x16_bf16(ab0,bq,f32x16{},0,0,0);p1=__builtin_amdgcn_mfma_f32_32x32x16_bf16(ab1,bq,f32x16{},0,0,0);
  #pragma unroll
  for(int d0=0;d0<4;++d0){
    const bf16x8 b0=*reinterpret_cast<const bf16x8*>(kb+d0*2048);
    const bf16x8 b1=*reinterpret_cast<const bf16x8*>(kb+d0*2048+512);
    p0=__builtin_amdgcn_mfma_f32_32x32x16_bf16(b0,qr[d0],p0,0,0,0);p1=__builtin_amdgcn_mfma_f32_32x32x16_bf16(b1,qr[d0],p1,0,0,0);}
}
__device__ __forceinline__ u32x4 make_bq(float mhat,int hi){
  const float nm=-mhat; const unsigned h1=cvtpk_s(nm,0.f)&0xffffu; const float r1=nm-__uint_as_float(h1<<16);
  const unsigned h2=cvtpk_s(r1,0.f)&0xffffu; const float r2=r1-__uint_as_float(h2<<16); const unsigned h3=cvtpk_s(r2,0.f)&0xffffu;
  u32x4 b; b.x=hi?0u:0x3f803f80u; b.y=hi?0u:(0x3f80u|(h1<<16)); b.z=hi?0u:(h2|(h3<<16)); b.w=0u; return b;
}
typedef unsigned u32x2_t __attribute__((ext_vector_type(2)));
#define ABF(rc) __builtin_bit_cast(bf16x8,(u32x4){(rc).x,(rc).y,0x3f803f80u,0u})
typedef __attribute__((address_space(3))) const char* lds_cptr;
typedef short v4i16_t __attribute__((ext_vector_type(4)));
__device__ __forceinline__ void kload8(bf16x8*kf,lds_cptr kp){
  kf[0]=*(const __attribute__((address_space(3))) bf16x8*)(kp);      kf[1]=*(const __attribute__((address_space(3))) bf16x8*)(kp+512);
  kf[2]=*(const __attribute__((address_space(3))) bf16x8*)(kp+2048); kf[3]=*(const __attribute__((address_space(3))) bf16x8*)(kp+2560);
  kf[4]=*(const __attribute__((address_space(3))) bf16x8*)(kp+4096); kf[5]=*(const __attribute__((address_space(3))) bf16x8*)(kp+4608);
  kf[6]=*(const __attribute__((address_space(3))) bf16x8*)(kp+6144); kf[7]=*(const __attribute__((address_space(3))) bf16x8*)(kp+6656);
}
__device__ __forceinline__ void kload2(bf16x8*kf,lds_cptr kp,int j){ kf[2*j]=*(const __attribute__((address_space(3))) bf16x8*)(kp+j*2048); kf[2*j+1]=*(const __attribute__((address_space(3))) bf16x8*)(kp+j*2048+512); }
__device__ __forceinline__ s16x4 vtr(lds_cptr p){ return __builtin_bit_cast(s16x4,__builtin_amdgcn_ds_read_tr16_b64_v4i16((__attribute__((address_space(3))) v4i16_t*)p)); }
__device__ __forceinline__ float rowmax(const f32x16&p0,const f32x16&p1){
  float a=max3f(p0[0],p0[1],p1[0]),b=max3f(p0[2],p0[3],p1[1]);a=max3f(a,p1[2],p1[3]);
  #pragma unroll
  for(int r=4;r<16;r+=4){a=max3f(a,p0[r],p0[r+1]);b=max3f(b,p0[r+2],p0[r+3]);a=max3f(a,p1[r],p1[r+1]);b=max3f(b,p1[r+2],p1[r+3]);}
  const float m=max2f(a,b);
  auto rr=__builtin_amdgcn_permlane32_swap(__float_as_uint(m),__float_as_uint(m),false,false);
  return max2f(__uint_as_float(rr[0]),__uint_as_float(rr[1]));
}
__device__ __forceinline__ void pv(f32x16*o,int vb,bf16x8 pa0,bf16x8 pa1,bf16x8 pa2,bf16x8 pa3){
  #pragma unroll
  for(int d0=0;d0<2;++d0){s16x4 lo[4],hi[4];
    #pragma unroll
    for(int ks=0;ks<4;++ks){
      asm volatile("ds_read_b64_tr_b16 %0,%1 offset:%c2":"=&v"(lo[ks]):"v"(vb),"i"(d0*4096+ks*1024):"memory");
      asm volatile("ds_read_b64_tr_b16 %0,%1 offset:%c2":"=&v"(hi[ks]):"v"(vb),"i"(d0*4096+ks*1024+512):"memory");}
    asm volatile("s_waitcnt lgkmcnt(0)":::"memory");SBAR();
    #define PK(k) (bf16x8){lo[k][0],lo[k][1],lo[k][2],lo[k][3],hi[k][0],hi[k][1],hi[k][2],hi[k][3]}
    o[d0]=__builtin_amdgcn_mfma_f32_32x32x16_bf16(pa0,PK(0),o[d0],0,0,0);
    o[d0]=__builtin_amdgcn_mfma_f32_32x32x16_bf16(pa1,PK(1),o[d0],0,0,0);
    o[d0]=__builtin_amdgcn_mfma_f32_32x32x16_bf16(pa2,PK(2),o[d0],0,0,0);
    o[d0]=__builtin_amdgcn_mfma_f32_32x32x16_bf16(pa3,PK(3),o[d0],0,0,0);
    #undef PK
  }
}

#ifndef ATTN_STORE16
#define ATTN_STORE16(p,v) (*(u32x4*)(p)=(v))
#endif
struct ConvSide { const bf16* Z; bf16* B; int row0; };
template<int THRL,bool SIDE> __device__ __forceinline__ void attn_unit(int b,int h,int qb,const bf16*Q,const bf16*__restrict__ K,const bf16*__restrict__ V,bf16*O,const u32x2_t*__restrict__ REC,char*shm,const ConvSide&cs,int ci){
  int tid_=threadIdx.x; asm volatile("":"+v"(tid_)); const int tid=tid_,lane=tid&63,r32=lane&31,hi=lane>>5; const int wid=__builtin_amdgcn_readfirstlane(tid>>6);
  const long rowbase=(long)b*SEQ; const int q0=qb*QB;
  const bf16*Qw=Q+(rowbase+q0+wid*QBLK)*DM+h*D;
  const bf16*Kh=K+rowbase*DM+h*D,*Vh=V+rowbase*DM+h*D;
  const unsigned lds0=(unsigned)(uintptr_t)shm;
  float*wsf=(float*)(shm+LDS_WS)+wid*64;
  const bf16*ksrc=Kh+(long)lane*DM+wid*8;
  const bf16*vsrc=Vh+(long)(16*(wid&3)+(lane>>2))*DM+(wid>>2)*32+(lane&3)*8;
  const unsigned kdst=lds0+LDS_K+wid*1024, vdst=lds0+LDS_V+wid*1024;
  #define DMA_K(t,slot) glds16(ksrc+(long)(t)*KVBLK*DM,(unsigned)__builtin_amdgcn_readfirstlane(kdst+(slot)))
  #define DMA_V(t,slot) glds16(vsrc+(long)(t)*KVBLK*DM,(unsigned)__builtin_amdgcn_readfirstlane(vdst+(slot)))
  const int vb0=(int)(lds0+LDS_V)+((lane>>4)&1)*32+(lane&3)*8+(4*hi+((lane&15)>>2))*64;
  const char*Kbase=shm+LDS_K; bf16x8 kf[8];
  const lds_cptr shm3=(lds_cptr)shm; const lds_cptr kp0=shm3+LDS_K+hi*1024+r32*16; const lds_cptr vp0=shm3+LDS_V+((lane>>4)&1)*32+(lane&3)*8+(4*hi+((lane&15)>>2))*64;
  const int NT=(q0+QB)/KVBLK;
  const u32x2_t*RECh=REC+(long)(b*NHEAD+h)*SEQ; const int nkeys=q0+QB; const int rk=2*tid;
  u32x4 rv0=u32x4{},rv1=u32x4{};
  if(rk<nkeys)rv0=*reinterpret_cast<const u32x4*>(RECh+rk);
  if(rk+1024<nkeys)rv1=*reinterpret_cast<const u32x4*>(RECh+rk+1024);
  const lds_cptr recp=(lds_cptr)shm+LDS_REC+r32*8;
  DMA_K(0,0);DMA_V(0,0);DMA_K(1,SLOTB);
  bf16x8 qr[4];
  #pragma unroll
  for(int d0=0;d0<4;++d0)qr[d0]=*reinterpret_cast<const bf16x8*>(&Qw[(long)r32*DM+d0*16+hi*8]);
  float l_reg=0.f;f32x16 o[2];o[0]=f32x16{};o[1]=f32x16{};
  { __attribute__((address_space(3))) u32x4*rl=(__attribute__((address_space(3))) u32x4*)((lds_cptr)shm+LDS_REC);
    if(rk<nkeys)rl[tid]=rv0; if(rk+1024<nkeys)rl[tid+512]=rv1; }
  u32x4 bq;
  u32x2_t rcA,rcB;
  #define RECLD(t_) do{ rcA=*(const __attribute__((address_space(3))) u32x2_t*)(recp+(t_)*512); rcB=*(const __attribute__((address_space(3))) u32x2_t*)(recp+(t_)*512+256); }while(0)
  const int qrel=wid*QBLK+r32;
  #define CMASK(P0,P1,t) do{int jb_=(t)-(NT-4); if(jb_>=0)cmask(P0,P1,jb_,qrel,hi);}while(0)
  #define START(P0,P1) do{ _Pragma("unroll") for(int r=0;r<16;++r)P0[r]=__builtin_amdgcn_exp2f(P0[r]); }while(0)
  #define RESC() do{}while(0)
  f32x16 pA0,pA1,pB0,pB1;
  int sl_prev=0,sl_cur=0,sl_next=SLOTB;
  #define ROT() do{sl_prev=sl_cur;sl_cur=sl_next;sl_next=(sl_next==(NSLOT-1)*SLOTB)?0:sl_next+SLOTB;}while(0)
  if constexpr(SIDE) asm volatile(""::"v"(qr[0]),"v"(qr[1]),"v"(qr[2]),"v"(qr[3]));
  DMA_K(2,2*SLOTB);
  if constexpr(SIDE){
    const int r0=16*ci+2*wid; const char*zg=(const char*)cs.Z+((long)cs.row0+r0)*2048+lane*16; const char*bg=(const char*)cs.B+((long)cs.row0+r0)*2048+lane*16;
    #pragma unroll
    for(int rr=0;rr<2;++rr){ const int slot=(r0+rr)%ZR_ROWS;
      #pragma unroll
      for(int hf=0;hf<2;++hf){ glds16(zg+rr*2048+hf*1024,(unsigned)__builtin_amdgcn_readfirstlane(lds0+LDS_ZR+slot*2048+hf*1024)); glds16(bg+rr*2048+hf*1024,(unsigned)__builtin_amdgcn_readfirstlane(lds0+LDS_OST+wid*4096+rr*2048+hf*1024)); } }
    WAIT_BAR(9);
  } else
  WAIT_BAR(3);
  { const u32x2_t rq=*(const __attribute__((address_space(3))) u32x2_t*)((lds_cptr)shm+LDS_REC+(q0+qrel)*8);
    const unsigned n1=(rq.x&0xffffu)^0x8000u, n2=(rq.x>>16)^0x8000u, n3=(rq.y&0xffffu)^0x8000u;
    bq.x=hi?0u:0x3f803f80u; bq.y=hi?0u:(0x3f80u|(n1<<16)); bq.z=hi?0u:(n2|(n3<<16)); bq.w=0u; }
  RECLD(0);
  qkt(pA0,pA1,Kbase,qr,ABF(rcA),ABF(rcB),__builtin_bit_cast(bf16x8,bq),r32,hi);asm volatile("s_nop 15\n\ts_nop 7":"+v"(pA0),"+v"(pA1));CMASK(pA0,pA1,0);
  START(pA0,pA1);
  _Pragma("unroll") for(int r=0;r<16;++r)pA1[r]=__builtin_amdgcn_exp2f(pA1[r]);
  if constexpr(SIDE){ WAIT_BAR(8); } else
  WAIT_BAR(0);
  DMA_K(3,0);DMA_V(1,SLOTB);
  ROT();
  kload8(kf,kp0+sl_cur);
  RECLD(1);
  if constexpr(SIDE){ WAIT_BAR(10); } else
  WAIT_BAR(2);
  s16x4 vlo[8],vhi[8]; u32x4 pw0,pw1,pw2,pw3;
  #define PKW(P,B) cvtpk_s(P[B],P[B+1])
  #define PAF(k) __builtin_bit_cast(bf16x8,pw##k)
  #define VFR(i) (bf16x8){vlo[i][0],vlo[i][1],vlo[i][2],vlo[i][3],vhi[i][0],vhi[i][1],vhi[i][2],vhi[i][3]}
  #define PIN(x) asm volatile("":"+v"(x))
  #define MX3(a,b,c) __builtin_fmaxf(__builtin_fmaxf((a),(b)),(c))
  #define GAPA(MF,A0,A1,A2,A3,W0,W1,PW) do{ MF; sacc+=A0; sacc+=A1; sacc+=A2; sacc+=A3; PIN(sacc); W0; W1; PIN(PW); SBAR(); }while(0)
  #define EX(v) __builtin_amdgcn_exp2f(v)
  #define GAPB(MF,X,B) do{ MF; X[B]=EX(X[B]); X[B+1]=EX(X[B+1]); X[B+2]=EX(X[B+2]); X[B+3]=EX(X[B+3]); PIN(X); SBAR(); }while(0)
  #define VRD(i) do{ vlo[i]=vtr(vp_+(((i)>>2)*4096+((i)&3)*1024)); vhi[i]=vtr(vp_+(((i)>>2)*4096+((i)&3)*1024+512)); }while(0)
  #define KRD(G,j) do{ if(G){ kload2(kf,kp0+sl_next,j); SBAR(); } }while(0)
  #define STEP(C0,C1,P0,P1,t,GK,GV,GL) do{ SBAR(); \
    const lds_cptr vp_=vp0+sl_prev; \
    VRD(0); SBAR(); float sacc=(P0[0]+P0[1]); \
    C0=__builtin_amdgcn_mfma_f32_32x32x16_bf16(ABF(rcA),__builtin_bit_cast(bf16x8,bq),f32x16{},0,0,0); C1=__builtin_amdgcn_mfma_f32_32x32x16_bf16(ABF(rcB),__builtin_bit_cast(bf16x8,bq),f32x16{},0,0,0); SBAR(); \
    GAPA(C0=__builtin_amdgcn_mfma_f32_32x32x16_bf16(kf[0],qr[0],C0,0,0,0), P0[2],P0[3],P0[4],P0[5],     pw0[0]=PKW(P0,0), pw0[1]=PKW(P0,2), pw0); \
    VRD(4); SBAR(); GAPA(C1=__builtin_amdgcn_mfma_f32_32x32x16_bf16(kf[1],qr[0],C1,0,0,0), P0[6],P0[7],P0[8],P0[9],     pw0[2]=PKW(P0,4), pw0[3]=PKW(P0,6), pw0); \
    VRD(1); SBAR(); GAPA(C0=__builtin_amdgcn_mfma_f32_32x32x16_bf16(kf[2],qr[1],C0,0,0,0),   P0[10],P0[11],P0[12],P0[13], pw1[0]=PKW(P0,8), pw1[1]=PKW(P0,10), pw1); \
    VRD(5); SBAR(); GAPA(C1=__builtin_amdgcn_mfma_f32_32x32x16_bf16(kf[3],qr[1],C1,0,0,0),   P0[14],P0[15],P1[0],P1[1],   pw1[2]=PKW(P0,12),pw1[3]=PKW(P0,14), pw1); \
    VRD(2); SBAR(); GAPA(C0=__builtin_amdgcn_mfma_f32_32x32x16_bf16(kf[4],qr[2],C0,0,0,0),   P1[2],P1[3],P1[4],P1[5],     pw2[0]=PKW(P1,0), pw2[1]=PKW(P1,2), pw2); \
    VRD(6); SBAR(); GAPA(C1=__builtin_amdgcn_mfma_f32_32x32x16_bf16(kf[5],qr[2],C1,0,0,0),   P1[6],P1[7],P1[8],P1[9],     pw2[2]=PKW(P1,4), pw2[3]=PKW(P1,6), pw2); \
    VRD(3); SBAR(); GAPA(C0=__builtin_amdgcn_mfma_f32_32x32x16_bf16(kf[6],qr[3],C0,0,0,0),   P1[10],P1[11],P1[12],P1[13], pw3[0]=PKW(P1,8), pw3[1]=PKW(P1,10), pw3); \
    VRD(7); SBAR(); GAPA(C1=__builtin_amdgcn_mfma_f32_32x32x16_bf16(kf[7],qr[3],C1,0,0,0),   P1[14],P1[15],0.f,0.f,       pw3[2]=PKW(P1,12),pw3[3]=PKW(P1,14), pw3); \
    l_reg+=sacc; \
    if(GK){DMA_K((t)+3,sl_cur);} if(GV){DMA_V((t)+1,sl_next);} \
    CMASK(C0,C1,t); \
    SBAR(); \
    GAPB(o[0]=__builtin_amdgcn_mfma_f32_32x32x16_bf16(PAF(0),VFR(0),o[0],0,0,0), C0,0); \
    GAPB(o[1]=__builtin_amdgcn_mfma_f32_32x32x16_bf16(PAF(0),VFR(4),o[1],0,0,0), C0,4); \
    if(GL){ RECLD((t)+1); SBAR(); } \
    KRD(GL,0); GAPB(o[0]=__builtin_amdgcn_mfma_f32_32x32x16_bf16(PAF(1),VFR(1),o[0],0,0,0), C0,8); \
    KRD(GL,1); GAPB(o[1]=__builtin_amdgcn_mfma_f32_32x32x16_bf16(PAF(1),VFR(5),o[1],0,0,0), C0,12); \
    KRD(GL,2); GAPB(o[0]=__builtin_amdgcn_mfma_f32_32x32x16_bf16(PAF(2),VFR(2),o[0],0,0,0), C1,0); \
    KRD(GL,3); GAPB(o[1]=__builtin_amdgcn_mfma_f32_32x32x16_bf16(PAF(2),VFR(6),o[1],0,0,0), C1,4); \
    GAPB(o[0]=__builtin_amdgcn_mfma_f32_32x32x16_bf16(PAF(3),VFR(3),o[0],0,0,0), C1,8); \
    GAPB(o[1]=__builtin_amdgcn_mfma_f32_32x32x16_bf16(PAF(3),VFR(7),o[1],0,0,0), C1,12); \
    }while(0)
  int t=1;
  #undef CMASK
  #define CMASK(P0,P1,t) do{}while(0)
  for(;t+5<NT;t+=2){
    STEP(pB0,pB1,pA0,pA1,t,true,true,true);     WAIT_BAR(2); RESC(); ROT();
    STEP(pA0,pA1,pB0,pB1,t+1,true,true,true);   WAIT_BAR(2); RESC(); ROT();
  }
  #undef CMASK
  #define CMASK(P0,P1,t) do{int jb_=(t)-(NT-4); if(jb_>=0)cmask(P0,P1,jb_,qrel,hi);}while(0)
  #define ENDW(tt) do{ if((tt)+3<NT){WAIT_BAR(2);} else if((tt)+2<NT){WAIT_BAR(1);} else {WAIT_BAR(0);} }while(0)
  for(;t+1<NT;t+=2){
    STEP(pB0,pB1,pA0,pA1,t,(t+3<NT),(t+1<NT),(t+1<NT));       ENDW(t);   RESC(); ROT();
    STEP(pA0,pA1,pB0,pB1,t+1,(t+4<NT),(t+2<NT),(t+2<NT));     ENDW(t+1); RESC(); ROT();
  }
  STEP(pB0,pB1,pA0,pA1,NT-1,false,false,false); RESC();
  { float sacc=pB0[0]+pB0[1]; _Pragma("unroll") for(int r=2;r<16;++r)sacc+=pB0[r]; _Pragma("unroll") for(int r=0;r<16;++r)sacc+=pB1[r]; l_reg+=sacc;
    pw0=(u32x4){PKW(pB0,0),PKW(pB0,2),PKW(pB0,4),PKW(pB0,6)};pw1=(u32x4){PKW(pB0,8),PKW(pB0,10),PKW(pB0,12),PKW(pB0,14)};pw2=(u32x4){PKW(pB1,0),PKW(pB1,2),PKW(pB1,4),PKW(pB1,6)};pw3=(u32x4){PKW(pB1,8),PKW(pB1,10),PKW(pB1,12),PKW(pB1,14)};
    SBAR(); pv(o,vb0+sl_cur,PAF(0),PAF(1),PAF(2),PAF(3)); }
  #undef PKW
  #undef PAF
  #undef VFR
  #undef PIN
  #undef MX3
  #undef GAPA
  #undef GAPB
  #undef EX
  #undef VRD
  #undef KRD
  #undef STEP
  #undef ENDW
  if constexpr(SIDE){
    const int cg=tid&127,rq=wid>>1; const lds_cptr zr=(lds_cptr)shm+LDS_ZR+cg*16, br=(lds_cptr)shm+LDS_OST+(4*rq)*2048+cg*16, cw=(lds_cptr)shm+LDS_CW+cg*32;
    typedef __attribute__((address_space(3))) const u32x4* lq_t; typedef __attribute__((address_space(3))) const f32x4_t* lf_t;
    int sl=(16*ci+4*rq+ZR_ROWS-2)%ZR_ROWS; u32x4 zz[6],bb[4];
    #pragma unroll
    for(int k=0;k<6;++k){ zz[k]=*(lq_t)(zr+sl*2048); sl=(sl+1==ZR_ROWS)?0:sl+1; }
    #pragma unroll
    for(int k=0;k<4;++k)bb[k]=*(lq_t)(br+k*2048);
    f32x4_t w[4][2];
    #pragma unroll
    for(int p_=0;p_<4;++p_){ w[p_][0]=*(lf_t)(cw+p_*4096); w[p_][1]=*(lf_t)(cw+p_*4096+16); }
    bf16*yb=cs.B+((long)cs.row0+16*ci+4*rq)*DM+cg*8;
    #define UP2(x) ((f32x2_t){__uint_as_float((x)<<16),__uint_as_float((x)&0xffff0000u)})
    #define W2(p_,n_,h_) __builtin_shufflevector(w[p_][n_],w[p_][n_],2*(h_),2*(h_)+1)
    #pragma unroll
    for(int k=0;k<4;++k){ const u32x4 z2=zz[k],z1=zz[k+1],z0=zz[k+2],bv=bb[k]; u32x4 y;
      #define CV(n_,h_,ZW) ({ const f32x2_t r_=UP2(bv.ZW)*(W2(3,n_,h_)+W2(0,n_,h_)*UP2(z2.ZW)+W2(1,n_,h_)*UP2(z1.ZW)+W2(2,n_,h_)*UP2(z0.ZW)); cvtpk_s(r_.x,r_.y); })
      y.x=CV(0,0,x); y.y=CV(0,1,y); y.z=CV(1,0,z); y.w=CV(1,1,w);
      #undef CV
      *(u32x4*)(yb+(long)k*DM)=y; }
    #undef UP2
    #undef W2
    asm volatile("s_waitcnt lgkmcnt(0)\n\ts_barrier":::"memory");
  }
  {auto rr=__builtin_amdgcn_permlane32_swap(__float_as_uint(l_reg),__float_as_uint(l_reg),false,false);l_reg=__uint_as_float(rr[0])+__uint_as_float(rr[1]);}
  if(hi==0)wsf[32+r32]=l_reg;asm volatile("s_waitcnt lgkmcnt(0)":::"memory");
  float rli[16];
  #pragma unroll
  for(int r=0;r<16;++r)rli[r]=__builtin_amdgcn_rcpf(wsf[32+crow(r,hi)]);
  bf16*Ow=O+(rowbase+q0+wid*QBLK)*DM+h*D;
  { bf16*stg=(bf16*)(shm+LDS_OST)+wid*2048;
    #pragma unroll
    for(int r=0;r<16;++r){const int orow=crow(r,hi);
      #pragma unroll
      for(int d0=0;d0<2;++d0)stg[orow*64+d0*32+r32]=__float2bfloat16(o[d0][r]*rli[r]);}
    asm volatile("s_waitcnt lgkmcnt(0)":::"memory");
    #pragma unroll
    for(int i=0;i<4;++i){const int row=i*8+(lane>>3),ch=lane&7; const u32x4 v=*(const u32x4*)(stg+row*64+ch*8); ATTN_STORE16(Ow+(long)row*DM+ch*8,v);} }
  asm volatile("s_waitcnt lgkmcnt(0)\n\ts_barrier":::"memory");
  #undef DMA_K
  #undef DMA_V
  #undef RECLD
  #undef CMASK
  #undef START
  #undef RESC
  #undef ROT
}
constexpr int ATTN_LDS_BYTES=LDS_SIDE_END;
struct AttnTensors { const bf16* Q; const bf16* K; const bf16* V; bf16* O; const u32x2_t* REC; };
struct AttnUnit { int bh; int qb; };
struct StaticOrder {
  int vcu,ngrp;
  __device__ __forceinline__ explicit StaticOrder(int grid,int block):vcu((grid%8==0)?(block%8)*(grid/8)+block/8:block),ngrp(grid/8){}
  __device__ __forceinline__ bool next(int i,AttnUnit&u)const{ const int per=(BATCH*NHEAD+ngrp-1)/ngrp; if(i>=per)return false; const int s=vcu&7,g=vcu>>3; u.bh=g*per+i; if(u.bh>=BATCH*NHEAD)return false; u.qb=(i&1)?7-s:s; return true; }
  __device__ __forceinline__ void a_ready(const AttnUnit&)const{}
  __device__ __forceinline__ void done(const AttnUnit&)const{}
};
template<class Sched,int THRL=8,bool SIDE=false> __device__ __forceinline__ void attn_phase(char*lds,const AttnTensors&T,const Sched&S,const ConvSide&cs=ConvSide{nullptr,nullptr,0}){
  AttnUnit u;
  for(int i=0;S.next(i,u);++i){ S.a_ready(u); attn_unit<THRL,SIDE>(u.bh/NHEAD,u.bh%NHEAD,u.qb,T.Q,T.K,T.V,T.O,T.REC,lds,cs,i); S.done(u); }
}
#undef SBAR
#undef WAIT_BAR
}
#define GAS __attribute__((address_space(1)))
#define LAS __attribute__((address_space(3)))
typedef unsigned short bf16;
typedef unsigned v4u __attribute__((ext_vector_type(4)));
typedef float f32x4 __attribute__((ext_vector_type(4)));
typedef short bf16x8 __attribute__((ext_vector_type(8)));
typedef GAS unsigned gu32;
typedef GAS unsigned long long gu64;
#define RLX_AGENT __ATOMIC_RELAXED, __HIP_MEMORY_SCOPE_AGENT
#define LDS_WAIT() asm volatile("s_waitcnt lgkmcnt(0)" ::: "memory")
#define VM_WAIT() asm volatile("s_waitcnt vmcnt(0)" ::: "memory")
__device__ __forceinline__ unsigned long long rt() { return __builtin_amdgcn_s_memrealtime(); }
__device__ __forceinline__ unsigned f2bf(float f) { unsigned u = __builtin_bit_cast(unsigned, f); return (u + 0x7fffu + ((u >> 16) & 1u)) >> 16; }
__device__ __forceinline__ unsigned pk2(float lo, float hi) { return f2bf(lo) | (f2bf(hi) << 16); }

#define XB_TMO      128
#define XB_XCNT(j)  (256  + 64 * (j))
#define XB_XSUB(j)  (1280 + 64 * (j))
#define XB_XGEN(j)  (2304 + 64 * (j))
#define XB_TOP      3328
#define XB_TOPGEN   3392
#define XCD_BAR_WORDS 3456
#define XB_SPIN_CAP (1u << 18)

__device__ __forceinline__ unsigned xb_ld(unsigned* p)              { return __hip_atomic_load(p, __ATOMIC_RELAXED, __HIP_MEMORY_SCOPE_AGENT); }
__device__ __forceinline__ unsigned xb_add(unsigned* p, unsigned v) { return __hip_atomic_fetch_add(p, v, __ATOMIC_RELAXED, __HIP_MEMORY_SCOPE_AGENT); }
__device__ __forceinline__ unsigned xb_xcc_id() { return (unsigned)__builtin_amdgcn_s_getreg((3 << 11) | 20) & 0xFu; }
#define XB_SPIN(cond, bar) do { unsigned _sp = 0; while (cond) { __builtin_amdgcn_s_sleep(1); \
    if ((++_sp & 255u) == 0u) { if (xb_ld(&(bar)[XB_TMO])) break; if (_sp > XB_SPIN_CAP) { atomicAdd(&(bar)[XB_TMO], 1u); break; } } } } while (0)

struct XcdBarrier {
    unsigned* bar; unsigned x;
    volatile LAS unsigned* st;
};

__device__ __forceinline__ XcdBarrier xcd_barrier_post(unsigned* bar, volatile LAS unsigned* st) {
    XcdBarrier b; b.bar = bar; b.x = xb_xcc_id(); b.st = st;
    if (threadIdx.x == 0) (void)xb_add(&bar[XB_XCNT(b.x)], 1u);
    return b;
}
__device__ __forceinline__ void xcd_barrier_complete(unsigned* bar, unsigned x, unsigned& nloc, unsigned& nx) {
    const unsigned G = gridDim.x * gridDim.y * gridDim.z;
    unsigned sum, cnt, mine, sp = 0u;
    for (;;) {
        sum = 0u; cnt = 0u; mine = 0u;
#pragma unroll
        for (unsigned j = 0; j < 16; ++j) { const unsigned c = xb_ld(&bar[XB_XCNT(j)]); sum += c; cnt += (c > 0u) ? 1u : 0u; mine = (j == x) ? c : mine; }
        if (sum == G) break;
        __builtin_amdgcn_s_sleep(1);
        if ((++sp & 255u) == 0u) { if (xb_ld(&bar[XB_TMO])) break; if (sp > XB_SPIN_CAP) { atomicAdd(&bar[XB_TMO], 1u); break; } }
    }
    nloc = mine > 0u ? mine : 1u; nx = cnt > 0u ? cnt : 1u;
}

__device__ __forceinline__ void xcd_barrier(const XcdBarrier& b) {
    asm volatile("s_waitcnt vmcnt(0)" ::: "memory");
    __syncthreads();
    if (threadIdx.x == 0) {
        unsigned* bar = b.bar;
        __builtin_amdgcn_s_waitcnt(0);
        unsigned nloc = b.st[0], nx = b.st[1];
        if (nloc == 0u) { xcd_barrier_complete(bar, b.x, nloc, nx); b.st[0] = nloc; b.st[1] = nx; }
        const unsigned old = xb_add(&bar[XB_XSUB(b.x)], 1u);
        const unsigned gen = old / nloc;
        if (old + 1u == (gen + 1u) * nloc) {
            __builtin_amdgcn_fence(__ATOMIC_RELEASE, "agent");
            asm volatile("s_waitcnt vmcnt(0)" ::: "memory");
            const unsigned og = xb_add(&bar[XB_TOP], 1u);
            const unsigned tg = og / nx;
            if (og + 1u == (tg + 1u) * nx) xb_add(&bar[XB_TOPGEN], 1u);
            else XB_SPIN(xb_ld(&bar[XB_TOPGEN]) == tg, bar);
            __builtin_amdgcn_fence(__ATOMIC_ACQUIRE, "agent");
            xb_add(&bar[XB_XGEN(b.x)], 1u);
            asm volatile("s_waitcnt vmcnt(0)" ::: "memory");
        } else {
            XB_SPIN(xb_ld(&bar[XB_XGEN(b.x)]) == gen, bar);
            __builtin_amdgcn_fence(__ATOMIC_ACQUIRE, "agent");
            asm volatile("s_waitcnt vmcnt(0)" ::: "memory");
        }
    }
    __syncthreads();
}

constexpr int NWAVES = 8;
constexpr int NB = 32, SEQ = 2048, D = 1024, NH = 16, T = NB * SEQ;
constexpr int NPROJ = 8192, LDW_IN = 8208, FCOL0 = 6144;
constexpr int NEXP = 32, DE = 512, NLOG = 36, LCAP = 65536;
constexpr float RMS_EPS = 1e-6f, LOG2E = 1.4426950408889634f;
constexpr size_t MiB = 1u << 20;
constexpr size_t WS_CTL = 0, CTL_ZERO_BYTES = 64 * 1024;
constexpr size_t WS_FLOG = 1 * MiB;
constexpr size_t WS_REC = 5 * MiB;
constexpr size_t WS_LIST = 13 * MiB;
constexpr size_t WS_LWT = 21 * MiB;
constexpr size_t WS_WRT = 29 * MiB;
constexpr size_t WS_SLOTOF = 12 * MiB;
constexpr size_t WS_RSTD = 11 * MiB;
constexpr size_t WS_WIN = 32 * MiB;
constexpr size_t WS_WC = 48 * MiB, WS_WA = 50 * MiB, WS_WO = 52 * MiB;
constexpr size_t WS_WE1 = 56 * MiB;
constexpr size_t WS_WE2 = 120 * MiB;
constexpr size_t WS_XN = 160 * MiB;
constexpr size_t WS_B = 288 * MiB;
constexpr size_t WS_Z = 416 * MiB;
constexpr size_t WS_Q = 544 * MiB;
constexpr size_t WS_K = 672 * MiB, WS_V = 800 * MiB;
static_assert(WS_V - WS_K == WS_K - WS_Q, "EpiProj: q, k, v equally spaced");
constexpr size_t WS_RINV = 928 * MiB;
constexpr size_t WS_DUMP = 928 * MiB;
constexpr size_t WS_END = 930 * MiB;
constexpr int CW_BAR = 4096;
constexpr int CW_CNT = 8192;
static_assert((CW_CNT + 64 * NEXP) * 4 <= (int)CTL_ZERO_BYTES, "CTL words inside the memset region");
constexpr int RING_OFF = 0, RING_BYTES = 131072;
constexpr int TAB_OFF = 131072;
constexpr int TAB_CNT = TAB_OFF, TAB_TSTART = TAB_OFF + 128, TAB_RSTART = TAB_OFF + 384, TAB_DESC = TAB_OFF + 640, TAB_IDX = TAB_OFF + 1024, TAB_WT = TAB_IDX + pg8::MOE_SLOTS * 1024, TAB_RS = TAB_WT + pg8::MOE_SLOTS * 1024, TAB_END = TAB_RS + pg8::MOE_SLOTS * 1024;
constexpr int P5_LCNT = 0, P5_LBASE = 128, P5_END = 256;
constexpr int LDS_BYTES = 163840, LDSCTL_OFF = LDS_BYTES - 1024;
static_assert(TAB_END <= LDSCTL_OFF && P5_END <= LDSCTL_OFF && attn_body::ATTN_LDS_BYTES <= LDSCTL_OFF, "LDS map");

typedef unsigned u32x2 __attribute__((ext_vector_type(2)));
typedef int i32x4 __attribute__((ext_vector_type(4)));

__device__ __forceinline__ float wave_sum(float v) {
#pragma unroll
    for (int o = 1; o < 64; o <<= 1) v += __shfl_xor(v, o);
    return v;
}
__device__ __forceinline__ float dpp_row_shr(float v, int n) {
    const int iv = __builtin_bit_cast(int, v); int r;
    switch (n) { case 1: r = __builtin_amdgcn_update_dpp(0, iv, 0x111, 0xf, 0xf, true); break; case 2: r = __builtin_amdgcn_update_dpp(0, iv, 0x112, 0xf, 0xf, true); break;
                 case 4: r = __builtin_amdgcn_update_dpp(0, iv, 0x114, 0xf, 0xf, true); break; default: r = __builtin_amdgcn_update_dpp(0, iv, 0x118, 0xf, 0xf, true); break; }
    return __builtin_bit_cast(float, r);
}
__device__ __forceinline__ float wave_total(float v) {
    v += dpp_row_shr(v, 1); v += dpp_row_shr(v, 2); v += dpp_row_shr(v, 4); v += dpp_row_shr(v, 8);
    v += __builtin_bit_cast(float, __builtin_amdgcn_update_dpp(0, __builtin_bit_cast(int, v), 0x142, 0xa, 0xf, false));
    v += __builtin_bit_cast(float, __builtin_amdgcn_update_dpp(0, __builtin_bit_cast(int, v), 0x143, 0xc, 0xf, false));
    return __builtin_bit_cast(float, __builtin_amdgcn_readlane(__builtin_bit_cast(int, v), 63));
}
__device__ __forceinline__ float dot4(const f32x4 a, const f32x4 b) { return (a.x * b.x + a.y * b.y) + (a.z * b.z + a.w * b.w); }

#ifndef PH_MASK
#define PH_MASK 0x1ff
#endif
#define PH(k) (((PH_MASK) >> (k)) & 1)
#ifndef DBL_MASK
#define DBL_MASK 0
#endif
#define NREP(k) ((((DBL_MASK) >> (k)) & 1) ? 2 : 1)
typedef float f32x2 __attribute__((ext_vector_type(2)));
__device__ __forceinline__ float dpp_quad(float v, const int ctrl_is_b1) {
    const int iv = __builtin_bit_cast(int, v);
    return __builtin_bit_cast(float, ctrl_is_b1 ? __builtin_amdgcn_update_dpp(0, iv, 0x4E, 0xf, 0xf, false) : __builtin_amdgcn_update_dpp(0, iv, 0xB1, 0xf, 0xf, false));
}
__device__ __forceinline__ void reduce4_store(const float (&p)[4], int lane, float* dq, int e) {
    const bool b0 = (lane & 1) != 0, b1 = (lane & 2) != 0;
    float a = b0 ? p[1] : p[0]; const float sa = b0 ? p[0] : p[1]; a += dpp_quad(sa, 0);
    float c = b0 ? p[3] : p[2]; const float sc = b0 ? p[2] : p[3]; c += dpp_quad(sc, 0);
    float t = b1 ? c : a; const float st = b1 ? a : c; t += dpp_quad(st, 1);
    t += dpp_row_shr(t, 4); t += dpp_row_shr(t, 8);
    t += __builtin_bit_cast(float, __builtin_amdgcn_ds_swizzle(__builtin_bit_cast(int, t), 0x401F));
    { auto rr = __builtin_amdgcn_permlane32_swap(__float_as_uint(t), __float_as_uint(t), false, false); t = __uint_as_float(rr[0]) + __uint_as_float(rr[1]); }
    if ((lane & 60) == 12) dq[e] = t;
}
template <int NL> __device__ __forceinline__ void row_logits4(const f32x4 (&v)[4][4], const LAS f32x4* W4, int lane, float* dq) {
    f32x4 wa[4], wb[4];
#pragma unroll
    for (int j = 0; j < 4; ++j) wa[j] = W4[64 * j + lane];
#define RL4_DOT(w_) float p[4]; { f32x2 acc[4]; _Pragma("unroll") for (int r = 0; r < 4; ++r) acc[r] = (f32x2){0.f, 0.f}; \
        _Pragma("unroll") for (int j = 0; j < 4; ++j) { const f32x2 wlo = __builtin_shufflevector(w_[j], w_[j], 0, 1), whi = __builtin_shufflevector(w_[j], w_[j], 2, 3); \
            _Pragma("unroll") for (int r = 0; r < 4; ++r) acc[r] += __builtin_shufflevector(v[r][j], v[r][j], 0, 1) * wlo; \
            _Pragma("unroll") for (int r = 0; r < 4; ++r) acc[r] += __builtin_shufflevector(v[r][j], v[r][j], 2, 3) * whi; } \
        _Pragma("unroll") for (int r = 0; r < 4; ++r) p[r] = acc[r].x + acc[r].y; }
#pragma unroll 1
    for (int e = 0; e < NL; e += 2) {
#pragma unroll
        for (int j = 0; j < 4; ++j) wb[j] = W4[(e + 1) * 256 + 64 * j + lane];
        { RL4_DOT(wa); reduce4_store(p, lane, dq, e); }
        if (e + 2 < NL) {
#pragma unroll
            for (int j = 0; j < 4; ++j) wa[j] = W4[(e + 2) * 256 + 64 * j + lane]; }
        { RL4_DOT(wb); reduce4_store(p, lane, dq, e + 1); }
    }
#undef RL4_DOT
}
struct Args { const float* in[16]; float* out; unsigned char* ws; };

__device__ __forceinline__ void p0_transpose_item(const float* W, int ldw, int k0, int src_n0, bf16* WT, int ldk, int dst_row0, LAS float* scr, int lane) {
#pragma unroll
    for (int i = 0; i < 32; ++i) { const int kk = 2 * i + (lane >> 5); scr[kk * 33 + (lane & 31)] = W[(size_t)(k0 + kk) * ldw + src_n0 + (lane & 31)]; }
    LDS_WAIT(); asm volatile("" ::: "memory");
    const int c = lane & 7;
#pragma unroll
    for (int j = 0; j < 4; ++j) { const int n = (lane >> 3) + 8 * j; const LAS float* s = scr + (8 * c) * 33 + n;
        v4u o; o.x = pk2(s[0 * 33], s[1 * 33]); o.y = pk2(s[2 * 33], s[3 * 33]); o.z = pk2(s[4 * 33], s[5 * 33]); o.w = pk2(s[6 * 33], s[7 * 33]);
        *(GAS v4u*)(WT + (size_t)(dst_row0 + n) * ldk + k0 + 8 * c) = o; }
    LDS_WAIT(); asm volatile("" ::: "memory");
}
__device__ __forceinline__ int proj_src_col(int d) {
    if (d < 2048) { const int pn = d >> 8, y = d & 255, wcc = y >> 6, hb = (y >> 5) & 1, x = y & 31; return (hb ? 2048 : 1024) + 128 * pn + 32 * wcc + x; }
    if (d < 3072) return d - 2048;
    if (d < 6144) return d;
    return d + 16;
}

constexpr int I_IN = 16 * 256, I_SQ = 16 * 32, I_E1 = NEXP * 512, I_E2 = NEXP * 256, NITEMS = I_IN + 3 * I_SQ, NITEMS_E = I_E1 + I_E2;

__global__ void __launch_bounds__(NWAVES * 64, 2) fox_moe_fwd(Args args) {
    extern __shared__ __attribute__((aligned(16))) unsigned char lds[];
    LAS unsigned char* const L = (LAS unsigned char*)lds;
    const int tid0 = threadIdx.x, wave = __builtin_amdgcn_readfirstlane(tid0 >> 6);
#define PHASE_IDS() int tid_ = threadIdx.x; asm volatile("" : "+v"(tid_)); const int tid = tid_, lane = tid & 63; (void)lane
    const int G = gridDim.x, bx = blockIdx.x;
    const int vcu = (G % 8 == 0) ? (bx % 8) * (G / 8) + bx / 8 : bx;
    const int gw = vcu * NWAVES + wave, NGW = G * NWAVES;
    typedef __attribute__((address_space(4))) const unsigned char* kargp_t;
    kargp_t kp = (kargp_t)__builtin_amdgcn_kernarg_segment_ptr();
#define KP_PHASE() asm volatile("" : "+s"(kp))
#ifndef P1_WGM
#define P1_WGM 4
#endif
#ifndef P3_WGM
#define P3_WGM 8
#endif
#ifndef STG_P1
#define STG_P1 0
#endif
#ifndef STG_P3
#define STG_P3 0
#endif
#ifndef STG_P4
#define STG_P4 0
#endif
#define XCD_STAGGER(ticks) do { if ((ticks) > 0) { const unsigned long long t0_ = __builtin_amdgcn_s_memrealtime(); const unsigned long long dl_ = (unsigned long long)(((blockIdx.x >> 3) & 7) * (ticks)); while (__builtin_amdgcn_s_memrealtime() - t0_ < dl_) __builtin_amdgcn_s_sleep(8); } } while (0)
#define LOCAL_SEAM() do { VM_WAIT(); __syncthreads(); if (threadIdx.x == 0) { __builtin_amdgcn_fence(__ATOMIC_ACQUIRE, "agent"); VM_WAIT(); } __syncthreads(); } while (0)
#define KIN(i) (*(const float* const __attribute__((address_space(4)))*)(kp + 8 * (i)))
#define KOUT() (*(float* const __attribute__((address_space(4)))*)(kp + 128))
#define KWS() (*(unsigned char* const __attribute__((address_space(4)))*)(kp + 136))
#define WSP(T_, off) ((T_*)(ws + (off)))
    gu32* const ctl = (gu32*)(KWS() + WS_CTL);
    for (int u = tid0; u < (LDS_BYTES - LDSCTL_OFF) / 4; u += NWAVES * 64) ((LAS unsigned*)(L + LDSCTL_OFF))[u] = 0u;
    __syncthreads();
    XcdBarrier bar = xcd_barrier_post((unsigned*)(ctl + CW_BAR), (volatile LAS unsigned*)(L + LDSCTL_OFF) + 8);

    if constexpr (PH(0)) _Pragma("unroll") for (int rep_ = 0; rep_ < NREP(0); ++rep_) {
        KP_PHASE(); PHASE_IDS(); unsigned char* const ws = KWS();
        const float* const x = KIN(0); const float* const g_mix = KIN(1); const float* const w_in = KIN(2); const float* const w_conv_out = KIN(6); const float* const w_att_out = KIN(7); const float* const w_out = KIN(8);
        const float* const g_ffn = KIN(9); const float* const w_rg = KIN(10); const float* const w_re = KIN(11); const float* const w_eg = KIN(12); const float* const w_eu = KIN(13); const float* const w_ed = KIN(14);
        bf16* const WIN = WSP(bf16, WS_WIN); bf16* const WC = WSP(bf16, WS_WC); bf16* const WA = WSP(bf16, WS_WA); bf16* const WO = WSP(bf16, WS_WO); bf16* const WE1 = WSP(bf16, WS_WE1); bf16* const WE2 = WSP(bf16, WS_WE2);
        bf16* const WRH = WSP(bf16, WS_WRT); bf16* const WRL = WRH + 48 * D; bf16* const XN = WSP(bf16, WS_XN); float* const FLOG = WSP(float, WS_FLOG); float* const RINV = WSP(float, WS_RINV);
        static_assert(T % (NWAVES * 256 * 4) == 0 && (NITEMS + NWAVES * 256 - 1) / (NWAVES * 256) <= 2 * (T / (NWAVES * 256 * 4)), "four rows and up to two weight items per wave and trip");
#define P0_DESC(it_, S_, D_, LW_, LK_, GS_) do { int r_ = (it_); GS_ = nullptr; \
            if (r_ < I_IN) { const int kb = r_ >> 8, d0 = (r_ & 255) * 32; S_ = w_in + (size_t)(64 * kb) * LDW_IN + proj_src_col(d0); D_ = WIN + (size_t)d0 * D + 64 * kb; LW_ = LDW_IN; LK_ = D; } \
            else if ((r_ -= I_IN) < 3 * I_SQ) { const int w = r_ / I_SQ, rr = r_ % I_SQ, kb = rr >> 5, d0 = (rr & 31) * 32; S_ = (w == 0 ? w_conv_out : w == 1 ? w_att_out : w_out) + (size_t)(64 * kb) * D + d0; D_ = (w == 0 ? WC : w == 1 ? WA : WO) + (size_t)d0 * D + 64 * kb; LW_ = D; LK_ = D; } \
            else if ((r_ -= 3 * I_SQ) < I_E1) { const int e = r_ >> 9, rr = r_ & 511, kb = rr >> 5, d0 = (rr & 31) * 32, pn = d0 >> 8, xx = d0 & 255; \
                S_ = (xx < 128 ? w_eg : w_eu) + (size_t)e * D * DE + (size_t)(64 * kb) * DE + 128 * pn + (xx & 127); D_ = WE1 + (size_t)e * 1024 * D + (size_t)d0 * D + 64 * kb; LW_ = DE; LK_ = D; GS_ = g_ffn + 64 * kb; } \
            else { r_ -= I_E1; const int e = r_ >> 8, rr = r_ & 255, kb = rr >> 5, d0 = (rr & 31) * 32; S_ = w_ed + (size_t)e * DE * D + (size_t)(64 * kb) * D + d0; D_ = WE2 + (size_t)e * 1024 * DE + (size_t)d0 * DE + 64 * kb; LW_ = D; LK_ = DE; } } while (0)
#define P0_ITEM_LOAD(v_, S_, LW_, GS_) do { _Pragma("unroll") for (int i_ = 0; i_ < 32; ++i_) v_[i_] = S_[(size_t)(2 * i_ + (lane >> 5)) * LW_ + (lane & 31)]; \
            if (GS_) { _Pragma("unroll") for (int i_ = 0; i_ < 32; ++i_) v_[i_] *= GS_[2 * i_ + (lane >> 5)]; } } while (0)
#define P0_ITEM_FINISH(v_, D_, LK_, scr_) do { _Pragma("unroll") for (int i_ = 0; i_ < 32; ++i_) scr_[(2 * i_ + (lane >> 5)) * 33 + (lane & 31)] = v_[i_]; \
            LDS_WAIT(); asm volatile("" ::: "memory"); const int c_ = lane & 7; \
            _Pragma("unroll") for (int j_ = 0; j_ < 4; ++j_) { const int n_ = (lane >> 3) + 8 * j_; const LAS float* s_ = scr_ + (8 * c_) * 33 + n_; \
                v4u o_; o_.x = pk2(s_[0 * 33], s_[1 * 33]); o_.y = pk2(s_[2 * 33], s_[3 * 33]); o_.z = pk2(s_[4 * 33], s_[5 * 33]); o_.w = pk2(s_[6 * 33], s_[7 * 33]); \
                *(GAS v4u*)(D_ + (size_t)n_ * LK_ + 8 * c_) = o_; } \
            LDS_WAIT(); asm volatile("" ::: "memory"); } while (0)
        for (int i = bx * (NWAVES * 64) + tid; i < 48 * D; i += G * NWAVES * 64) { const int e = i >> 10, k = i & 1023;
            const float w = (e < 4 ? w_rg[k * 4 + e] : e < NLOG ? w_re[(size_t)((e - 4) >> 3) * D * 8 + k * 8 + ((e - 4) & 7)] : 0.f) * g_ffn[k]; const unsigned hi = f2bf(w); WRH[i] = (bf16)hi; WRL[i] = (bf16)f2bf(w - __uint_as_float(hi << 16)); }
        LAS float* wfT = (LAS float*)(L + RING_OFF);
        LAS float* scrA = (LAS float*)(L + RING_OFF + 65536 + wave * 8448); LAS float* scrB = scrA;
        static_assert(65536 + NWAVES * 8448 <= LDSCTL_OFF, "P0 LDS map");
#pragma unroll
        for (int i = 0; i < 2; ++i) { const int k = tid + 512 * i; const GAS f32x4* src = (const GAS f32x4*)(w_in + (size_t)k * LDW_IN + FCOL0);
#pragma unroll
            for (int q = 0; q < 4; ++q) { const f32x4 v = src[q]; wfT[(4 * q + 0) * 1024 + k] = v.x; wfT[(4 * q + 1) * 1024 + k] = v.y; wfT[(4 * q + 2) * 1024 + k] = v.z; wfT[(4 * q + 3) * 1024 + k] = v.w; } }
        __syncthreads();
        f32x4 gv[4];
#pragma unroll
        for (int j = 0; j < 4; ++j) gv[j] = ((const GAS f32x4*)g_mix)[lane + 64 * j];
        f32x4 nx[4][4];
#define P0_LOAD(i_) do { _Pragma("unroll") for (int r = 0; r < 4; ++r) { const GAS f32x4* xr_ = (const GAS f32x4*)(x + (size_t)(gw + ((i_) + r) * NGW) * D) + lane; _Pragma("unroll") for (int j = 0; j < 4; ++j) nx[r][j] = xr_[64 * j]; } } while (0)
        const int nrow = T / NGW;
        for (int i = 0; i + 4 <= nrow; i += 4) {
            P0_LOAD(i);
            const int itA = gw + (i >> 1) * NGW, itB = itA + NGW; const bool hasA = itA < NITEMS, hasB = itB < NITEMS;
            const float* sA = nullptr; const float* sB = nullptr; bf16* dA = nullptr; bf16* dB = nullptr; const float* gA = nullptr; const float* gB = nullptr; int lwA = 0, lwB = 0, lkA = 0, lkB = 0; float ia[32], ib[32];
            if (hasA) { P0_DESC(itA, sA, dA, lwA, lkA, gA); P0_ITEM_LOAD(ia, sA, lwA, gA); }
            if (hasB) { P0_DESC(itB, sB, dB, lwB, lkB, gB); P0_ITEM_LOAD(ib, sB, lwB, gB); }
            f32x4 (&v)[4][4] = nx;
            float s2[4];
#pragma unroll
            for (int r = 0; r < 4; ++r) s2[r] = (dot4(v[r][0], v[r][0]) + dot4(v[r][1], v[r][1])) + (dot4(v[r][2], v[r][2]) + dot4(v[r][3], v[r][3]));
#pragma unroll
            for (int r = 0; r < 4; ++r) { const float rinv_ = sqrtf(wave_total(s2[r]) * (1.f / D) + RMS_EPS), rstd = 1.0f / rinv_; const int m = gw + (i + r) * NGW; if (lane == 0) RINV[m] = rinv_;
                GAS unsigned long long* o8 = (GAS unsigned long long*)(XN + (size_t)m * D) + lane;
#pragma unroll
                for (int j = 0; j < 4; ++j) { v[r][j] = (v[r][j] * rstd) * gv[j]; o8[64 * j] = (unsigned long long)pk2(v[r][j].x, v[r][j].y) | ((unsigned long long)pk2(v[r][j].z, v[r][j].w) << 32); } }
            row_logits4<16>(v, (const LAS f32x4*)wfT, lane, FLOG + (size_t)(gw + (i + (lane & 3)) * NGW) * 16);
            if (hasA) P0_ITEM_FINISH(ia, dA, lkA, scrA);
            if (hasB) P0_ITEM_FINISH(ib, dB, lkB, scrB);
        }
    }
    xcd_barrier(bar);

    if constexpr (PH(1)) _Pragma("unroll") for (int rep_ = 0; rep_ < NREP(1); ++rep_) {
        KP_PHASE(); PHASE_IDS(); unsigned char* const ws = KWS(); const float* const b_forget = KIN(5); float* const out = KOUT();
        float* const FLOG = WSP(float, WS_FLOG); u32x2* const REC = WSP(u32x2, WS_REC); bf16* const XN = WSP(bf16, WS_XN); bf16* const WIN = WSP(bf16, WS_WIN);
        bf16* const ZB = WSP(bf16, WS_Z); bf16* const BB = WSP(bf16, WS_B); bf16* const QO = WSP(bf16, WS_Q); bf16* const KB = WSP(bf16, WS_K); bf16* const VB = WSP(bf16, WS_V);
        bf16* const SGC = (bf16*)out; bf16* const SGA = (bf16*)((unsigned char*)out + (size_t)T * D);
        LAS float* red = (LAS float*)(L + RING_OFF);
        for (int bh = bx; bh < NB * NH; bh += G) {
            const int b = bh >> 4, h = bh & 15; const float bf = b_forget[h];
            float c[4];
#pragma unroll
            for (int i = 0; i < 4; ++i) { const float xv = FLOG[((size_t)b * SEQ + 4 * tid + i) * 16 + h] + bf; const float ls = fminf(xv, 0.f) - log1pf(expf(-fabsf(xv))); c[i] = ls * LOG2E; }
            c[1] += c[0]; c[2] += c[1]; c[3] += c[2];
            const float tot = c[3]; float sc = tot;
#pragma unroll
            for (int o = 1; o < 64; o <<= 1) { const float tv = __shfl_up(sc, o); if (lane >= o) sc += tv; }
            if (lane == 63) red[wave] = sc;
            __syncthreads();
            float off = 0.f;
            for (int w = 0; w < wave; ++w) off += red[w];
            const float excl = off + (sc - tot);
            unsigned rw[8];
#pragma unroll
            for (int i = 0; i < 4; ++i) { const float bias = -(excl + c[i]);
                const unsigned h1 = f2bf(bias); const float r1 = bias - __uint_as_float(h1 << 16); const unsigned h2 = f2bf(r1); const float r2 = r1 - __uint_as_float(h2 << 16); const unsigned h3 = f2bf(r2);
                rw[2 * i] = h1 | (h2 << 16); rw[2 * i + 1] = h3 | (0x3f80u << 16); }
            GAS v4u* dst = (GAS v4u*)(REC + (size_t)bh * SEQ + 4 * tid);
            dst[0] = (v4u){rw[0], rw[1], rw[2], rw[3]}; dst[1] = (v4u){rw[4], rw[5], rw[6], rw[7]};
            __syncthreads();
        }
                pg8::StaticOrder S; S.init(XN, WIN, T, NPROJ, D, G, bx, P1_WGM);
        pg8::EpiProj E{ZB, BB, QO, KB, VB, SGC, SGA, attn_body::C2, L + TAB_OFF + wave * 4096};
        XCD_STAGGER(STG_P1);
        pg8::gemm_phase<pg8::EpiProj, pg8::StaticOrder, true, false>(L + RING_OFF, D, S, E, ws + WS_DUMP);
#ifdef HOT_UNITS
        { VM_WAIT(); __syncthreads(); const pg8::HotOrder HS{XN, WIN, D, HOT_UNITS, bx, HOT_PN};
#if HOT_STORE
          bf16* const dmp = WSP(bf16, WS_LIST); pg8::EpiProj HE{dmp, dmp, dmp, dmp, dmp, dmp, dmp, 1.0f, L + TAB_OFF + wave * 4096}; pg8::gemm_phase<pg8::EpiProj, pg8::HotOrder, true, false>(L + RING_OFF, D, HS, HE);
#else
          pg8::EpiNull HE{WSP(float, WS_LIST)}; pg8::gemm_phase<pg8::EpiNull, pg8::HotOrder, true, false>(L + RING_OFF, D, HS, HE);
#endif
        }
#endif
    }
    xcd_barrier(bar);

    if constexpr (PH(2)) _Pragma("unroll") for (int rep_ = 0; rep_ < NREP(2); ++rep_) {
        KP_PHASE(); PHASE_IDS(); unsigned char* const ws = KWS(); const float* const conv_w = KIN(3); const float* const conv_b = KIN(4);
        bf16* const ZB = WSP(bf16, WS_Z); bf16* const BB = WSP(bf16, WS_B); bf16* const QO = WSP(bf16, WS_Q); bf16* const KB = WSP(bf16, WS_K); bf16* const VB = WSP(bf16, WS_V); u32x2* const REC = WSP(u32x2, WS_REC);
        const bool dummy_ = (rep_ + 1 < NREP(2)); bf16* const CO = dummy_ ? WSP(bf16, WS_XN) : BB; bf16* const AO = dummy_ ? WSP(bf16, WS_XN) : QO;
        const attn_body::AttnTensors AT{(const attn_body::bf16*)QO, (const attn_body::bf16*)KB, (const attn_body::bf16*)VB, (attn_body::bf16*)AO, (const attn_body::u32x2_t*)REC};
        const attn_body::StaticOrder S(G, bx);
        if (G == NB * SEQ / 256 && !dummy_) {
            for (int u = tid; u < 1024; u += NWAVES * 64) ((LAS f32x4*)(L + RING_OFF + attn_body::LDS_CW))[u] = u < 768 ? ((const GAS f32x4*)conv_w)[u] : ((const GAS f32x4*)conv_b)[u - 768];
            if (tid < 256) { const int rr = tid >> 7, c = tid & 127; v4u v = (v4u){0u, 0u, 0u, 0u};
                if ((bx & (SEQ / 256 - 1)) != 0) v = *(const GAS v4u*)(ZB + ((size_t)256 * bx - 2 + rr) * D + 8 * c);
                *(LAS v4u*)(L + RING_OFF + attn_body::LDS_ZR + (16 + rr) * 2048 + c * 16) = v; }
            __syncthreads();
            const attn_body::ConvSide CS{(const attn_body::bf16*)ZB, (attn_body::bf16*)BB, 256 * bx};
            attn_body::attn_phase<attn_body::StaticOrder, 40, true>((char*)lds + RING_OFF, AT, S, CS);
        } else {
        const int cg = tid & 127;
        float w0[8], w1[8], w2[8], cb[8];
#pragma unroll
        for (int j = 0; j < 8; ++j) { w0[j] = conv_w[8 * cg + j]; w1[j] = conv_w[D + 8 * cg + j]; w2[j] = conv_w[2 * D + 8 * cg + j]; cb[j] = conv_b[8 * cg + j]; }
        for (int task = bx * (NWAVES * 64) + tid; task < (T / 32) * 128; task += G * NWAVES * 64) {
            const int t0 = (task >> 7) * 32;
            float z1[8], z2[8];
            if ((t0 & (SEQ - 1)) == 0) {
#pragma unroll
                for (int j = 0; j < 8; ++j) { z1[j] = 0.f; z2[j] = 0.f; }
            } else {
                const v4u a = *(const GAS v4u*)(ZB + (size_t)(t0 - 2) * D + 8 * cg), bq = *(const GAS v4u*)(ZB + (size_t)(t0 - 1) * D + 8 * cg);
                z2[0] = pg8::bf_lo(a.x); z2[1] = pg8::bf_hi(a.x); z2[2] = pg8::bf_lo(a.y); z2[3] = pg8::bf_hi(a.y); z2[4] = pg8::bf_lo(a.z); z2[5] = pg8::bf_hi(a.z); z2[6] = pg8::bf_lo(a.w); z2[7] = pg8::bf_hi(a.w);
                z1[0] = pg8::bf_lo(bq.x); z1[1] = pg8::bf_hi(bq.x); z1[2] = pg8::bf_lo(bq.y); z1[3] = pg8::bf_hi(bq.y); z1[4] = pg8::bf_lo(bq.z); z1[5] = pg8::bf_hi(bq.z); z1[6] = pg8::bf_lo(bq.w); z1[7] = pg8::bf_hi(bq.w);
            }
#pragma unroll 4
            for (int r = 0; r < 32; ++r) {
                const size_t off = (size_t)(t0 + r) * D + 8 * cg;
                const v4u zc = *(const GAS v4u*)(ZB + off), bv = *(const GAS v4u*)(BB + off);
                float z0[8], bb[8], y[8];
                z0[0] = pg8::bf_lo(zc.x); z0[1] = pg8::bf_hi(zc.x); z0[2] = pg8::bf_lo(zc.y); z0[3] = pg8::bf_hi(zc.y); z0[4] = pg8::bf_lo(zc.z); z0[5] = pg8::bf_hi(zc.z); z0[6] = pg8::bf_lo(zc.w); z0[7] = pg8::bf_hi(zc.w);
                bb[0] = pg8::bf_lo(bv.x); bb[1] = pg8::bf_hi(bv.x); bb[2] = pg8::bf_lo(bv.y); bb[3] = pg8::bf_hi(bv.y); bb[4] = pg8::bf_lo(bv.z); bb[5] = pg8::bf_hi(bv.z); bb[6] = pg8::bf_lo(bv.w); bb[7] = pg8::bf_hi(bv.w);
#pragma unroll
                for (int j = 0; j < 8; ++j) { y[j] = bb[j] * (cb[j] + w0[j] * z2[j] + w1[j] * z1[j] + w2[j] * z0[j]); z2[j] = z1[j]; z1[j] = z0[j]; }
                *(GAS v4u*)(CO + off) = (v4u){pk2(y[0], y[1]), pk2(y[2], y[3]), pk2(y[4], y[5]), pk2(y[6], y[7])};
            }
        }
        VM_WAIT(); __syncthreads();
        attn_body::attn_phase<attn_body::StaticOrder, 40, false>((char*)lds + RING_OFF, AT, S);
        }
    }
    xcd_barrier(bar);

    if constexpr (PH(3)) _Pragma("unroll") for (int rep_ = 0; rep_ < NREP(3); ++rep_) {
        KP_PHASE(); PHASE_IDS(); unsigned char* const ws = KWS(); float* const out = KOUT();
        bf16* const BB = WSP(bf16, WS_B); bf16* const QO = WSP(bf16, WS_Q); bf16* const MB = WSP(bf16, WS_Z); bf16* const WC = WSP(bf16, WS_WC); bf16* const WA = WSP(bf16, WS_WA);
        const unsigned char* const SGC = (const unsigned char*)out; const unsigned char* const SGA = (const unsigned char*)out + (size_t)T * D;
        XCD_STAGGER(STG_P3);
        { pg8::StaticOrder S; S.init(BB, WC, T, D, D, G, bx, P3_WGM); pg8::EpiGate<false> E{SGC, MB, L + TAB_OFF + wave * 4096}; pg8::gemm_phase<pg8::EpiGate<false>, pg8::StaticOrder, true, false>(L + RING_OFF, D, S, E, ws + WS_DUMP); }
        VM_WAIT(); __syncthreads();
        { pg8::StaticOrder S; S.init(QO, WA, T, D, D, G, bx, P3_WGM); pg8::EpiGate<true> E{SGA, MB, L + TAB_OFF + wave * 4096}; pg8::gemm_phase<pg8::EpiGate<true>, pg8::StaticOrder, true, false>(L + RING_OFF, D, S, E, ws + WS_DUMP); }
    }
    xcd_barrier(bar);

    if constexpr (PH(4)) _Pragma("unroll") for (int rep_ = 0; rep_ < NREP(4); ++rep_) {
        KP_PHASE(); PHASE_IDS(); unsigned char* const ws = KWS(); float* const out = KOUT(); const float* const x = KIN(0); const float* const g_mix = KIN(1); bf16* const MB = WSP(bf16, WS_Z); bf16* const WO = WSP(bf16, WS_WO); bf16* const XM = WSP(bf16, WS_K); (void)out;
        pg8::StaticOrder S; S.init(MB, WO, T, D, D, G, bx);
        bool gok = true;
#pragma unroll
        for (int j = 0; j < 4; ++j) { const f32x4 gq = ((const GAS f32x4*)g_mix)[lane + 64 * j];
#pragma unroll
            for (int c = 0; c < 4; ++c) { const float a = fabsf(gq[c]); gok = gok && (a >= 1e-18f) && (a <= 1e18f); } }
        const bool use_xn = __builtin_amdgcn_ballot_w64(!gok) == 0ull;
        if (use_xn) { pg8::EpiResXN E{WSP(bf16, WS_XN), WSP(float, WS_RINV), g_mix, XM, L + TAB_OFF + wave * 4096}; pg8::gemm_phase<pg8::EpiResXN, pg8::StaticOrder, true, false>(L + RING_OFF, D, S, E, ws + WS_DUMP); }
        else { pg8::EpiRes E{x, XM, L + TAB_OFF + wave * 4096}; pg8::gemm_phase<pg8::EpiRes, pg8::StaticOrder, true, false>(L + RING_OFF, D, S, E, ws + WS_DUMP); }
    }
    xcd_barrier(bar);

    if constexpr (PH(5)) _Pragma("unroll") for (int rep_ = 0; rep_ < NREP(5); ++rep_) {
        KP_PHASE(); PHASE_IDS(); unsigned char* const ws = KWS();
        const bf16* const WRH = WSP(bf16, WS_WRT); const bf16* const WRL = WRH + 48 * D; const bf16* const XM = WSP(bf16, WS_K); float* const LOGITS = WSP(float, WS_FLOG); float* const RSTD = WSP(float, WS_RSTD); unsigned* const LIST = WSP(unsigned, WS_LIST); float* const LWT = WSP(float, WS_LWT);
        LAS int* lcnt = (LAS int*)(L + P5_LCNT); LAS int* lbase = (LAS int*)(L + P5_LBASE);
        if (tid < 32) lcnt[tid] = 0;
        __syncthreads();
        if (wave >= 4 && rep_ + 1 == NREP(5)) {
            const float* const w_in = KIN(2); const float* const w_conv_out = KIN(6); const float* const w_att_out = KIN(7); const float* const w_out = KIN(8);
            const float* const g_ffn = KIN(9); const float* const w_eg = KIN(12); const float* const w_eu = KIN(13); const float* const w_ed = KIN(14);
            bf16* const WIN = WSP(bf16, WS_WIN); bf16* const WC = WSP(bf16, WS_WC); bf16* const WA = WSP(bf16, WS_WA); bf16* const WO = WSP(bf16, WS_WO); bf16* const WE1 = WSP(bf16, WS_WE1); bf16* const WE2 = WSP(bf16, WS_WE2);
            LAS float* scr = (LAS float*)(L + RING_OFF + 65536 + wave * 8448);
            const int iw = vcu * 4 + (wave - 4), NIW = G * 4;
            for (int r = iw; r < NITEMS_E; r += 4 * NIW) {
                const int it0 = NITEMS + r; const bool h1 = r + NIW < NITEMS_E, h2 = r + 2 * NIW < NITEMS_E, h3 = r + 3 * NIW < NITEMS_E;
                const float *sq0 = nullptr, *sq1 = nullptr, *sq2 = nullptr, *sq3 = nullptr, *gq0 = nullptr, *gq1 = nullptr, *gq2 = nullptr, *gq3 = nullptr; bf16 *dq0 = nullptr, *dq1 = nullptr, *dq2 = nullptr, *dq3 = nullptr;
                int lw0 = 0, lw1 = 0, lw2 = 0, lw3 = 0, lk0 = 0, lk1 = 0, lk2 = 0, lk3 = 0; float iq0[32], iq1[32], iq2[32], iq3[32];
                P0_DESC(it0, sq0, dq0, lw0, lk0, gq0); P0_ITEM_LOAD(iq0, sq0, lw0, gq0);
                if (h1) { P0_DESC(it0 + NIW, sq1, dq1, lw1, lk1, gq1); P0_ITEM_LOAD(iq1, sq1, lw1, gq1); }
                if (h2) { P0_DESC(it0 + 2 * NIW, sq2, dq2, lw2, lk2, gq2); P0_ITEM_LOAD(iq2, sq2, lw2, gq2); }
                if (h3) { P0_DESC(it0 + 3 * NIW, sq3, dq3, lw3, lk3, gq3); P0_ITEM_LOAD(iq3, sq3, lw3, gq3); }
                P0_ITEM_FINISH(iq0, dq0, lk0, scr);
                if (h1) P0_ITEM_FINISH(iq1, dq1, lk1, scr);
                if (h2) P0_ITEM_FINISH(iq2, dq2, lk2, scr);
                if (h3) P0_ITEM_FINISH(iq3, dq3, lk3, scr);
            }
        }
        for (int rb = bx; rb < T / 256; rb += G) {
          if (wave < 4)
#pragma unroll 1
          for (int pass = 0; pass < 2; ++pass) {
            const int mbase = rb * 256 + wave * 64 + pass * 32, fr = lane & 15, fq = lane >> 4;
            const GAS bf16x8* ap0 = (const GAS bf16x8*)(XM + (size_t)(mbase + fr) * D + 8 * fq); const GAS bf16x8* ap1 = (const GAS bf16x8*)(XM + (size_t)(mbase + 16 + fr) * D + 8 * fq);
            const GAS bf16x8* bh = (const GAS bf16x8*)(WRH + (size_t)fr * D + 8 * fq); const GAS bf16x8* bl = (const GAS bf16x8*)(WRL + (size_t)fr * D + 8 * fq);
            f32x4 acc[2][3]; float ss0 = 0.f, ss1 = 0.f;
#pragma unroll
            for (int mt = 0; mt < 2; ++mt)
#pragma unroll
                for (int nt = 0; nt < 3; ++nt) acc[mt][nt] = (f32x4){0.f, 0.f, 0.f, 0.f};
#pragma unroll 4
            for (int s = 0; s < D / 32; ++s) {
                const bf16x8 a0 = ap0[4 * s], a1 = ap1[4 * s];
                bf16x8 wh[3], wl[3];
#pragma unroll
                for (int nt = 0; nt < 3; ++nt) { wh[nt] = bh[4 * s + nt * 2048]; wl[nt] = bl[4 * s + nt * 2048]; }
#pragma unroll
                for (int nt = 0; nt < 3; ++nt) { acc[0][nt] = __builtin_amdgcn_mfma_f32_16x16x32_bf16(a0, wh[nt], acc[0][nt], 0, 0, 0); acc[1][nt] = __builtin_amdgcn_mfma_f32_16x16x32_bf16(a1, wh[nt], acc[1][nt], 0, 0, 0);
                    acc[0][nt] = __builtin_amdgcn_mfma_f32_16x16x32_bf16(a0, wl[nt], acc[0][nt], 0, 0, 0); acc[1][nt] = __builtin_amdgcn_mfma_f32_16x16x32_bf16(a1, wl[nt], acc[1][nt], 0, 0, 0); }
#pragma unroll
                for (int j = 0; j < 8; ++j) { const float x0 = __uint_as_float((unsigned)(unsigned short)a0[j] << 16), x1 = __uint_as_float((unsigned)(unsigned short)a1[j] << 16); ss0 += x0 * x0; ss1 += x1 * x1; }
            }
            ss0 += __builtin_bit_cast(float, __builtin_amdgcn_ds_swizzle(__builtin_bit_cast(int, ss0), 0x401F)); ss1 += __builtin_bit_cast(float, __builtin_amdgcn_ds_swizzle(__builtin_bit_cast(int, ss1), 0x401F));
            { auto r0 = __builtin_amdgcn_permlane32_swap(__float_as_uint(ss0), __float_as_uint(ss0), false, false); ss0 = __uint_as_float(r0[0]) + __uint_as_float(r0[1]);
              auto r1 = __builtin_amdgcn_permlane32_swap(__float_as_uint(ss1), __float_as_uint(ss1), false, false); ss1 = __uint_as_float(r1[0]) + __uint_as_float(r1[1]); }
            if (fq == 0) { RSTD[mbase + fr] = 1.0f / sqrtf(ss0 * (1.f / D) + RMS_EPS); RSTD[mbase + 16 + fr] = 1.0f / sqrtf(ss1 * (1.f / D) + RMS_EPS); }
#pragma unroll
            for (int mt = 0; mt < 2; ++mt)
#pragma unroll
                for (int nt = 0; nt < 3; ++nt) { const int col = 16 * nt + fr;
                    if (col < NLOG) {
#pragma unroll
                        for (int i = 0; i < 4; ++i) LOGITS[(size_t)(mbase + 16 * mt + 4 * fq + i) * NLOG + col] = acc[mt][nt][i]; } }
          }
            VM_WAIT();
            __syncthreads();
            if (rep_ + 1 < NREP(5)) continue;
            i32x4 rt = (i32x4){0, 0, 0, 0}; int rk1 = 0, rk2 = 0;
            if (tid < 256) {
                const GAS f32x4* lp = (const GAS f32x4*)(LOGITS + (size_t)(rb * 256 + tid) * NLOG); float lg[NLOG];
                const float rs = RSTD[rb * 256 + tid];
#pragma unroll
                for (int q = 0; q < NLOG / 4; ++q) { const f32x4 t4 = lp[q] * rs; lg[4 * q] = t4.x; lg[4 * q + 1] = t4.y; lg[4 * q + 2] = t4.z; lg[4 * q + 3] = t4.w; }
                int g = 0; float mg = lg[0];
#pragma unroll
                for (int i = 1; i < 4; ++i) if (lg[i] > mg) { mg = lg[i]; g = i; }
                float sg = 0.f;
#pragma unroll
                for (int i = 0; i < 4; ++i) sg += expf(lg[i] - mg);
                const float gval = 1.0f / sg;
                float le[8];
#pragma unroll
                for (int j = 0; j < 8; ++j) le[j] = g == 0 ? lg[4 + j] : g == 1 ? lg[12 + j] : g == 2 ? lg[20 + j] : lg[28 + j];
                int i1 = 0; float m1 = le[0];
#pragma unroll
                for (int j = 1; j < 8; ++j) if (le[j] > m1) { m1 = le[j]; i1 = j; }
                int i2 = 0; float m2 = -INFINITY;
#pragma unroll
                for (int j = 0; j < 8; ++j) if (j != i1 && le[j] > m2) { m2 = le[j]; i2 = j; }
                const float e2 = expf(m2 - m1), v1 = 1.0f / (1.0f + e2), v2 = e2 / (1.0f + e2);
                rt = (i32x4){8 * g + i1, 8 * g + i2, (int)__float_as_uint(gval * v1), (int)__float_as_uint(gval * v2)}; }
            if (tid < 256) { rk1 = __hip_atomic_fetch_add(lcnt + rt.x, 1, __ATOMIC_RELAXED, __HIP_MEMORY_SCOPE_WORKGROUP); rk2 = __hip_atomic_fetch_add(lcnt + rt.y, 1, __ATOMIC_RELAXED, __HIP_MEMORY_SCOPE_WORKGROUP); }
            __syncthreads();
            if (tid < 32) lbase[tid] = (int)__hip_atomic_fetch_add(ctl + CW_CNT + 64 * tid, (unsigned)lcnt[tid], RLX_AGENT);
            __syncthreads();
            if (tid < 256) { const unsigned tok = (unsigned)(rb * 256 + tid);
                const size_t p1 = (size_t)rt.x * LCAP + (size_t)(lbase[rt.x] + rk1), p2 = (size_t)rt.y * LCAP + (size_t)(lbase[rt.y] + rk2);
                LIST[p1] = 2u * tok; LWT[p1] = __uint_as_float((unsigned)rt.z); LIST[p2] = 2u * tok + 1u; LWT[p2] = __uint_as_float((unsigned)rt.w); }
            __syncthreads();
            if (tid < 32) lcnt[tid] = 0;
            __syncthreads();
        }
    }
    xcd_barrier(bar);

    LAS int* tcnt = (LAS int*)(L + TAB_CNT); LAS int* tstart = (LAS int*)(L + TAB_TSTART); LAS int* rstart = (LAS int*)(L + TAB_RSTART);
    LAS i32x4* desc = (LAS i32x4*)(L + TAB_DESC); LAS unsigned* tidx = (LAS unsigned*)(L + TAB_IDX); LAS float* twt = (LAS float*)(L + TAB_WT); LAS float* trs = (LAS float*)(L + TAB_RS);
    if constexpr (PH(6)) {
        KP_PHASE(); PHASE_IDS(); unsigned char* const ws = KWS(); unsigned* const LIST = WSP(unsigned, WS_LIST); float* const LWT = WSP(float, WS_LWT); const float* const RSTD = WSP(float, WS_RSTD); unsigned* const SLOTOF = WSP(unsigned, WS_SLOTOF);
        if (tid < 32) tcnt[tid] = (int)__hip_atomic_load(ctl + CW_CNT + 64 * tid, RLX_AGENT);
        __syncthreads();
        if (tid == 0) { int ts = 0, rs = 0; for (int e = 0; e < NEXP; ++e) { tstart[e] = ts; rstart[e] = rs; ts += (tcnt[e] + 255) >> 8; rs += tcnt[e]; } tstart[NEXP] = ts; rstart[NEXP] = rs; }
        __syncthreads();
        if (tid < pg8::MOE_SLOTS) {
            const int nU = 4 * tstart[NEXP], chunk = (nU + 7) >> 3, per = (G + 7) / 8, s = tid * per + (bx >> 3), U = (bx & 7) * chunk + s;
            i32x4 d = (i32x4){0, 0, 0, 0};
            if (s < chunk && U < nU) { const int rowtile = U >> 2; int e = 0; while (e < NEXP - 1 && tstart[e + 1] <= rowtile) ++e; const int rt = rowtile - tstart[e]; int nv = tcnt[e] - 256 * rt; nv = nv > 256 ? 256 : nv; d = (i32x4){e, rt, U & 3, nv}; }
            desc[tid] = d;
        }
        __syncthreads();
        { static_assert(pg8::MOE_SLOTS * 256 % (NWAVES * 64) == 0, "table fill");
            constexpr int NE = pg8::MOE_SLOTS * 256 / (NWAVES * 64); unsigned ent[NE]; float w[NE], rs[NE];
#pragma unroll
            for (int k = 0; k < NE; ++k) { const int e = tid + k * (NWAVES * 64), slot = e >> 8, r = e & 255; const i32x4 d = desc[slot]; ent[k] = 0u; w[k] = 0.f;
                if (r < d.w) { const size_t p = (size_t)d.x * LCAP + (size_t)(256 * d.y + r); ent[k] = LIST[p]; w[k] = LWT[p]; } }
#pragma unroll
            for (int k = 0; k < NE; ++k) { const int e = tid + k * (NWAVES * 64), slot = e >> 8, r = e & 255; const i32x4 d = desc[slot]; rs[k] = (r < d.w) ? RSTD[ent[k] >> 1] : 0.f; }
#pragma unroll
            for (int k = 0; k < NE; ++k) { const int e = tid + k * (NWAVES * 64), slot = e >> 8, r = e & 255; const i32x4 d = desc[slot]; tidx[e] = ent[k]; twt[e] = w[k]; trs[e] = rs[k];
                if (d.z == 0 && r < d.w) SLOTOF[ent[k]] = (unsigned)(rstart[d.x] + 256 * d.y + r); } }
        __syncthreads();
    }
    if constexpr (PH(6)) _Pragma("unroll") for (int rep_ = 0; rep_ < NREP(6); ++rep_) {
        KP_PHASE(); PHASE_IDS(); unsigned char* const ws = KWS(); bf16* const XM = WSP(bf16, WS_K); bf16* const WE1 = WSP(bf16, WS_WE1); bf16* const ACT = WSP(bf16, WS_Q);
        pg8::MoeOrder S{XM, WE1, D, (size_t)1024 * D * 2, desc, rstart, tidx, true}; pg8::EpiSilu E{ACT, rstart, trs};
        pg8::gemm_phase<pg8::EpiSilu, pg8::MoeOrder, true, true>(L + RING_OFF, D, S, E);
    }
    xcd_barrier(bar);
    if constexpr (PH(7)) _Pragma("unroll") for (int rep_ = 0; rep_ < NREP(7); ++rep_) {
        KP_PHASE(); PHASE_IDS(); unsigned char* const ws = KWS(); bf16* const ACT = WSP(bf16, WS_Q); bf16* const WE2 = WSP(bf16, WS_WE2); bf16* const YB = WSP(bf16, WS_XN);
        pg8::MoeOrder S{ACT, WE2, DE, (size_t)1024 * DE * 2, desc, rstart, tidx, false}; pg8::EpiDown E{YB, rstart, twt, L + (wave < 4 ? TAB_IDX + wave * 2304 : TAB_RS + (wave - 4) * 2304)};
        pg8::gemm_phase<pg8::EpiDown, pg8::MoeOrder, true, false>(L + RING_OFF, DE, S, E);
    }
    xcd_barrier(bar);

    if constexpr (PH(8)) _Pragma("unroll") for (int rep_ = 0; rep_ < NREP(8); ++rep_) {
        KP_PHASE(); PHASE_IDS(); unsigned char* const ws = KWS(); float* const out = KOUT(); const float* const g_fin = KIN(15); const bf16* const YB = WSP(bf16, WS_XN); const bf16* const XM = WSP(bf16, WS_K); const unsigned* const SLOTOF = WSP(unsigned, WS_SLOTOF);
        f32x4 gv[4];
#pragma unroll
        for (int j = 0; j < 4; ++j) gv[j] = ((const GAS f32x4*)g_fin)[lane + 64 * j];
        u32x2 nx[4], na[4], nb[4]; unsigned ns0 = 0u, ns1 = 0u;
#define P8_SLOTS(mm) do { ns0 = (unsigned)__builtin_amdgcn_readfirstlane((int)SLOTOF[2 * (mm)]); ns1 = (unsigned)__builtin_amdgcn_readfirstlane((int)SLOTOF[2 * (mm) + 1]); } while (0)
#define P8_LOAD(mm) do { const GAS u32x2* xr_ = (const GAS u32x2*)(XM + (size_t)(mm) * D) + lane; const GAS u32x2* y0_ = (const GAS u32x2*)(YB + (size_t)ns0 * D) + lane; const GAS u32x2* y1_ = (const GAS u32x2*)(YB + (size_t)ns1 * D) + lane; \
            _Pragma("unroll") for (int j = 0; j < 4; ++j) { nx[j] = xr_[64 * j]; na[j] = y0_[64 * j]; nb[j] = y1_[64 * j]; } } while (0)
        if (gw < T) { P8_SLOTS(gw); P8_LOAD(gw); if (gw + NGW < T) P8_SLOTS(gw + NGW); }
        for (int m = gw; m < T; m += NGW) {
            GAS f32x4* xw = (rep_ + 1 < NREP(8)) ? (GAS f32x4*)(WSP(float, WS_Z) + (size_t)m * D) + lane : (GAS f32x4*)(out + (size_t)m * D) + lane;
            f32x4 v[4]; u32x2 ya[4], yb[4]; float s2 = 0.f;
#pragma unroll
            for (int j = 0; j < 4; ++j) { v[j] = (f32x4){pg8::bf_lo(nx[j].x), pg8::bf_hi(nx[j].x), pg8::bf_lo(nx[j].y), pg8::bf_hi(nx[j].y)}; ya[j] = na[j]; yb[j] = nb[j]; }
            if (m + NGW < T) { P8_LOAD(m + NGW); if (m + 2 * NGW < T) P8_SLOTS(m + 2 * NGW); }
#pragma unroll
            for (int j = 0; j < 4; ++j) { const u32x2 a = ya[j], b = yb[j];
                v[j].x += pg8::bf_lo(a.x) + pg8::bf_lo(b.x); v[j].y += pg8::bf_hi(a.x) + pg8::bf_hi(b.x); v[j].z += pg8::bf_lo(a.y) + pg8::bf_lo(b.y); v[j].w += pg8::bf_hi(a.y) + pg8::bf_hi(b.y);
                s2 += dot4(v[j], v[j]); }
            const float rstd = 1.0f / sqrtf(wave_total(s2) * (1.f / D) + RMS_EPS);
#pragma unroll
            for (int j = 0; j < 4; ++j) xw[64 * j] = (v[j] * rstd) * gv[j];
        }
    }
}

extern "C" void kernel_launch(void* const* d_in, const int* in_sizes, int n_in, void* d_out, int out_size, void* d_ws, size_t ws_size, hipStream_t stream) {
    static int grid = 0;
    if (grid == 0) {
        if (n_in != 16 || in_sizes[0] != T * D || out_size != T * D || ws_size < WS_END) { fprintf(stderr, "kernel_launch: built for 16 inputs, x/out of %d floats, >= %zu bytes of workspace; got n_in %d, in0 %d, out %d, ws %zu; nothing launched\n", T * D, (size_t)WS_END, n_in, n_in > 0 ? in_sizes[0] : -1, out_size, ws_size); grid = -1; return; }
        int dev = 0, cus = 0, per_cu = 0;
        if (hipGetDevice(&dev) != hipSuccess || hipDeviceGetAttribute(&cus, hipDeviceAttributeMultiprocessorCount, dev) != hipSuccess) { fprintf(stderr, "kernel_launch: hipGetDevice / hipDeviceGetAttribute failed; nothing launched\n"); grid = -1; return; }
        if (hipFuncSetAttribute((const void*)fox_moe_fwd, hipFuncAttributeMaxDynamicSharedMemorySize, LDS_BYTES) != hipSuccess) { fprintf(stderr, "kernel_launch: hipFuncSetAttribute(%d B LDS) failed; nothing launched\n", LDS_BYTES); grid = -1; return; }
        if (hipOccupancyMaxActiveBlocksPerMultiprocessor(&per_cu, (const void*)fox_moe_fwd, NWAVES * 64, LDS_BYTES) != hipSuccess || per_cu < 1)
            fprintf(stderr, "kernel_launch: note: the occupancy query reports %d workgroups per CU\n", per_cu);
        (void)hipGetLastError();
        grid = cus;
        if (grid != T / 256) { fprintf(stderr, "kernel_launch: %d CUs, but this kernel deals one 256-row panel per workgroup and needs exactly %d resident workgroups; nothing launched\n", cus, T / 256); grid = -1; return; }
        if (grid % 8 != 0 || grid < 8) { fprintf(stderr, "kernel_launch: %d CUs: this kernel wants a multiple of 8\n", grid); grid = (grid / 8) * 8; if (grid == 0) { grid = -1; return; } }
    }
    if (grid < 0) return;
    if (hipMemsetAsync((char*)d_ws + WS_CTL, 0, CTL_ZERO_BYTES, stream) != hipSuccess) { fprintf(stderr, "kernel_launch: hipMemsetAsync of the control words failed; nothing launched\n"); return; }
    Args a{};
    for (int i = 0; i < 16; ++i) a.in[i] = (const float*)d_in[i];
    a.out = (float*)d_out; a.ws = (unsigned char*)d_ws;
    hipLaunchKernelGGL(fox_moe_fwd, dim3(grid), dim3(NWAVES * 64), LDS_BYTES, stream, a);
    const hipError_t le = hipPeekAtLastError();
    if (le != hipSuccess) fprintf(stderr, "kernel_launch: launch failed: %s (grid %d x %d threads, %d B LDS)\n", hipGetErrorName(le), grid, NWAVES * 64, LDS_BYTES);
}
```

```cpp
#include <hip/hip_runtime.h>
#include <hip/hip_bf16.h>
#include <cstdio>
#include <cstdint>
#include <cmath>
namespace pg8 {
#define PG8_LAS __attribute__((address_space(3)))
typedef unsigned short bf16_t;
typedef short bf16x8 __attribute__((ext_vector_type(8)));
typedef float f32x4 __attribute__((ext_vector_type(4)));
typedef unsigned u32x4 __attribute__((ext_vector_type(4)));
typedef unsigned u32x2 __attribute__((ext_vector_type(2)));
typedef int i32x4 __attribute__((ext_vector_type(4)));
constexpr int BM = 256, BK = 64, HALF = 128, HTB = HALF * BK * 2  , STAGE_BYTES = 8 * HTB, NXCD = 8, WGM = 8;

__host__ __device__ __forceinline__ int lds_byte(int r, int c) { const int st = (r >> 4) * 2 + (c >> 5), rr = r & 15, cc = c & 31, ob = rr * 64 + cc * 2; return st * 1024 + (ob ^ (((ob >> 9) & 1) << 5)); }
__host__ __device__ __forceinline__ void stage_rc(int b, int& R, int& C) { const int st = b / 1024, sb = b % 1024, swz = sb ^ (((sb >> 9) & 1) << 5); R = (st >> 1) * 16 + swz / 64; C = (st & 1) * 32 + (swz % 64) / 2; }
__host__ __device__ __forceinline__ int perm32(int rho) { const int n = rho >> 4, i = rho & 15; return 8 * (i >> 2) + 4 * n + (i & 3); }

struct Unit { int pm, pn, e, rt, slot, nvalid; };

struct StaticOrder {
    const bf16_t* A; const bf16_t* Bt; int K;
    int nM, nN, nwg, G, c, wgm;
    __device__ __forceinline__ void init(const bf16_t* A_, const bf16_t* Bt_, int M, int N, int K_, int G_, int c_, int wgm_ = WGM) { A = A_; Bt = Bt_; K = K_; nM = M / BM; nN = N / BM; nwg = nM * nN; G = G_; c = c_; wgm = wgm_; }
    __device__ __forceinline__ bool next(int i, Unit& u) const {
        const long L = (long)i * G + c; if (L >= nwg) return false;
        int wgid = (int)L; { const int q = nwg / NXCD, r = nwg % NXCD, xcd = wgid % NXCD, off = wgid / NXCD; wgid = (xcd < r ? xcd * (q + 1) : r * (q + 1) + (xcd - r) * q) + off; }
        const int nig = wgm * nN, gid = wgid / nig, fm = gid * wgm, gsz = (nM - fm) < wgm ? (nM - fm) : wgm;
        u.pm = fm + ((wgid % nig) % gsz); u.pn = (wgid % nig) / gsz; u.e = 0; u.rt = 0; u.slot = i; u.nvalid = BM; return true;
    }
    __device__ __forceinline__ const char* a_tile(const Unit& u) const { return (const char*)A + (size_t)u.pm * ((size_t)BM * K * 2); }
    __device__ __forceinline__ const char* b_tile(const Unit& u) const { return (const char*)Bt + (size_t)u.pn * ((size_t)BM * K * 2); }
    __device__ __forceinline__ void a_rows(int, const int (&)[2], const int (&)[2], unsigned (&)[2][2]) const {}
};

struct DualSrcOrder : StaticOrder {
    const bf16_t* A2; const bf16_t* B2;
    __device__ __forceinline__ void init2(const bf16_t* A1, const bf16_t* B1, const bf16_t* A2_, const bf16_t* B2_, int M, int N, int K_, int G_, int c_, int wgm_) { init(A1, B1, M, N, K_, G_, c_, wgm_); A2 = A2_; B2 = B2_; }
    __device__ __forceinline__ const char* a_tile2(const Unit& u) const { return (const char*)A2 + (size_t)u.pm * ((size_t)BM * K * 2); }
    __device__ __forceinline__ const char* b_tile2(const Unit& u) const { return (const char*)B2 + (size_t)u.pn * ((size_t)BM * K * 2); }
};

struct PanelOrder {
    const bf16_t* A; const bf16_t* Bt; int K; int nN, c;
    __device__ __forceinline__ bool next(int i, Unit& u) const { if (i >= nN) return false; u.pm = c; u.pn = i; u.e = 0; u.rt = 0; u.slot = i; u.nvalid = BM; return true; }
    __device__ __forceinline__ const char* a_tile(const Unit& u) const { return (const char*)A + (size_t)u.pm * ((size_t)BM * K * 2); }
    __device__ __forceinline__ const char* b_tile(const Unit& u) const { return (const char*)Bt + (size_t)u.pn * ((size_t)BM * K * 2); }
    __device__ __forceinline__ void a_rows(int, const int (&)[2], const int (&)[2], unsigned (&)[2][2]) const {}
};

struct HotOrder {
    const bf16_t* A; const bf16_t* Bt; int K; int n, c, pn;
    __device__ __forceinline__ bool next(int i, Unit& u) const { if (i >= n) return false; u.pm = c & 7; u.pn = pn; u.e = 0; u.rt = 0; u.slot = i; u.nvalid = BM; return true; }
    __device__ __forceinline__ const char* a_tile(const Unit& u) const { return (const char*)A + (size_t)u.pm * ((size_t)BM * K * 2); }
    __device__ __forceinline__ const char* b_tile(const Unit& u) const { return (const char*)Bt + (size_t)u.pn * ((size_t)BM * K * 2); }
    __device__ __forceinline__ void a_rows(int, const int (&)[2], const int (&)[2], unsigned (&)[2][2]) const {}
};
struct EpiNull {
    static constexpr bool PERM = true, AFTER_DRAIN = false; static constexpr int BMAP = 1;
    float* dump;
    static constexpr int NST = 0;
    __device__ __forceinline__ void operator()(f32x4 (&acc)[2][2][4][2], const Unit& u, int wr, int wc, int fr, int fq) const {
        f32x4 s = (f32x4){0.f, 0.f, 0.f, 0.f};
#pragma unroll
        for (int ai = 0; ai < 2; ++ai)
#pragma unroll
            for (int bj = 0; bj < 2; ++bj)
#pragma unroll
                for (int m = 0; m < 4; ++m)
#pragma unroll
                    for (int n = 0; n < 2; ++n) s += acc[ai][bj][m][n];
        *(f32x4*)(dump + (size_t)(blockIdx.x * 512 + threadIdx.x) * 4) = s;
#pragma unroll
        for (int ai = 0; ai < 2; ++ai)
#pragma unroll
            for (int bj = 0; bj < 2; ++bj)
#pragma unroll
                for (int m = 0; m < 4; ++m) { acc[ai][bj][m][0] = (f32x4){0.f, 0.f, 0.f, 0.f}; acc[ai][bj][m][1] = (f32x4){0.f, 0.f, 0.f, 0.f}; }
    }
};

constexpr int MOE_SLOTS = 10;
struct MoeOrder {
    const bf16_t* A; const bf16_t* Bt; int K; size_t bexp;
    const PG8_LAS i32x4* desc; const PG8_LAS int* rstart; const PG8_LAS unsigned* idx; bool gather;
    __device__ __forceinline__ bool next(int i, Unit& u) const {
        if (i >= MOE_SLOTS) return false;
        const i32x4 d = desc[i]; const int nv = __builtin_amdgcn_readfirstlane(d.w); if (nv <= 0) return false;
        u.e = __builtin_amdgcn_readfirstlane(d.x); u.rt = __builtin_amdgcn_readfirstlane(d.y); u.pn = __builtin_amdgcn_readfirstlane(d.z); u.nvalid = nv; u.slot = i; u.pm = 0; return true;
    }
    __device__ __forceinline__ const char* a_tile(const Unit& u) const {
        if (gather) return (const char*)A;
        const int r0 = __builtin_amdgcn_readfirstlane(rstart[u.e]) + BM * u.rt; return (const char*)A + (size_t)r0 * ((size_t)K * 2); }
    __device__ __forceinline__ const char* b_tile(const Unit& u) const { return (const char*)Bt + (size_t)u.e * bexp + (size_t)u.pn * ((size_t)BM * K * 2); }
    __device__ __forceinline__ void a_rows(int slot, const int (&Rp)[2], const int (&Cp)[2], unsigned (&voff)[2][2]) const {
#pragma unroll
        for (int h = 0; h < 2; ++h)
#pragma unroll
            for (int p = 0; p < 2; ++p) { const unsigned ent = idx[slot * BM + h * HALF + Rp[p]]; voff[h][p] = (ent >> 1) * (unsigned)(K * 2) + (unsigned)(Cp[p] * 2); }
    }
};

__device__ __forceinline__ unsigned cvt_pk_bf16(float lo, float hi) { unsigned r; asm volatile("v_cvt_pk_bf16_f32 %0, %1, %2" : "=v"(r) : "v"(lo), "v"(hi)); return r; }
__device__ __forceinline__ float bf_lo(unsigned w) { return __uint_as_float(w << 16); }
__device__ __forceinline__ float bf_hi(unsigned w) { return __uint_as_float(w & 0xffff0000u); }
__device__ __forceinline__ float sigmoid_f(float x) { return __builtin_amdgcn_rcpf(1.0f + __builtin_amdgcn_exp2f(-1.4426950408889634f * x)); }
__device__ __forceinline__ u32x4 pack8(const f32x4 v0, const f32x4 v1) { u32x4 w; w.x = cvt_pk_bf16(v0[0], v0[1]); w.y = cvt_pk_bf16(v0[2], v0[3]); w.z = cvt_pk_bf16(v1[0], v1[1]); w.w = cvt_pk_bf16(v1[2], v1[3]); return w; }

__device__ __forceinline__ unsigned gate_q(float x) { return __float_as_uint(__builtin_fmaf(sigmoid_f(x), 255.0f, 8388608.0f)); }
__device__ __forceinline__ unsigned gate_pack4(unsigned t0, unsigned t1, unsigned t2, unsigned t3) { return __builtin_amdgcn_perm(t1, t0, 0x0c0c0400u) | __builtin_amdgcn_perm(t3, t2, 0x04000c0cu); }
__device__ __forceinline__ float gate_f(unsigned w, int b) { return (float)((w >> (8 * b)) & 0xffu) * (1.0f / 255.0f); }
struct EpiProj {
    static constexpr bool PERM = true, AFTER_DRAIN = false; static constexpr int BMAP = 2;
    static constexpr int NST = 0;
    bf16_t *Z, *Bb, *Q, *Kk, *V, *SGC, *SGA; float qscale; PG8_LAS unsigned char* stg;
    __device__ __forceinline__ void operator()(f32x4 (&acc)[2][2][4][2], const Unit& u, int wr, int wc, int fr, int fq) const {
        if (u.pn < 8) {
            const int row0 = u.pm * BM + wr * 64 + fr, col0 = u.pn * HALF + wc * 32 + 8 * fq;
#pragma unroll
            for (int ai = 0; ai < 2; ++ai)
#pragma unroll
                for (int m = 0; m < 4; ++m) { bf16_t* rowp = Z + (size_t)(row0 + ai * HALF + m * 16) * 1024 + col0;
                    *(u32x4*)rowp = pack8(acc[ai][0][m][0] * acc[ai][1][m][0], acc[ai][0][m][1] * acc[ai][1][m][1]);
                    acc[ai][0][m][0] = (f32x4){0.f, 0.f, 0.f, 0.f}; acc[ai][0][m][1] = (f32x4){0.f, 0.f, 0.f, 0.f}; acc[ai][1][m][0] = (f32x4){0.f, 0.f, 0.f, 0.f}; acc[ai][1][m][1] = (f32x4){0.f, 0.f, 0.f, 0.f}; }
        } else if (u.pn >= 24) {
            unsigned char* base = (unsigned char*)(u.pn < 28 ? SGC : SGA); const int lane = fq * 16 + fr;
            PG8_LAS unsigned char* wp = stg + fr * 80 + fq * 8;
            const PG8_LAS unsigned char* rp = stg + (lane >> 2) * 80 + (lane & 3) * 16;
            unsigned char* gp = base + (size_t)(u.pm * BM + wr * 64 + (lane >> 2)) * 1024 + (u.pn & 3) * BM + wc * 64 + (lane & 3) * 16;
#pragma unroll
            for (int ai = 0; ai < 2; ++ai)
#pragma unroll
                for (int m = 0; m < 4; ++m) {
#pragma unroll
                    for (int bj = 0; bj < 2; ++bj) { const f32x4 v0 = acc[ai][bj][m][0], v1 = acc[ai][bj][m][1]; u32x2 w;
                        w.x = gate_pack4(gate_q(v0[0]), gate_q(v0[1]), gate_q(v0[2]), gate_q(v0[3])); w.y = gate_pack4(gate_q(v1[0]), gate_q(v1[1]), gate_q(v1[2]), gate_q(v1[3]));
                        *(PG8_LAS u32x2*)(wp + bj * 32) = w; acc[ai][bj][m][0] = (f32x4){0.f, 0.f, 0.f, 0.f}; acc[ai][bj][m][1] = (f32x4){0.f, 0.f, 0.f, 0.f}; }
                    const u32x4 r0 = *(const PG8_LAS u32x4*)rp;
                    *(u32x4*)(gp + (size_t)(ai * HALF + m * 16) * 1024) = r0; }
        } else {
            const int t = (u.pn - 8) >> 2; bf16_t* base = Bb + (t ? (Q - Bb) + (long)(t - 1) * (Kk - Q) : 0L);
            const float sc = (t == 1) ? qscale : 1.0f; const int lane = fq * 16 + fr;
            PG8_LAS unsigned char* wp = stg + fr * 144 + fq * 16;
            const PG8_LAS unsigned char* rp = stg + (lane >> 3) * 144 + (lane & 7) * 16;
            bf16_t* gp = base + (size_t)(u.pm * BM + wr * 64 + (lane >> 3)) * 1024 + ((u.pn - 8) & 3) * BM + wc * 64 + (lane & 7) * 8;
#pragma unroll
            for (int ai = 0; ai < 2; ++ai)
#pragma unroll
                for (int m = 0; m < 4; ++m) {
#pragma unroll
                    for (int bj = 0; bj < 2; ++bj) { f32x4 v0 = acc[ai][bj][m][0], v1 = acc[ai][bj][m][1];
                        v0 = v0 * sc; v1 = v1 * sc;
                        *(PG8_LAS u32x4*)(wp + bj * 64) = pack8(v0, v1); acc[ai][bj][m][0] = (f32x4){0.f, 0.f, 0.f, 0.f}; acc[ai][bj][m][1] = (f32x4){0.f, 0.f, 0.f, 0.f}; }
                    const u32x4 r0 = *(const PG8_LAS u32x4*)rp, r1 = *(const PG8_LAS u32x4*)(rp + 8 * 144);
                    bf16_t* g0 = gp + (size_t)(ai * HALF + m * 16) * 1024;
                    *(u32x4*)g0 = r0; *(u32x4*)(g0 + 8 * 1024) = r1; }
        }
    }
};
template <bool ADD> struct EpiGate {
    static constexpr bool PERM = true, AFTER_DRAIN = false; static constexpr int BMAP = 2;
    const unsigned char* G; bf16_t* Mo; PG8_LAS unsigned char* stg;
    static constexpr int NST = 0;
    __device__ __forceinline__ void operator()(f32x4 (&acc)[2][2][4][2], const Unit& u, int wr, int wc, int fr, int fq) const {
        const int row0 = u.pm * BM + wr * 64 + fr, col0 = u.pn * BM + wc * 64 + 8 * fq, lane = fq * 16 + fr;
        PG8_LAS unsigned char* wp = stg + fr * 144 + fq * 16; const PG8_LAS unsigned char* rp = stg + (lane >> 3) * 144 + (lane & 7) * 16;
        bf16_t* gp = Mo + (size_t)(u.pm * BM + wr * 64 + (lane >> 3)) * 1024 + u.pn * BM + wc * 64 + (lane & 7) * 8;
        u32x2 ga[2][4][2];
#pragma unroll
        for (int ai = 0; ai < 2; ++ai)
#pragma unroll
            for (int m = 0; m < 4; ++m)
#pragma unroll
                for (int bj = 0; bj < 2; ++bj) ga[ai][m][bj] = *(const u32x2*)(G + (size_t)(row0 + ai * HALF + m * 16) * 1024 + col0 + bj * 32);
#pragma unroll
        for (int ai = 0; ai < 2; ++ai) {
            u32x4 o[4][2];
            if (ADD) {
#pragma unroll
                for (int m = 0; m < 4; ++m)
#pragma unroll
                    for (int bj = 0; bj < 2; ++bj) o[m][bj] = *(const u32x4*)(Mo + (size_t)(row0 + ai * HALF + m * 16) * 1024 + col0 + bj * 32); }
            u32x2 (&g)[4][2] = ga[ai];
#pragma unroll
            for (int m = 0; m < 4; ++m) {
#pragma unroll
                for (int bj = 0; bj < 2; ++bj) { const u32x2 gg = g[m][bj]; f32x4 v0 = acc[ai][bj][m][0], v1 = acc[ai][bj][m][1];
                    v0[0] *= gate_f(gg.x, 0); v0[1] *= gate_f(gg.x, 1); v0[2] *= gate_f(gg.x, 2); v0[3] *= gate_f(gg.x, 3); v1[0] *= gate_f(gg.y, 0); v1[1] *= gate_f(gg.y, 1); v1[2] *= gate_f(gg.y, 2); v1[3] *= gate_f(gg.y, 3);
                    if (ADD) { const u32x4 oo = o[m][bj];
                        v0[0] += bf_lo(oo.x); v0[1] += bf_hi(oo.x); v0[2] += bf_lo(oo.y); v0[3] += bf_hi(oo.y); v1[0] += bf_lo(oo.z); v1[1] += bf_hi(oo.z); v1[2] += bf_lo(oo.w); v1[3] += bf_hi(oo.w); }
                    *(PG8_LAS u32x4*)(wp + bj * 64) = pack8(v0, v1); acc[ai][bj][m][0] = (f32x4){0.f, 0.f, 0.f, 0.f}; acc[ai][bj][m][1] = (f32x4){0.f, 0.f, 0.f, 0.f}; }
                const u32x4 r0 = *(const PG8_LAS u32x4*)rp, r1 = *(const PG8_LAS u32x4*)(rp + 8 * 144);
                bf16_t* g0 = gp + (size_t)(ai * HALF + m * 16) * 1024;
                *(u32x4*)g0 = r0; *(u32x4*)(g0 + 8 * 1024) = r1; }
        }
    }
};
struct EpiGateFused {
    static constexpr bool PERM = true, AFTER_DRAIN = false; static constexpr int BMAP = 2;
    const unsigned char* GC; const unsigned char* GA; bf16_t* Mo; PG8_LAS unsigned char* stg;
    static constexpr int NST = 0;
    static __device__ __forceinline__ float qf(unsigned w, int b) { return (float)((w >> (8 * b)) & 0xffu); }
    static __device__ __forceinline__ float qa_eff(unsigned w, int b) { return __builtin_fmaxf(qf(w, b), 9.5367431640625e-07f); }
    __device__ __forceinline__ void mid(f32x4 (&acc)[2][2][4][2], const Unit& u, int wr, int wc, int fr, int fq) const {
        int row0 = u.pm * BM + wr * 64 + fr, col0 = u.pn * BM + wc * 64 + 8 * fq;
        asm volatile("" : "+v"(row0), "+v"(col0));
#pragma unroll
        for (int am = 0; am < 4; ++am) {
            const int ai = am >> 1, mb = 2 * (am & 1);
            u32x2 c[2][2], a[2][2];
#pragma unroll
            for (int m = 0; m < 2; ++m)
#pragma unroll
                for (int bj = 0; bj < 2; ++bj) { const unsigned off = (unsigned)((row0 + ai * HALF + (mb + m) * 16) * 1024 + col0 + bj * 32); c[m][bj] = *(const u32x2*)(GC + off); a[m][bj] = *(const u32x2*)(GA + off); }
#pragma unroll
            for (int m = 0; m < 2; ++m)
#pragma unroll
                for (int bj = 0; bj < 2; ++bj)
#pragma unroll
                    for (int j = 0; j < 4; ++j) { acc[ai][bj][mb + m][0][j] *= qf(c[m][bj].x, j) * __builtin_amdgcn_rcpf(qa_eff(a[m][bj].x, j)); acc[ai][bj][mb + m][1][j] *= qf(c[m][bj].y, j) * __builtin_amdgcn_rcpf(qa_eff(a[m][bj].y, j)); }
        }
    }
    __device__ __forceinline__ void operator()(f32x4 (&acc)[2][2][4][2], const Unit& u, int wr, int wc, int fr, int fq) const {
        const int row0 = u.pm * BM + wr * 64 + fr, col0 = u.pn * BM + wc * 64 + 8 * fq, lane = fq * 16 + fr;
        PG8_LAS unsigned char* wp = stg + fr * 144 + fq * 16; const PG8_LAS unsigned char* rp = stg + (lane >> 3) * 144 + (lane & 7) * 16;
        bf16_t* gp = Mo + (size_t)(u.pm * BM + wr * 64 + (lane >> 3)) * 1024 + u.pn * BM + wc * 64 + (lane & 7) * 8;
        u32x2 ga[2][4][2];
#pragma unroll
        for (int ai = 0; ai < 2; ++ai)
#pragma unroll
            for (int m = 0; m < 4; ++m)
#pragma unroll
                for (int bj = 0; bj < 2; ++bj) ga[ai][m][bj] = *(const u32x2*)(GA + (unsigned)((row0 + ai * HALF + m * 16) * 1024 + col0 + bj * 32));
#pragma unroll
        for (int ai = 0; ai < 2; ++ai)
#pragma unroll
            for (int m = 0; m < 4; ++m) {
#pragma unroll
                for (int bj = 0; bj < 2; ++bj) { const u32x2 gg = ga[ai][m][bj]; f32x4 v0 = acc[ai][bj][m][0], v1 = acc[ai][bj][m][1];
#pragma unroll
                    for (int j = 0; j < 4; ++j) { v0[j] *= qa_eff(gg.x, j) * (1.0f / 255.0f); v1[j] *= qa_eff(gg.y, j) * (1.0f / 255.0f); }
                    *(PG8_LAS u32x4*)(wp + bj * 64) = pack8(v0, v1); acc[ai][bj][m][0] = (f32x4){0.f, 0.f, 0.f, 0.f}; acc[ai][bj][m][1] = (f32x4){0.f, 0.f, 0.f, 0.f}; }
                const u32x4 r0 = *(const PG8_LAS u32x4*)rp, r1 = *(const PG8_LAS u32x4*)(rp + 8 * 144);
                bf16_t* g0 = gp + (size_t)(ai * HALF + m * 16) * 1024;
                *(u32x4*)g0 = r0; *(u32x4*)(g0 + 8 * 1024) = r1; }
    }
};
struct EpiRes {
    static constexpr bool PERM = true, AFTER_DRAIN = false; static constexpr int BMAP = 2;
    const float* R; bf16_t* C; PG8_LAS unsigned char* stg;
    static constexpr int NST = 0;
    __device__ __forceinline__ void operator()(f32x4 (&acc)[2][2][4][2], const Unit& u, int wr, int wc, int fr, int fq) const {
        const int row0 = u.pm * BM + wr * 64 + fr, col0 = u.pn * BM + wc * 64 + 8 * fq, lane = fq * 16 + fr;
        PG8_LAS unsigned char* wp = stg + fr * 144 + fq * 16; const PG8_LAS unsigned char* rp = stg + (lane >> 3) * 144 + (lane & 7) * 16;
        bf16_t* gp = C + (size_t)(u.pm * BM + wr * 64 + (lane >> 3)) * 1024 + u.pn * BM + wc * 64 + (lane & 7) * 8;
#pragma unroll
        for (int ai = 0; ai < 2; ++ai) {
            f32x4 r[4][2][2];
#pragma unroll
            for (int m = 0; m < 4; ++m)
#pragma unroll
                for (int bj = 0; bj < 2; ++bj)
#pragma unroll
                    for (int n = 0; n < 2; ++n) r[m][bj][n] = *(const f32x4*)(R + (size_t)(row0 + ai * HALF + m * 16) * 1024 + col0 + bj * 32 + n * 4);
#pragma unroll
            for (int m = 0; m < 4; ++m) {
#pragma unroll
                for (int bj = 0; bj < 2; ++bj) { *(PG8_LAS u32x4*)(wp + bj * 64) = pack8(r[m][bj][0] + acc[ai][bj][m][0], r[m][bj][1] + acc[ai][bj][m][1]); acc[ai][bj][m][0] = (f32x4){0.f, 0.f, 0.f, 0.f}; acc[ai][bj][m][1] = (f32x4){0.f, 0.f, 0.f, 0.f}; }
                const u32x4 q0 = *(const PG8_LAS u32x4*)rp, q1 = *(const PG8_LAS u32x4*)(rp + 8 * 144);
                bf16_t* g0 = gp + (size_t)(ai * HALF + m * 16) * 1024;
                *(u32x4*)g0 = q0; *(u32x4*)(g0 + 8 * 1024) = q1; }
        }
    }
};
struct EpiResXN {
    static constexpr bool PERM = true, AFTER_DRAIN = false; static constexpr int BMAP = 2;
    const bf16_t* XNp; const float* RINV; const float* gain; bf16_t* C; PG8_LAS unsigned char* stg;
    static constexpr int NST = 0;
    __device__ __forceinline__ void operator()(f32x4 (&acc)[2][2][4][2], const Unit& u, int wr, int wc, int fr, int fq) const {
        const int row0 = u.pm * BM + wr * 64 + fr, col0 = u.pn * BM + wc * 64 + 8 * fq, lane = fq * 16 + fr;
        PG8_LAS unsigned char* wp = stg + fr * 144 + fq * 16; const PG8_LAS unsigned char* rp = stg + (lane >> 3) * 144 + (lane & 7) * 16;
        bf16_t* gp = C + (size_t)(u.pm * BM + wr * 64 + (lane >> 3)) * 1024 + u.pn * BM + wc * 64 + (lane & 7) * 8;
        f32x4 gi[2][2];
#pragma unroll
        for (int bj = 0; bj < 2; ++bj)
#pragma unroll
            for (int n = 0; n < 2; ++n) { const f32x4 gv = *(const f32x4*)(gain + col0 + bj * 32 + n * 4); gi[bj][n] = (f32x4){1.0f / gv[0], 1.0f / gv[1], 1.0f / gv[2], 1.0f / gv[3]}; }
#pragma unroll
        for (int ai = 0; ai < 2; ++ai) {
            u32x4 xn[4][2]; float ri[4];
#pragma unroll
            for (int m = 0; m < 4; ++m) { ri[m] = RINV[row0 + ai * HALF + m * 16];
#pragma unroll
                for (int bj = 0; bj < 2; ++bj) xn[m][bj] = *(const u32x4*)(XNp + (size_t)(row0 + ai * HALF + m * 16) * 1024 + col0 + bj * 32); }
#pragma unroll
            for (int m = 0; m < 4; ++m) {
#pragma unroll
                for (int bj = 0; bj < 2; ++bj) { const u32x4 q = xn[m][bj]; const float r = ri[m]; f32x4 v0 = acc[ai][bj][m][0], v1 = acc[ai][bj][m][1];
                    v0[0] += bf_lo(q.x) * r * gi[bj][0][0]; v0[1] += bf_hi(q.x) * r * gi[bj][0][1]; v0[2] += bf_lo(q.y) * r * gi[bj][0][2]; v0[3] += bf_hi(q.y) * r * gi[bj][0][3];
                    v1[0] += bf_lo(q.z) * r * gi[bj][1][0]; v1[1] += bf_hi(q.z) * r * gi[bj][1][1]; v1[2] += bf_lo(q.w) * r * gi[bj][1][2]; v1[3] += bf_hi(q.w) * r * gi[bj][1][3];
                    *(PG8_LAS u32x4*)(wp + bj * 64) = pack8(v0, v1); acc[ai][bj][m][0] = (f32x4){0.f, 0.f, 0.f, 0.f}; acc[ai][bj][m][1] = (f32x4){0.f, 0.f, 0.f, 0.f}; }
                const u32x4 q0 = *(const PG8_LAS u32x4*)rp, q1 = *(const PG8_LAS u32x4*)(rp + 8 * 144);
                bf16_t* g0 = gp + (size_t)(ai * HALF + m * 16) * 1024;
                *(u32x4*)g0 = q0; *(u32x4*)(g0 + 8 * 1024) = q1; }
        }
    }
};
struct EpiSilu {
    static constexpr bool PERM = true, AFTER_DRAIN = false; static constexpr int BMAP = 1;
    static constexpr int NST = 0;
    bf16_t* ACT; const PG8_LAS int* rstart; const PG8_LAS float* rs;
    __device__ __forceinline__ void operator()(f32x4 (&acc)[2][2][4][2], const Unit& u, int wr, int wc, int fr, int fq) const {
        const int rbase = __builtin_amdgcn_readfirstlane(rstart[u.e]) + BM * u.rt, col0 = u.pn * HALF + wc * 32 + 8 * fq;
#pragma unroll
        for (int ai = 0; ai < 2; ++ai)
#pragma unroll
            for (int m = 0; m < 4; ++m) { const int r = ai * HALF + wr * 64 + m * 16 + fr;
                if (r < u.nvalid) { f32x4 v0, v1; const float s = rs[u.slot * BM + r];
#pragma unroll
                    for (int j = 0; j < 4; ++j) { const float a0 = s * acc[ai][0][m][0][j], a1 = s * acc[ai][0][m][1][j]; v0[j] = a0 * sigmoid_f(a0) * (s * acc[ai][1][m][0][j]); v1[j] = a1 * sigmoid_f(a1) * (s * acc[ai][1][m][1][j]); }
                    *(u32x4*)(ACT + (size_t)(rbase + r) * 512 + col0) = pack8(v0, v1); }
                acc[ai][0][m][0] = (f32x4){0.f, 0.f, 0.f, 0.f}; acc[ai][0][m][1] = (f32x4){0.f, 0.f, 0.f, 0.f}; acc[ai][1][m][0] = (f32x4){0.f, 0.f, 0.f, 0.f}; acc[ai][1][m][1] = (f32x4){0.f, 0.f, 0.f, 0.f}; }
    }
};
struct EpiDown {
    static constexpr bool PERM = true, AFTER_DRAIN = false; static constexpr int BMAP = 2;
    bf16_t* Y; const PG8_LAS int* rstart; const PG8_LAS float* wt; PG8_LAS unsigned char* stg;
    static constexpr int NST = 0;
    __device__ __forceinline__ void operator()(f32x4 (&acc)[2][2][4][2], const Unit& u, int wr, int wc, int fr, int fq) const {
        const int rbase = __builtin_amdgcn_readfirstlane(rstart[u.e]) + BM * u.rt, lane = fq * 16 + fr;
        PG8_LAS unsigned char* wp = stg + fr * 144 + fq * 16;
        const PG8_LAS unsigned char* rp = stg + (lane >> 3) * 144 + (lane & 7) * 16;
        bf16_t* gp = Y + (size_t)(rbase + wr * 64 + (lane >> 3)) * 1024 + u.pn * BM + wc * 64 + (lane & 7) * 8;
#pragma unroll
        for (int ai = 0; ai < 2; ++ai)
#pragma unroll
            for (int m = 0; m < 4; ++m) { const int r = ai * HALF + wr * 64 + m * 16 + fr; const float w = wt[u.slot * BM + r];
#pragma unroll
                for (int bj = 0; bj < 2; ++bj) { *(PG8_LAS u32x4*)(wp + bj * 64) = pack8(acc[ai][bj][m][0] * w, acc[ai][bj][m][1] * w); acc[ai][bj][m][0] = (f32x4){0.f, 0.f, 0.f, 0.f}; acc[ai][bj][m][1] = (f32x4){0.f, 0.f, 0.f, 0.f}; }
                const u32x4 r0 = *(const PG8_LAS u32x4*)rp, r1 = *(const PG8_LAS u32x4*)(rp + 8 * 144);
                const int rs = ai * HALF + wr * 64 + m * 16 + (lane >> 3); bf16_t* g0 = gp + (size_t)(ai * HALF + m * 16) * 1024;
                const bf16_t* g1 = g0 + 8 * 1024;
                if (rs < u.nvalid) asm volatile("global_store_dwordx4 %0, %1, off nt" :: "v"(g0), "v"(r0) : "memory");
                if (rs + 8 < u.nvalid) asm volatile("global_store_dwordx4 %0, %1, off nt" :: "v"(g1), "v"(r1) : "memory"); }
    }
};

template <class Epi, class Sched, bool ALIGN_EPI, bool GATHER, bool DUAL = false>
__device__ __forceinline__ void gemm_phase(PG8_LAS unsigned char* lds, const int K, const Sched& S, const Epi& E, unsigned char* dump = nullptr) {
    int tid_ = threadIdx.x; asm volatile("" : "+v"(tid_));
    const int tid = tid_, wid = __builtin_amdgcn_readfirstlane(tid >> 6), lane = tid & 63, wr = wid >> 2, wc = wid & 3, fr = lane & 15, fq = lane >> 4;
    const int nth = K / BK, nt = DUAL ? 2 * nth : nth;
    unsigned voffB[2][2], voffC[2][2], voffN[2][2]; int Rp[2], Cp[2];
#pragma unroll
    for (int i = 0; i < 2; ++i) { int R, C; stage_rc(tid * 16 + i * 8192, R, C); Rp[i] = R; Cp[i] = C;
#pragma unroll
        for (int hh = 0; hh < 2; ++hh) { const int Rb = Epi::BMAP == 2 ? (64 * (R >> 5) + 32 * hh + perm32(R & 31)) : (HALF * hh + (Epi::PERM ? ((R & ~31) + perm32(R & 31)) : R)); voffB[hh][i] = (unsigned)(Rb * K + C) * 2u; }
        voffC[0][i] = (unsigned)(R * K + C) * 2u; voffC[1][i] = (unsigned)((R + HALF) * K + C) * 2u; voffN[0][i] = voffC[0][i]; voffN[1][i] = voffC[1][i]; }
    const size_t kstep = (size_t)(BK * 2);
    const unsigned ldsw = (unsigned)wid * 1024u;
    const int aoff = lds_byte(wr * 64 + fr, fq * 8), boff = lds_byte(wc * 32 + fr, fq * 8);
#define PG8_SA(b, h) (((b) * 2 + (h)) * HTB)
#define PG8_SB(b, h) ((4 + (b) * 2 + (h)) * HTB)
#define PG8_STAGE(bufoff, gbase, voff) do { _Pragma("unroll") for (int _i = 0; _i < 2; ++_i) \
        __builtin_amdgcn_global_load_lds((const unsigned*)((const char*)(gbase) + (voff)[_i]), (PG8_LAS unsigned*)(lds + (bufoff) + ldsw + _i * 8192), 16, 0, 0); } while (0)
#define PG8_LDA(dst, b, h) do { _Pragma("unroll") for (int m = 0; m < 4; ++m) _Pragma("unroll") for (int k = 0; k < 2; ++k) dst[m][k] = *(const PG8_LAS bf16x8*)(lds + PG8_SA(b, h) + aoff + m * 2048 + k * 1024); } while (0)
#define PG8_LDB(dst, b, h) do { _Pragma("unroll") for (int n = 0; n < 2; ++n) _Pragma("unroll") for (int k = 0; k < 2; ++k) dst[n][k] = *(const PG8_LAS bf16x8*)(lds + PG8_SB(b, h) + boff + n * 2048 + k * 1024); } while (0)
#define PG8_MMA(ai, bj, At, Bt) do { __builtin_amdgcn_s_setprio(1); _Pragma("unroll") for (int m = 0; m < 4; ++m) _Pragma("unroll") for (int n = 0; n < 2; ++n) _Pragma("unroll") for (int k = 0; k < 2; ++k) \
        acc[ai][bj][m][n] = __builtin_amdgcn_mfma_f32_16x16x32_bf16(Bt[n][k], At[m][k], acc[ai][bj][m][n], 0, 0, 0); __builtin_amdgcn_s_setprio(0); } while (0)
#define PG8_WAIT_V(n) asm volatile("s_waitcnt vmcnt(" #n ")" ::: "memory")
#define PG8_WAIT_VR(rlx) do { if constexpr (Epi::NST == 16) asm volatile("s_waitcnt vmcnt(24)\n\ts_cmp_lg_u32 %0, 0\n\ts_cbranch_scc1 .Lrlx_%=\n\ts_waitcnt vmcnt(8)\n.Lrlx_%=:" :: "s"(rlx) : "memory", "scc"); \
        else if constexpr (Epi::NST == 8) asm volatile("s_waitcnt vmcnt(16)\n\ts_cmp_lg_u32 %0, 0\n\ts_cbranch_scc1 .Lrlx_%=\n\ts_waitcnt vmcnt(8)\n.Lrlx_%=:" :: "s"(rlx) : "memory", "scc"); else PG8_WAIT_V(8); } while (0)
#define PG8_WAIT_L(n) asm volatile("s_waitcnt lgkmcnt(" #n ")" ::: "memory")
#define PG8_BAR __builtin_amdgcn_s_barrier()
#define PG8_SCHED __builtin_amdgcn_sched_barrier(0)
    Unit cur, nxt; int ui = 0;
    if (!S.next(0, cur)) return;
    if constexpr (GATHER) S.a_rows(0, Rp, Cp, voffC);
    f32x4 acc[2][2][4][2];
#pragma unroll
    for (int a = 0; a < 2; ++a)
#pragma unroll
        for (int b = 0; b < 2; ++b)
#pragma unroll
            for (int m = 0; m < 4; ++m)
#pragma unroll
                for (int n = 0; n < 2; ++n) acc[a][b][m][n] = (f32x4){0.f, 0.f, 0.f, 0.f};
    bf16x8 At[4][2], B0[2][2], B1[2][2];
    const char* cA = S.a_tile(cur); const char* cB = S.b_tile(cur);
    const char* cA2 = cA; const char* cB2 = cB;
    if constexpr (DUAL) { cA2 = S.a_tile2(cur) - (size_t)nth * (size_t)(BK * 2); cB2 = S.b_tile2(cur) - (size_t)nth * (size_t)(BK * 2); }
    PG8_STAGE(PG8_SB(0, 0), cB, voffB[0]); PG8_STAGE(PG8_SB(0, 1), cB, voffB[1]); PG8_STAGE(PG8_SA(0, 0), cA, voffC[0]); PG8_STAGE(PG8_SA(0, 1), cA, voffC[1]);
    if (wr == 1) PG8_BAR;
    PG8_WAIT_V(2); PG8_BAR;
    PG8_STAGE(PG8_SB(1, 0), cB + kstep, voffB[0]); PG8_STAGE(PG8_SA(1, 0), cA + kstep, voffC[0]); PG8_STAGE(PG8_SB(1, 1), cB + kstep, voffB[1]);
    PG8_WAIT_V(6); PG8_BAR;
    (void)dump;
    for (;;) {
        const bool has_next = S.next(ui + 1, nxt);
        const char* nA = has_next ? S.a_tile(nxt) : cA; const char* nB = has_next ? S.b_tile(nxt) : cB;
        if constexpr (GATHER) { if (has_next) S.a_rows(ui + 1, Rp, Cp, voffN); else {
#pragma unroll
                for (int h = 0; h < 2; ++h)
#pragma unroll
                    for (int p = 0; p < 2; ++p) voffN[h][p] = voffC[h][p]; } }
#define PG8_KTRIP(FIRST_) do { \
            const bool last = (t == nt - 2); \
            const char* a1 = ((DUAL && t >= nth) ? cA2 : cA) + (size_t)(t + 1) * kstep; \
            const char* a2 = last ? nA : ((DUAL && t + 2 >= nth) ? cA2 : cA) + (size_t)(t + 2) * kstep; const char* b2 = last ? nB : ((DUAL && t + 2 >= nth) ? cB2 : cB) + (size_t)(t + 2) * kstep; \
            const char* a3 = a2 + kstep; const char* b3 = b2 + kstep; \
            unsigned vo2[2][2]; \
            _Pragma("unroll") \
            for (int h = 0; h < 2; ++h) \
            _Pragma("unroll") \
                for (int p = 0; p < 2; ++p) vo2[h][p] = (GATHER && last) ? voffN[h][p] : voffC[h][p]; \
            PG8_LDB(B0, 0, 0); PG8_LDB(B1, 0, 1); PG8_SCHED; PG8_LDA(At, 0, 0); PG8_STAGE(PG8_SA(1, 1), a1, voffC[1]); \
            PG8_WAIT_VR(FIRST_); PG8_WAIT_L(0); PG8_BAR; PG8_MMA(0, 0, At, B0); PG8_MMA(0, 1, At, B1); PG8_BAR; PG8_SCHED; \
            PG8_LDA(At, 0, 1); PG8_STAGE(PG8_SB(0, 0), b2, voffB[0]); PG8_STAGE(PG8_SB(0, 1), b2, voffB[1]); PG8_STAGE(PG8_SA(0, 0), a2, vo2[0]); \
            PG8_WAIT_VR(FIRST_); PG8_WAIT_L(0); PG8_BAR; PG8_MMA(1, 0, At, B0); PG8_MMA(1, 1, At, B1); PG8_BAR; PG8_SCHED; \
            PG8_LDB(B0, 1, 0); PG8_LDB(B1, 1, 1); PG8_SCHED; PG8_LDA(At, 1, 0); PG8_STAGE(PG8_SA(0, 1), a2, vo2[1]); \
            PG8_WAIT_V(8); PG8_WAIT_L(0); PG8_BAR; PG8_MMA(0, 0, At, B0); PG8_MMA(0, 1, At, B1); PG8_BAR; PG8_SCHED; \
            PG8_LDA(At, 1, 1); PG8_STAGE(PG8_SB(1, 0), b3, voffB[0]); PG8_STAGE(PG8_SB(1, 1), b3, voffB[1]); PG8_STAGE(PG8_SA(1, 0), a3, vo2[0]); \
            PG8_WAIT_V(8); PG8_WAIT_L(0); PG8_BAR; PG8_MMA(1, 0, At, B0); PG8_MMA(1, 1, At, B1); PG8_BAR; PG8_SCHED; \
        } while (0)
        for (int t = 0; t < nt; t += 2) { const int rlx = __builtin_amdgcn_readfirstlane((t == 0 && ui > 0) ? 1 : 0); if constexpr (DUAL) { if (t == nth) E.mid(acc, cur, wr, wc, fr, fq); } PG8_KTRIP(rlx); }
#undef PG8_KTRIP
        if constexpr (ALIGN_EPI) { if (wr == 0) PG8_BAR; }
        E(acc, cur, wr, wc, fr, fq);
        if (!has_next) break;
        cur = nxt; cA = nA; cB = nB; ++ui;
        if constexpr (DUAL) { cA2 = S.a_tile2(cur) - (size_t)nth * (size_t)(BK * 2); cB2 = S.b_tile2(cur) - (size_t)nth * (size_t)(BK * 2); }
        if constexpr (GATHER) {
#pragma unroll
            for (int h = 0; h < 2; ++h)
#pragma unroll
                for (int p = 0; p < 2; ++p) voffC[h][p] = voffN[h][p]; }
        if constexpr (ALIGN_EPI) { if (wr == 1) PG8_BAR; }
    }
    PG8_WAIT_V(0);
    if constexpr (!ALIGN_EPI) { if (wr == 0) PG8_BAR; }
    PG8_BAR;
#undef PG8_SA
#undef PG8_SB
#undef PG8_STAGE
#undef PG8_LDA
#undef PG8_LDB
#undef PG8_MMA
#undef PG8_WAIT_V
#undef PG8_WAIT_VR
#undef PG8_WAIT_L
#undef PG8_BAR
#undef PG8_SCHED
}
}

#include <hip/hip_bf16.h>
#include <cmath>
namespace attn_body {
using bf16=__hip_bfloat16;
using bf16x8=__attribute__((ext_vector_type(8)))short;
using s16x4=__attribute__((ext_vector_type(4)))short;
using f32x16=__attribute__((ext_vector_type(16)))float;
using u32x4=__attribute__((ext_vector_type(4)))unsigned;
using f32x4_t=__attribute__((ext_vector_type(4)))float;
constexpr int BATCH=32,NHEAD=16,SEQ=2048,D=64,DM=NHEAD*D;
constexpr int NW=8,QBLK=32,QB=QBLK*NW,KVBLK=64,NQB=SEQ/QB;
constexpr int ATTN_PITCH=DM, ATTN_UNIT_ROWS=QB;
__device__ __forceinline__ int crow(int r,int hi){return (r&3)+8*(r>>2)+4*hi;}
#define SBAR() __builtin_amdgcn_sched_barrier(0)
__device__ __forceinline__ void cmask(f32x16&p0,f32x16&p1,int jb,int qrel,int hi){
  const float NEG=-INFINITY; int kb=64*jb+4*hi;
  #pragma unroll
  for(int r=0;r<16;++r){int kv=kb+(r&3)+8*(r>>2); if(kv>qrel)p0[r]=NEG; if(kv+32>qrel)p1[r]=NEG;}
}

constexpr int NSLOT=3, SLOTB=8192;
constexpr int LDS_K=0, LDS_V=NSLOT*SLOTB, LDS_WS=2*NSLOT*SLOTB, LDS_OST=LDS_WS+NW*64*4, LDS_REC=LDS_OST+NW*4096, LDS_BYTES=LDS_REC+SEQ*8, LDS_ZR=LDS_BYTES, ZR_ROWS=18, LDS_CW=LDS_ZR+ZR_ROWS*2048, LDS_SIDE_END=LDS_CW+16384;
constexpr float C2=0.125f*1.4426950408889634f;
__device__ __forceinline__ void glds16(const void*gsrc,unsigned lds_dst){unsigned keep;
  asm volatile("s_mov_b32 %0, m0\n\ts_mov_b32 m0, %2\n\ts_nop 0\n\tglobal_load_lds_dwordx4 %1, off\n\ts_mov_b32 m0, %0":"=&s"(keep):"v"(gsrc),"s"(lds_dst):"memory");}
__device__ __forceinline__ float max3f(float a,float b,float c){float r;asm("v_max3_f32 %0, %1, %2, %3":"=v"(r):"v"(a),"v"(b),"v"(c));return r;}
__device__ __forceinline__ float max2f(float a,float b){float r;asm("v_max_f32_e32 %0, %1, %2":"=v"(r):"v"(a),"v"(b));return r;}
__device__ __forceinline__ float fadd_s(float a,float b){float r;asm("v_add_f32_e32 %0, %1, %2":"=v"(r):"v"(a),"v"(b));return r;}
__device__ __forceinline__ float fsub_s(float a,float b){float r;asm("v_sub_f32_e32 %0, %1, %2":"=v"(r):"v"(a),"v"(b));return r;}
typedef float f32x2_t __attribute__((ext_vector_type(2))); typedef __bf16 bf16x2_t __attribute__((ext_vector_type(2)));
__device__ __forceinline__ unsigned cvtpk_s(float lo,float hi){f32x2_t v={lo,hi};bf16x2_t b=__builtin_convertvector(v,bf16x2_t);return __builtin_bit_cast(unsigned,b);}
#define WAIT_BAR(N) asm volatile("s_waitcnt vmcnt(" #N ") lgkmcnt(0)\n\ts_barrier":::"memory")

__device__ __forceinline__ void qkt(f32x16&p0,f32x16&p1,const char*Kslot,const bf16x8*qr,bf16x8 ab0,bf16x8 ab1,bf16x8 bq,int r32,int hi){
  const char*kb=Kslot+hi*1024+r32*16;
  p0=__builtin_amdgcn_mfma_f32_32x32x16_bf16(ab0,bq,f32x16{},0,0,0);p1=__builtin_amdgcn_mfma_f32_32x32x16_bf16(ab1,bq,f32x16{},0,0,0);
  #pragma unroll
  for(int d0=0;d0<4;++d0){
    const bf16x8 b0=*reinterpret_cast<const bf16x8*>(kb+d0*2048);
    const bf16x8 b1=*reinterpret_cast<const bf16x8*>(kb+d0*2048+512);
    p0=__builtin_amdgcn_mfma_f32_32x32x16_bf16(b0,qr[d0],p0,0,0,0);p1=__builtin_amdgcn_mfma_f32_32x32x16_bf16(b1,qr[d0],p1,0,0,0);}
}
__device__ __forceinline__ u32x4 make_bq(float mhat,int hi){
  const float nm=-mhat; const unsigned h1=cvtpk_s(nm,0.f)&0xffffu; const float r1=nm-__uint_as_float(h1<<16);
  const unsigned h2=cvtpk_s(r1,0.f)&0xffffu; const float r2=r1-__uint_as_float(h2<<16); const unsigned h3=cvtpk_s(r2,0.f)&0xffffu;
  u32x4 b; b.x=hi?0u:0x3f803f80u; b.y=hi?0u:(0x3f80u|(h1<<16)); b.z=hi?0u:(h2|(h3<<16)); b.w=0u; return b;
}
typedef unsigned u32x2_t __attribute__((ext_vector_type(2)));
#define ABF(rc) __builtin_bit_cast(bf16x8,(u32x4){(rc).x,(rc).y,0x3f803f80u,0u})
typedef __attribute__((address_space(3))) const char* lds_cptr;
typedef short v4i16_t __attribute__((ext_vector_type(4)));
__device__ __forceinline__ void kload8(bf16x8*kf,lds_cptr kp){
  kf[0]=*(const __attribute__((address_space(3))) bf16x8*)(kp);      kf[1]=*(const __attribute__((address_space(3))) bf16x8*)(kp+512);
  kf[2]=*(const __attribute__((address_space(3))) bf16x8*)(kp+2048); kf[3]=*(const __attribute__((address_space(3))) bf16x8*)(kp+2560);
  kf[4]=*(const __attribute__((address_space(3))) bf16x8*)(kp+4096); kf[5]=*(const __attribute__((address_space(3))) bf16x8*)(kp+4608);
  kf[6]=*(const __attribute__((address_space(3))) bf16x8*)(kp+6144); kf[7]=*(const __attribute__((address_space(3))) bf16x8*)(kp+6656);
}
__device__ __forceinline__ void kload2(bf16x8*kf,lds_cptr kp,int j){ kf[2*j]=*(const __attribute__((address_space(3))) bf16x8*)(kp+j*2048); kf[2*j+1]=*(const __attribute__((address_space(3))) bf16x8*)(kp+j*2048+512); }
__device__ __forceinline__ s16x4 vtr(lds_cptr p){ return __builtin_bit_cast(s16x4,__builtin_amdgcn_ds_read_tr16_b64_v4i16((__attribute__((address_space(3))) v4i16_t*)p)); }
__device__ __forceinline__ float rowmax(const f32x16&p0,const f32x16&p1){
  float a=max3f(p0[0],p0[1],p1[0]),b=max3f(p0[2],p0[3],p1[1]);a=max3f(a,p1[2],p1[3]);
  #pragma unroll
  for(int r=4;r<16;r+=4){a=max3f(a,p0[r],p0[r+1]);b=max3f(b,p0[r+2],p0[r+3]);a=max3f(a,p1[r],p1[r+1]);b=max3f(b,p1[r+2],p1[r+3]);}
  const float m=max2f(a,b);
  auto rr=__builtin_amdgcn_permlane32_swap(__float_as_uint(m),__float_as_uint(m),false,false);
  return max2f(__uint_as_float(rr[0]),__uint_as_float(rr[1]));
}
__device__ __forceinline__ void pv(f32x16*o,int vb,bf16x8 pa0,bf16x8 pa1,bf16x8 pa2,bf16x8 pa3){
  #pragma unroll
  for(int d0=0;d0<2;++d0){s16x4 lo[4],hi[4];
    #pragma unroll
    for(int ks=0;ks<4;++ks){
      asm volatile("ds_read_b64_tr_b16 %0,%1 offset:%c2":"=&v"(lo[ks]):"v"(vb),"i"(d0*4096+ks*1024):"memory");
      asm volatile("ds_read_b64_tr_b16 %0,%1 offset:%c2":"=&v"(hi[ks]):"v"(vb),"i"(d0*4096+ks*1024+512):"memory");}
    asm volatile("s_waitcnt lgkmcnt(0)":::"memory");SBAR();
    #define PK(k) (bf16x8){lo[k][0],lo[k][1],lo[k][2],lo[k][3],hi[k][0],hi[k][1],hi[k][2],hi[k][3]}
    o[d0]=__builtin_amdgcn_mfma_f32_32x32x16_bf16(pa0,PK(0),o[d0],0,0,0);
    o[d0]=__builtin_amdgcn_mfma_f32_32x32x16_bf16(pa1,PK(1),o[d0],0,0,0);
    o[d0]=__builtin_amdgcn_mfma_f32_32x32x16_bf16(pa2,PK(2),o[d0],0,0,0);
    o[d0]=__builtin_amdgcn_mfma_f32_32x32x16_bf16(pa3,PK(3),o[d0],0,0,0);
    #undef PK
  }
}

#ifndef ATTN_STORE16
#define ATTN_STORE16(p,v) (*(u32x4*)(p)=(v))
#endif
struct ConvSide { const bf16* Z; bf16* B; int row0; };
template<int THRL,bool SIDE> __device__ __forceinline__ void attn_unit(int b,int h,int qb,const bf16*Q,const bf16*__restrict__ K,const bf16*__restrict__ V,bf16*O,const u32x2_t*__restrict__ REC,char*shm,const ConvSide&cs,int ci){
  int tid_=threadIdx.x; asm volatile("":"+v"(tid_)); const int tid=tid_,lane=tid&63,r32=lane&31,hi=lane>>5; const int wid=__builtin_amdgcn_readfirstlane(tid>>6);
  const long rowbase=(long)b*SEQ; const int q0=qb*QB;
  const bf16*Qw=Q+(rowbase+q0+wid*QBLK)*DM+h*D;
  const bf16*Kh=K+rowbase*DM+h*D,*Vh=V+rowbase*DM+h*D;
  const unsigned lds0=(unsigned)(uintptr_t)shm;
  float*wsf=(float*)(shm+LDS_WS)+wid*64;
  const bf16*ksrc=Kh+(long)lane*DM+wid*8;
  const bf16*vsrc=Vh+(long)(16*(wid&3)+(lane>>2))*DM+(wid>>2)*32+(lane&3)*8;
  const unsigned kdst=lds0+LDS_K+wid*1024, vdst=lds0+LDS_V+wid*1024;
  #define DMA_K(t,slot) glds16(ksrc+(long)(t)*KVBLK*DM,(unsigned)__builtin_amdgcn_readfirstlane(kdst+(slot)))
  #define DMA_V(t,slot) glds16(vsrc+(long)(t)*KVBLK*DM,(unsigned)__builtin_amdgcn_readfirstlane(vdst+(slot)))
  const int vb0=(int)(lds0+LDS_V)+((lane>>4)&1)*32+(lane&3)*8+(4*hi+((lane&15)>>2))*64;
  const char*Kbase=shm+LDS_K; bf16x8 kf[8];
  const lds_cptr shm3=(lds_cptr)shm; const lds_cptr kp0=shm3+LDS_K+hi*1024+r32*16; const lds_cptr vp0=shm3+LDS_V+((lane>>4)&1)*32+(lane&3)*8+(4*hi+((lane&15)>>2))*64;
  const int NT=(q0+QB)/KVBLK;
  const u32x2_t*RECh=REC+(long)(b*NHEAD+h)*SEQ; const int nkeys=q0+QB; const int rk=2*tid;
  u32x4 rv0=u32x4{},rv1=u32x4{};
  if(rk<nkeys)rv0=*reinterpret_cast<const u32x4*>(RECh+rk);
  if(rk+1024<nkeys)rv1=*reinterpret_cast<const u32x4*>(RECh+rk+1024);
  const lds_cptr recp=(lds_cptr)shm+LDS_REC+r32*8;
  DMA_K(0,0);DMA_V(0,0);DMA_K(1,SLOTB);
  bf16x8 qr[4];
  #pragma unroll
  for(int d0=0;d0<4;++d0)qr[d0]=*reinterpret_cast<const bf16x8*>(&Qw[(long)r32*DM+d0*16+hi*8]);
  float l_reg=0.f;f32x16 o[2];o[0]=f32x16{};o[1]=f32x16{};
  { __attribute__((address_space(3))) u32x4*rl=(__attribute__((address_space(3))) u32x4*)((lds_cptr)shm+LDS_REC);
    if(rk<nkeys)rl[tid]=rv0; if(rk+1024<nkeys)rl[tid+512]=rv1; }
  u32x4 bq;
  u32x2_t rcA,rcB;
  #define RECLD(t_) do{ rcA=*(const __attribute__((address_space(3))) u32x2_t*)(recp+(t_)*512); rcB=*(const __attribute__((address_space(3))) u32x2_t*)(recp+(t_)*512+256); }while(0)
  const int qrel=wid*QBLK+r32;
  #define CMASK(P0,P1,t) do{int jb_=(t)-(NT-4); if(jb_>=0)cmask(P0,P1,jb_,qrel,hi);}while(0)
  #define START(P0,P1) do{ _Pragma("unroll") for(int r=0;r<16;++r)P0[r]=__builtin_amdgcn_exp2f(P0[r]); }while(0)
  #define RESC() do{}while(0)
  f32x16 pA0,pA1,pB0,pB1;
  int sl_prev=0,sl_cur=0,sl_next=SLOTB;
  #define ROT() do{sl_prev=sl_cur;sl_cur=sl_next;sl_next=(sl_next==(NSLOT-1)*SLOTB)?0:sl_next+SLOTB;}while(0)
  if constexpr(SIDE) asm volatile(""::"v"(qr[0]),"v"(qr[1]),"v"(qr[2]),"v"(qr[3]));
  DMA_K(2,2*SLOTB);
  if constexpr(SIDE){
    const int r0=16*ci+2*wid; const char*zg=(const char*)cs.Z+((long)cs.row0+r0)*2048+lane*16; const char*bg=(const char*)cs.B+((long)cs.row0+r0)*2048+lane*16;
    #pragma unroll
    for(int rr=0;rr<2;++rr){ const int slot=(r0+rr)%ZR_ROWS;
      #pragma unroll
      for(int hf=0;hf<2;++hf){ glds16(zg+rr*2048+hf*1024,(unsigned)__builtin_amdgcn_readfirstlane(lds0+LDS_ZR+slot*2048+hf*1024)); glds16(bg+rr*2048+hf*1024,(unsigned)__builtin_amdgcn_readfirstlane(lds0+LDS_OST+wid*4096+rr*2048+hf*1024)); } }
    WAIT_BAR(9);
  } else
  WAIT_BAR(3);
  { const u32x2_t rq=*(const __attribute__((address_space(3))) u32x2_t*)((lds_cptr)shm+LDS_REC+(q0+qrel)*8);
    const unsigned n1=(rq.x&0xffffu)^0x8000u, n2=(rq.x>>16)^0x8000u, n3=(rq.y&0xffffu)^0x8000u;
    bq.x=hi?0u:0x3f803f80u; bq.y=hi?0u:(0x3f80u|(n1<<16)); bq.z=hi?0u:(n2|(n3<<16)); bq.w=0u; }
  RECLD(0);
  qkt(pA0,pA1,Kbase,qr,ABF(rcA),ABF(rcB),__builtin_bit_cast(bf16x8,bq),r32,hi);asm volatile("s_nop 15\n\ts_nop 7":"+v"(pA0),"+v"(pA1));CMASK(pA0,pA1,0);
  START(pA0,pA1);
  _Pragma("unroll") for(int r=0;r<16;++r)pA1[r]=__builtin_amdgcn_exp2f(pA1[r]);
  if constexpr(SIDE){ WAIT_BAR(8); } else
  WAIT_BAR(0);
  DMA_K(3,0);DMA_V(1,SLOTB);
  ROT();
  kload8(kf,kp0+sl_cur);
  RECLD(1);
  if constexpr(SIDE){ WAIT_BAR(10); } else
  WAIT_BAR(2);
  s16x4 vlo[8],vhi[8]; u32x4 pw0,pw1,pw2,pw3;
  #define PKW(P,B) cvtpk_s(P[B],P[B+1])
  #define PAF(k) __builtin_bit_cast(bf16x8,pw##k)
  #define VFR(i) (bf16x8){vlo[i][0],vlo[i][1],vlo[i][2],vlo[i][3],vhi[i][0],vhi[i][1],vhi[i][2],vhi[i][3]}
  #define PIN(x) asm volatile("":"+v"(x))
  #define MX3(a,b,c) __builtin_fmaxf(__builtin_fmaxf((a),(b)),(c))
  #define GAPA(MF,A0,A1,A2,A3,W0,W1,PW) do{ MF; sacc+=A0; sacc+=A1; sacc+=A2; sacc+=A3; PIN(sacc); W0; W1; PIN(PW); SBAR(); }while(0)
  #define EX(v) __builtin_amdgcn_exp2f(v)
  #define GAPB(MF,X,B) do{ MF; X[B]=EX(X[B]); X[B+1]=EX(X[B+1]); X[B+2]=EX(X[B+2]); X[B+3]=EX(X[B+3]); PIN(X); SBAR(); }while(0)
  #define VRD(i) do{ vlo[i]=vtr(vp_+(((i)>>2)*4096+((i)&3)*1024)); vhi[i]=vtr(vp_+(((i)>>2)*4096+((i)&3)*1024+512)); }while(0)
  #define KRD(G,j) do{ if(G){ kload2(kf,kp0+sl_next,j); SBAR(); } }while(0)
  #define STEP(C0,C1,P0,P1,t,GK,GV,GL) do{ SBAR(); \
    const lds_cptr vp_=vp0+sl_prev; \
    VRD(0); SBAR(); float sacc=(P0[0]+P0[1]); \
    C0=__builtin_amdgcn_mfma_f32_32x32x16_bf16(ABF(rcA),__builtin_bit_cast(bf16x8,bq),f32x16{},0,0,0); C1=__builtin_amdgcn_mfma_f32_32x32x16_bf16(ABF(rcB),__builtin_bit_cast(bf16x8,bq),f32x16{},0,0,0); SBAR(); \
    GAPA(C0=__builtin_amdgcn_mfma_f32_32x32x16_bf16(kf[0],qr[0],C0,0,0,0), P0[2],P0[3],P0[4],P0[5],     pw0[0]=PKW(P0,0), pw0[1]=PKW(P0,2), pw0); \
    VRD(4); SBAR(); GAPA(C1=__builtin_amdgcn_mfma_f32_32x32x16_bf16(kf[1],qr[0],C1,0,0,0), P0[6],P0[7],P0[8],P0[9],     pw0[2]=PKW(P0,4), pw0[3]=PKW(P0,6), pw0); \
    VRD(1); SBAR(); GAPA(C0=__builtin_amdgcn_mfma_f32_32x32x16_bf16(kf[2],qr[1],C0,0,0,0),   P0[10],P0[11],P0[12],P0[13], pw1[0]=PKW(P0,8), pw1[1]=PKW(P0,10), pw1); \
    VRD(5); SBAR(); GAPA(C1=__builtin_amdgcn_mfma_f32_32x32x16_bf16(kf[3],qr[1],C1,0,0,0),   P0[14],P0[15],P1[0],P1[1],   pw1[2]=PKW(P0,12),pw1[3]=PKW(P0,14), pw1); \
    VRD(2); SBAR(); GAPA(C0=__builtin_amdgcn_mfma_f32_32x32x16_bf16(kf[4],qr[2],C0,0,0,0),   P1[2],P1[3],P1[4],P1[5],     pw2[0]=PKW(P1,0), pw2[1]=PKW(P1,2), pw2); \
    VRD(6); SBAR(); GAPA(C1=__builtin_amdgcn_mfma_f32_32x32x16_bf16(kf[5],qr[2],C1,0,0,0),   P1[6],P1[7],P1[8],P1[9],     pw2[2]=PKW(P1,4), pw2[3]=PKW(P1,6), pw2); \
    VRD(3); SBAR(); GAPA(C0=__builtin_amdgcn_mfma_f32_32x32x16_bf16(kf[6],qr[3],C0,0,0,0),   P1[10],P1[11],P1[12],P1[13], pw3[0]=PKW(P1,8), pw3[1]=PKW(P1,10), pw3); \
    VRD(7); SBAR(); GAPA(C1=__builtin_amdgcn_mfma_f32_32x32x16_bf16(kf[7],qr[3],C1,0,0,0),   P1[14],P1[15],0.f,0.f,       pw3[2]=PKW(P1,12),pw3[3]=PKW(P1,14), pw3); \
    l_reg+=sacc; \
    if(GK){DMA_K((t)+3,sl_cur);} if(GV){DMA_V((t)+1,sl_next);} \
    CMASK(C0,C1,t); \
    SBAR(); \
    GAPB(o[0]=__builtin_amdgcn_mfma_f32_32x32x16_bf16(PAF(0),VFR(0),o[0],0,0,0), C0,0); \
    GAPB(o[1]=__builtin_amdgcn_mfma_f32_32x32x16_bf16(PAF(0),VFR(4),o[1],0,0,0), C0,4); \
    if(GL){ RECLD((t)+1); SBAR(); } \
    KRD(GL,0); GAPB(o[0]=__builtin_amdgcn_mfma_f32_32x32x16_bf16(PAF(1),VFR(1),o[0],0,0,0), C0,8); \
    KRD(GL,1); GAPB(o[1]=__builtin_amdgcn_mfma_f32_32x32x16_bf16(PAF(1),VFR(5),o[1],0,0,0), C0,12); \
    KRD(GL,2); GAPB(o[0]=__builtin_amdgcn_mfma_f32_32x32x16_bf16(PAF(2),VFR(2),o[0],0,0,0), C1,0); \
    KRD(GL,3); GAPB(o[1]=__builtin_amdgcn_mfma_f32_32x32x16_bf16(PAF(2),VFR(6),o[1],0,0,0), C1,4); \
    GAPB(o[0]=__builtin_amdgcn_mfma_f32_32x32x16_bf16(PAF(3),VFR(3),o[0],0,0,0), C1,8); \
    GAPB(o[1]=__builtin_amdgcn_mfma_f32_32x32x16_bf16(PAF(3),VFR(7),o[1],0,0,0), C1,12); \
    }while(0)
  int t=1;
  #undef CMASK
  #define CMASK(P0,P1,t) do{}while(0)
  for(;t+5<NT;t+=2){
    STEP(pB0,pB1,pA0,pA1,t,true,true,true);     WAIT_BAR(2); RESC(); ROT();
    STEP(pA0,pA1,pB0,pB1,t+1,true,true,true);   WAIT_BAR(2); RESC(); ROT();
  }
  #undef CMASK
  #define CMASK(P0,P1,t) do{int jb_=(t)-(NT-4); if(jb_>=0)cmask(P0,P1,jb_,qrel,hi);}while(0)
  #define ENDW(tt) do{ if((tt)+3<NT){WAIT_BAR(2);} else if((tt)+2<NT){WAIT_BAR(1);} else {WAIT_BAR(0);} }while(0)
  for(;t+1<NT;t+=2){
    STEP(pB0,pB1,pA0,pA1,t,(t+3<NT),(t+1<NT),(t+1<NT));       ENDW(t);   RESC(); ROT();
    STEP(pA0,pA1,pB0,pB1,t+1,(t+4<NT),(t+2<NT),(t+2<NT));     ENDW(t+1); RESC(); ROT();
  }
  STEP(pB0,pB1,pA0,pA1,NT-1,false,false,false); RESC();
  { float sacc=pB0[0]+pB0[1]; _Pragma("unroll") for(int r=2;r<16;++r)sacc+=pB0[r]; _Pragma("unroll") for(int r=0;r<16;++r)sacc+=pB1[r]; l_reg+=sacc;
    pw0=(u32x4){PKW(pB0,0),PKW(pB0,2),PKW(pB0,4),PKW(pB0,6)};pw1=(u32x4){PKW(pB0,8),PKW(pB0,10),PKW(pB0,12),PKW(pB0,14)};pw2=(u32x4){PKW(pB1,0),PKW(pB1,2),PKW(pB1,4),PKW(pB1,6)};pw3=(u32x4){PKW(pB1,8),PKW(pB1,10),PKW(pB1,12),PKW(pB1,14)};
    SBAR(); pv(o,vb0+sl_cur,PAF(0),PAF(1),PAF(2),PAF(3)); }
  #undef PKW
  #undef PAF
  #undef VFR
  #undef PIN
  #undef MX3
  #undef GAPA
  #undef GAPB
  #undef EX
  #undef VRD
  #undef KRD
  #undef STEP
  #undef ENDW
  if constexpr(SIDE){
    const int cg=tid&127,rq=wid>>1; const lds_cptr zr=(lds_cptr)shm+LDS_ZR+cg*16, br=(lds_cptr)shm+LDS_OST+(4*rq)*2048+cg*16, cw=(lds_cptr)shm+LDS_CW+cg*32;
    typedef __attribute__((address_space(3))) const u32x4* lq_t; typedef __attribute__((address_space(3))) const f32x4_t* lf_t;
    int sl=(16*ci+4*rq+ZR_ROWS-2)%ZR_ROWS; u32x4 zz[6],bb[4];
    #pragma unroll
    for(int k=0;k<6;++k){ zz[k]=*(lq_t)(zr+sl*2048); sl=(sl+1==ZR_ROWS)?0:sl+1; }
    #pragma unroll
    for(int k=0;k<4;++k)bb[k]=*(lq_t)(br+k*2048);
    f32x4_t w[4][2];
    #pragma unroll
    for(int p_=0;p_<4;++p_){ w[p_][0]=*(lf_t)(cw+p_*4096); w[p_][1]=*(lf_t)(cw+p_*4096+16); }
    bf16*yb=cs.B+((long)cs.row0+16*ci+4*rq)*DM+cg*8;
    #define UP2(x) ((f32x2_t){__uint_as_float((x)<<16),__uint_as_float((x)&0xffff0000u)})
    #define W2(p_,n_,h_) __builtin_shufflevector(w[p_][n_],w[p_][n_],2*(h_),2*(h_)+1)
    #pragma unroll
    for(int k=0;k<4;++k){ const u32x4 z2=zz[k],z1=zz[k+1],z0=zz[k+2],bv=bb[k]; u32x4 y;
      #define CV(n_,h_,ZW) ({ const f32x2_t r_=UP2(bv.ZW)*(W2(3,n_,h_)+W2(0,n_,h_)*UP2(z2.ZW)+W2(1,n_,h_)*UP2(z1.ZW)+W2(2,n_,h_)*UP2(z0.ZW)); cvtpk_s(r_.x,r_.y); })
      y.x=CV(0,0,x); y.y=CV(0,1,y); y.z=CV(1,0,z); y.w=CV(1,1,w);
      #undef CV
      *(u32x4*)(yb+(long)k*DM)=y; }
    #undef UP2
    #undef W2
    asm volatile("s_waitcnt lgkmcnt(0)\n\ts_barrier":::"memory");
  }
  {auto rr=__builtin_amdgcn_permlane32_swap(__float_as_uint(l_reg),__float_as_uint(l_reg),false,false);l_reg=__uint_as_float(rr[0])+__uint_as_float(rr[1]);}
  if(hi==0)wsf[32+r32]=l_reg;asm volatile("s_waitcnt lgkmcnt(0)":::"memory");
  float rli[16];
  #pragma unroll
  for(int r=0;r<16;++r)rli[r]=__builtin_amdgcn_rcpf(wsf[32+crow(r,hi)]);
  bf16*Ow=O+(rowbase+q0+wid*QBLK)*DM+h*D;
  { bf16*stg=(bf16*)(shm+LDS_OST)+wid*2048;
    #pragma unroll
    for(int r=0;r<16;++r){const int orow=crow(r,hi);
      #pragma unroll
      for(int d0=0;d0<2;++d0)stg[orow*64+d0*32+r32]=__float2bfloat16(o[d0][r]*rli[r]);}
    asm volatile("s_waitcnt lgkmcnt(0)":::"memory");
    #pragma unroll
    for(int i=0;i<4;++i){const int row=i*8+(lane>>3),ch=lane&7; const u32x4 v=*(const u32x4*)(stg+row*64+ch*8); ATTN_STORE16(Ow+(long)row*DM+ch*8,v);} }
  asm volatile("s_waitcnt lgkmcnt(0)\n\ts_barrier":::"memory");
  #undef DMA_K
  #undef DMA_V
  #undef RECLD
  #undef CMASK
  #undef START
  #undef RESC
  #undef ROT
}
constexpr int ATTN_LDS_BYTES=LDS_SIDE_END;
struct AttnTensors { const bf16* Q; const bf16* K; const bf16* V; bf16* O; const u32x2_t* REC; };
struct AttnUnit { int bh; int qb; };
struct StaticOrder {
  int vcu,ngrp;
  __device__ __forceinline__ explicit StaticOrder(int grid,int block):vcu((grid%8==0)?(block%8)*(grid/8)+block/8:block),ngrp(grid/8){}
  __device__ __forceinline__ bool next(int i,AttnUnit&u)const{ const int per=(BATCH*NHEAD+ngrp-1)/ngrp; if(i>=per)return false; const int s=vcu&7,g=vcu>>3; u.bh=g*per+i; if(u.bh>=BATCH*NHEAD)return false; u.qb=(i&1)?7-s:s; return true; }
  __device__ __forceinline__ void a_ready(const AttnUnit&)const{}
  __device__ __forceinline__ void done(const AttnUnit&)const{}
};
template<class Sched,int THRL=8,bool SIDE=false> __device__ __forceinline__ void attn_phase(char*lds,const AttnTensors&T,const Sched&S,const ConvSide&cs=ConvSide{nullptr,nullptr,0}){
  AttnUnit u;
  for(int i=0;S.next(i,u);++i){ S.a_ready(u); attn_unit<THRL,SIDE>(u.bh/NHEAD,u.bh%NHEAD,u.qb,T.Q,T.K,T.V,T.O,T.REC,lds,cs,i); S.done(u); }
}
#undef SBAR
#undef WAIT_BAR
}
#define GAS __attribute__((address_space(1)))
#define LAS __attribute__((address_space(3)))
typedef unsigned short bf16;
typedef unsigned v4u __attribute__((ext_vector_type(4)));
typedef float f32x4 __attribute__((ext_vector_type(4)));
typedef short bf16x8 __attribute__((ext_vector_type(8)));
typedef GAS unsigned gu32;
typedef GAS unsigned long long gu64;
#define RLX_AGENT __ATOMIC_RELAXED, __HIP_MEMORY_SCOPE_AGENT
#define LDS_WAIT() asm volatile("s_waitcnt lgkmcnt(0)" ::: "memory")
#define VM_WAIT() asm volatile("s_waitcnt vmcnt(0)" ::: "memory")
__device__ __forceinline__ unsigned long long rt() { return __builtin_amdgcn_s_memrealtime(); }
__device__ __forceinline__ unsigned f2bf(float f) { unsigned u = __builtin_bit_cast(unsigned, f); return (u + 0x7fffu + ((u >> 16) & 1u)) >> 16; }
__device__ __forceinline__ unsigned pk2(float lo, float hi) { return f2bf(lo) | (f2bf(hi) << 16); }

#define XB_TMO      128
#define XB_XCNT(j)  (256  + 64 * (j))
#define XB_XSUB(j)  (1280 + 64 * (j))
#define XB_XGEN(j)  (2304 + 64 * (j))
#define XB_TOP      3328
#define XB_TOPGEN   3392
#define XCD_BAR_WORDS 3456
#define XB_SPIN_CAP (1u << 18)

__device__ __forceinline__ unsigned xb_ld(unsigned* p)              { return __hip_atomic_load(p, __ATOMIC_RELAXED, __HIP_MEMORY_SCOPE_AGENT); }
__device__ __forceinline__ unsigned xb_add(unsigned* p, unsigned v) { return __hip_atomic_fetch_add(p, v, __ATOMIC_RELAXED, __HIP_MEMORY_SCOPE_AGENT); }
__device__ __forceinline__ unsigned xb_xcc_id() { return (unsigned)__builtin_amdgcn_s_getreg((3 << 11) | 20) & 0xFu; }
#define XB_SPIN(cond, bar) do { unsigned _sp = 0; while (cond) { __builtin_amdgcn_s_sleep(1); \
    if ((++_sp & 255u) == 0u) { if (xb_ld(&(bar)[XB_TMO])) break; if (_sp > XB_SPIN_CAP) { atomicAdd(&(bar)[XB_TMO], 1u); break; } } } } while (0)

struct XcdBarrier {
    unsigned* bar; unsigned x;
    volatile LAS unsigned* st;
};

__device__ __forceinline__ XcdBarrier xcd_barrier_post(unsigned* bar, volatile LAS unsigned* st) {
    XcdBarrier b; b.bar = bar; b.x = xb_xcc_id(); b.st = st;
    if (threadIdx.x == 0) (void)xb_add(&bar[XB_XCNT(b.x)], 1u);
    return b;
}
__device__ __forceinline__ void xcd_barrier_complete(unsigned* bar, unsigned x, unsigned& nloc, unsigned& nx) {
    const unsigned G = gridDim.x * gridDim.y * gridDim.z;
    unsigned sum, cnt, mine, sp = 0u;
    for (;;) {
        sum = 0u; cnt = 0u; mine = 0u;
#pragma unroll
        for (unsigned j = 0; j < 16; ++j) { const unsigned c = xb_ld(&bar[XB_XCNT(j)]); sum += c; cnt += (c > 0u) ? 1u : 0u; mine = (j == x) ? c : mine; }
        if (sum == G) break;
        __builtin_amdgcn_s_sleep(1);
        if ((++sp & 255u) == 0u) { if (xb_ld(&bar[XB_TMO])) break; if (sp > XB_SPIN_CAP) { atomicAdd(&bar[XB_TMO], 1u); break; } }
    }
    nloc = mine > 0u ? mine : 1u; nx = cnt > 0u ? cnt : 1u;
}

__device__ __forceinline__ void xcd_barrier(const XcdBarrier& b) {
    asm volatile("s_waitcnt vmcnt(0)" ::: "memory");
    __syncthreads();
    if (threadIdx.x == 0) {
        unsigned* bar = b.bar;
        __builtin_amdgcn_s_waitcnt(0);
        unsigned nloc = b.st[0], nx = b.st[1];
        if (nloc == 0u) { xcd_barrier_complete(bar, b.x, nloc, nx); b.st[0] = nloc; b.st[1] = nx; }
        const unsigned old = xb_add(&bar[XB_XSUB(b.x)], 1u);
        const unsigned gen = old / nloc;
        if (old + 1u == (gen + 1u) * nloc) {
            __builtin_amdgcn_fence(__ATOMIC_RELEASE, "agent");
            asm volatile("s_waitcnt vmcnt(0)" ::: "memory");
            const unsigned og = xb_add(&bar[XB_TOP], 1u);
            const unsigned tg = og / nx;
            if (og + 1u == (tg + 1u) * nx) xb_add(&bar[XB_TOPGEN], 1u);
            else XB_SPIN(xb_ld(&bar[XB_TOPGEN]) == tg, bar);
            __builtin_amdgcn_fence(__ATOMIC_ACQUIRE, "agent");
            xb_add(&bar[XB_XGEN(b.x)], 1u);
            asm volatile("s_waitcnt vmcnt(0)" ::: "memory");
        } else {
            XB_SPIN(xb_ld(&bar[XB_XGEN(b.x)]) == gen, bar);
            __builtin_amdgcn_fence(__ATOMIC_ACQUIRE, "agent");
            asm volatile("s_waitcnt vmcnt(0)" ::: "memory");
        }
    }
    __syncthreads();
}

constexpr int NWAVES = 8;
constexpr int NB = 32, SEQ = 2048, D = 1024, NH = 16, T = NB * SEQ;
constexpr int NPROJ = 8192, LDW_IN = 8208, FCOL0 = 6144;
constexpr int NEXP = 32, DE = 512, NLOG = 36, LCAP = 65536;
constexpr float RMS_EPS = 1e-6f, LOG2E = 1.4426950408889634f;
constexpr size_t MiB = 1u << 20;
constexpr size_t WS_CTL = 0, CTL_ZERO_BYTES = 64 * 1024;
constexpr size_t WS_FLOG = 1 * MiB;
constexpr size_t WS_REC = 5 * MiB;
constexpr size_t WS_LIST = 13 * MiB;
constexpr size_t WS_LWT = 21 * MiB;
constexpr size_t WS_WRT = 29 * MiB;
constexpr size_t WS_SLOTOF = 12 * MiB;
constexpr size_t WS_RSTD = 11 * MiB;
constexpr size_t WS_WIN = 32 * MiB;
constexpr size_t WS_WC = 48 * MiB, WS_WA = 50 * MiB, WS_WO = 52 * MiB;
constexpr size_t WS_WE1 = 56 * MiB;
constexpr size_t WS_WE2 = 120 * MiB;
constexpr size_t WS_XN = 160 * MiB;
constexpr size_t WS_B = 288 * MiB;
constexpr size_t WS_Z = 416 * MiB;
constexpr size_t WS_Q = 544 * MiB;
constexpr size_t WS_K = 672 * MiB, WS_V = 800 * MiB;
static_assert(WS_V - WS_K == WS_K - WS_Q, "EpiProj: q, k, v equally spaced");
constexpr size_t WS_RINV = 928 * MiB;
constexpr size_t WS_DUMP = 928 * MiB;
constexpr size_t WS_END = 930 * MiB;
constexpr int CW_BAR = 4096;
constexpr int CW_CNT = 8192;
static_assert((CW_CNT + 64 * NEXP) * 4 <= (int)CTL_ZERO_BYTES, "CTL words inside the memset region");
constexpr int RING_OFF = 0, RING_BYTES = 131072;
constexpr int TAB_OFF = 131072;
constexpr int TAB_CNT = TAB_OFF, TAB_TSTART = TAB_OFF + 128, TAB_RSTART = TAB_OFF + 384, TAB_DESC = TAB_OFF + 640, TAB_IDX = TAB_OFF + 1024, TAB_WT = TAB_IDX + pg8::MOE_SLOTS * 1024, TAB_RS = TAB_WT + pg8::MOE_SLOTS * 1024, TAB_END = TAB_RS + pg8::MOE_SLOTS * 1024;
constexpr int P5_LCNT = 0, P5_LBASE = 128, P5_END = 256;
constexpr int LDS_BYTES = 163840, LDSCTL_OFF = LDS_BYTES - 1024;
static_assert(TAB_END <= LDSCTL_OFF && P5_END <= LDSCTL_OFF && attn_body::ATTN_LDS_BYTES <= LDSCTL_OFF, "LDS map");

typedef unsigned u32x2 __attribute__((ext_vector_type(2)));
typedef int i32x4 __attribute__((ext_vector_type(4)));

__device__ __forceinline__ float wave_sum(float v) {
#pragma unroll
    for (int o = 1; o < 64; o <<= 1) v += __shfl_xor(v, o);
    return v;
}
__device__ __forceinline__ float dpp_row_shr(float v, int n) {
    const int iv = __builtin_bit_cast(int, v); int r;
    switch (n) { case 1: r = __builtin_amdgcn_update_dpp(0, iv, 0x111, 0xf, 0xf, true); break; case 2: r = __builtin_amdgcn_update_dpp(0, iv, 0x112, 0xf, 0xf, true); break;
                 case 4: r = __builtin_amdgcn_update_dpp(0, iv, 0x114, 0xf, 0xf, true); break; default: r = __builtin_amdgcn_update_dpp(0, iv, 0x118, 0xf, 0xf, true); break; }
    return __builtin_bit_cast(float, r);
}
__device__ __forceinline__ float wave_total(float v) {
    v += dpp_row_shr(v, 1); v += dpp_row_shr(v, 2); v += dpp_row_shr(v, 4); v += dpp_row_shr(v, 8);
    v += __builtin_bit_cast(float, __builtin_amdgcn_update_dpp(0, __builtin_bit_cast(int, v), 0x142, 0xa, 0xf, false));
    v += __builtin_bit_cast(float, __builtin_amdgcn_update_dpp(0, __builtin_bit_cast(int, v), 0x143, 0xc, 0xf, false));
    return __builtin_bit_cast(float, __builtin_amdgcn_readlane(__builtin_bit_cast(int, v), 63));
}
__device__ __forceinline__ float dot4(const f32x4 a, const f32x4 b) { return (a.x * b.x + a.y * b.y) + (a.z * b.z + a.w * b.w); }

#ifndef PH_MASK
#define PH_MASK 0x1ff
#endif
#define PH(k) (((PH_MASK) >> (k)) & 1)
#ifndef DBL_MASK
#define DBL_MASK 0
#endif
#define NREP(k) ((((DBL_MASK) >> (k)) & 1) ? 2 : 1)
typedef float f32x2 __attribute__((ext_vector_type(2)));
__device__ __forceinline__ float dpp_quad(float v, const int ctrl_is_b1) {
    const int iv = __builtin_bit_cast(int, v);
    return __builtin_bit_cast(float, ctrl_is_b1 ? __builtin_amdgcn_update_dpp(0, iv, 0x4E, 0xf, 0xf, false) : __builtin_amdgcn_update_dpp(0, iv, 0xB1, 0xf, 0xf, false));
}
__device__ __forceinline__ void reduce4_store(const float (&p)[4], int lane, float* dq, int e) {
    const bool b0 = (lane & 1) != 0, b1 = (lane & 2) != 0;
    float a = b0 ? p[1] : p[0]; const float sa = b0 ? p[0] : p[1]; a += dpp_quad(sa, 0);
    float c = b0 ? p[3] : p[2]; const float sc = b0 ? p[2] : p[3]; c += dpp_quad(sc, 0);
    float t = b1 ? c : a; const float st = b1 ? a : c; t += dpp_quad(st, 1);
    t += dpp_row_shr(t, 4); t += dpp_row_shr(t, 8);
    t += __builtin_bit_cast(float, __builtin_amdgcn_ds_swizzle(__builtin_bit_cast(int, t), 0x401F));
    { auto rr = __builtin_amdgcn_permlane32_swap(__float_as_uint(t), __float_as_uint(t), false, false); t = __uint_as_float(rr[0]) + __uint_as_float(rr[1]); }
    if ((lane & 60) == 12) dq[e] = t;
}
template <int NL> __device__ __forceinline__ void row_logits4(const f32x4 (&v)[4][4], const LAS f32x4* W4, int lane, float* dq) {
    f32x4 wa[4], wb[4];
#pragma unroll
    for (int j = 0; j < 4; ++j) wa[j] = W4[64 * j + lane];
#define RL4_DOT(w_) float p[4]; { f32x2 acc[4]; _Pragma("unroll") for (int r = 0; r < 4; ++r) acc[r] = (f32x2){0.f, 0.f}; \
        _Pragma("unroll") for (int j = 0; j < 4; ++j) { const f32x2 wlo = __builtin_shufflevector(w_[j], w_[j], 0, 1), whi = __builtin_shufflevector(w_[j], w_[j], 2, 3); \
            _Pragma("unroll") for (int r = 0; r < 4; ++r) acc[r] += __builtin_shufflevector(v[r][j], v[r][j], 0, 1) * wlo; \
            _Pragma("unroll") for (int r = 0; r < 4; ++r) acc[r] += __builtin_shufflevector(v[r][j], v[r][j], 2, 3) * whi; } \
        _Pragma("unroll") for (int r = 0; r < 4; ++r) p[r] = acc[r].x + acc[r].y; }
#pragma unroll 1
    for (int e = 0; e < NL; e += 2) {
#pragma unroll
        for (int j = 0; j < 4; ++j) wb[j] = W4[(e + 1) * 256 + 64 * j + lane];
        { RL4_DOT(wa); reduce4_store(p, lane, dq, e); }
        if (e + 2 < NL) {
#pragma unroll
            for (int j = 0; j < 4; ++j) wa[j] = W4[(e + 2) * 256 + 64 * j + lane]; }
        { RL4_DOT(wb); reduce4_store(p, lane, dq, e + 1); }
    }
#undef RL4_DOT
}
struct Args { const float* in[16]; float* out; unsigned char* ws; };

__device__ __forceinline__ void p0_transpose_item(const float* W, int ldw, int k0, int src_n0, bf16* WT, int ldk, int dst_row0, LAS float* scr, int lane) {
#pragma unroll
    for (int i = 0; i < 32; ++i) { const int kk = 2 * i + (lane >> 5); scr[kk * 33 + (lane & 31)] = W[(size_t)(k0 + kk) * ldw + src_n0 + (lane & 31)]; }
    LDS_WAIT(); asm volatile("" ::: "memory");
    const int c = lane & 7;
#pragma unroll
    for (int j = 0; j < 4; ++j) { const int n = (lane >> 3) + 8 * j; const LAS float* s = scr + (8 * c) * 33 + n;
        v4u o; o.x = pk2(s[0 * 33], s[1 * 33]); o.y = pk2(s[2 * 33], s[3 * 33]); o.z = pk2(s[4 * 33], s[5 * 33]); o.w = pk2(s[6 * 33], s[7 * 33]);
        *(GAS v4u*)(WT + (size_t)(dst_row0 + n) * ldk + k0 + 8 * c) = o; }
    LDS_WAIT(); asm volatile("" ::: "memory");
}
__device__ __forceinline__ int proj_src_col(int d) {
    if (d < 2048) { const int pn = d >> 8, y = d & 255, wcc = y >> 6, hb = (y >> 5) & 1, x = y & 31; return (hb ? 2048 : 1024) + 128 * pn + 32 * wcc + x; }
    if (d < 3072) return d - 2048;
    if (d < 6144) return d;
    return d + 16;
}

constexpr int I_IN = 16 * 256, I_SQ = 16 * 32, I_E1 = NEXP * 512, I_E2 = NEXP * 256, NITEMS = I_IN + 3 * I_SQ, NITEMS_E = I_E1 + I_E2;

__global__ void __launch_bounds__(NWAVES * 64, 2) fox_moe_fwd(Args args) {
    extern __shared__ __attribute__((aligned(16))) unsigned char lds[];
    LAS unsigned char* const L = (LAS unsigned char*)lds;
    const int tid0 = threadIdx.x, wave = __builtin_amdgcn_readfirstlane(tid0 >> 6);
#define PHASE_IDS() int tid_ = threadIdx.x; asm volatile("" : "+v"(tid_)); const int tid = tid_, lane = tid & 63; (void)lane
    const int G = gridDim.x, bx = blockIdx.x;
    const int vcu = (G % 8 == 0) ? (bx % 8) * (G / 8) + bx / 8 : bx;
    const int gw = vcu * NWAVES + wave, NGW = G * NWAVES;
    typedef __attribute__((address_space(4))) const unsigned char* kargp_t;
    kargp_t kp = (kargp_t)__builtin_amdgcn_kernarg_segment_ptr();
#define KP_PHASE() asm volatile("" : "+s"(kp))
#ifndef P1_WGM
#define P1_WGM 4
#endif
#ifndef P3_WGM
#define P3_WGM 8
#endif
#ifndef STG_P1
#define STG_P1 0
#endif
#ifndef STG_P3
#define STG_P3 0
#endif
#ifndef STG_P4
#define STG_P4 0
#endif
#define XCD_STAGGER(ticks) do { if ((ticks) > 0) { const unsigned long long t0_ = __builtin_amdgcn_s_memrealtime(); const unsigned long long dl_ = (unsigned long long)(((blockIdx.x >> 3) & 7) * (ticks)); while (__builtin_amdgcn_s_memrealtime() - t0_ < dl_) __builtin_amdgcn_s_sleep(8); } } while (0)
#define LOCAL_SEAM() do { VM_WAIT(); __syncthreads(); if (threadIdx.x == 0) { __builtin_amdgcn_fence(__ATOMIC_ACQUIRE, "agent"); VM_WAIT(); } __syncthreads(); } while (0)
#define KIN(i) (*(const float* const __attribute__((address_space(4)))*)(kp + 8 * (i)))
#define KOUT() (*(float* const __attribute__((address_space(4)))*)(kp + 128))
#define KWS() (*(unsigned char* const __attribute__((address_space(4)))*)(kp + 136))
#define WSP(T_, off) ((T_*)(ws + (off)))
    gu32* const ctl = (gu32*)(KWS() + WS_CTL);
    for (int u = tid0; u < (LDS_BYTES - LDSCTL_OFF) / 4; u += NWAVES * 64) ((LAS unsigned*)(L + LDSCTL_OFF))[u] = 0u;
    __syncthreads();
    XcdBarrier bar = xcd_barrier_post((unsigned*)(ctl + CW_BAR), (volatile LAS unsigned*)(L + LDSCTL_OFF) + 8);

    if constexpr (PH(0)) _Pragma("unroll") for (int rep_ = 0; rep_ < NREP(0); ++rep_) {
        KP_PHASE(); PHASE_IDS(); unsigned char* const ws = KWS();
        const float* const x = KIN(0); const float* const g_mix = KIN(1); const float* const w_in = KIN(2); const float* const w_conv_out = KIN(6); const float* const w_att_out = KIN(7); const float* const w_out = KIN(8);
        const float* const g_ffn = KIN(9); const float* const w_rg = KIN(10); const float* const w_re = KIN(11); const float* const w_eg = KIN(12); const float* const w_eu = KIN(13); const float* const w_ed = KIN(14);
        bf16* const WIN = WSP(bf16, WS_WIN); bf16* const WC = WSP(bf16, WS_WC); bf16* const WA = WSP(bf16, WS_WA); bf16* const WO = WSP(bf16, WS_WO); bf16* const WE1 = WSP(bf16, WS_WE1); bf16* const WE2 = WSP(bf16, WS_WE2);
        bf16* const WRH = WSP(bf16, WS_WRT); bf16* const WRL = WRH + 48 * D; bf16* const XN = WSP(bf16, WS_XN); float* const FLOG = WSP(float, WS_FLOG); float* const RINV = WSP(float, WS_RINV);
        static_assert(T % (NWAVES * 256 * 4) == 0 && (NITEMS + NWAVES * 256 - 1) / (NWAVES * 256) <= 2 * (T / (NWAVES * 256 * 4)), "four rows and up to two weight items per wave and trip");
#define P0_DESC(it_, S_, D_, LW_, LK_, GS_) do { int r_ = (it_); GS_ = nullptr; \
            if (r_ < I_IN) { const int kb = r_ >> 8, d0 = (r_ & 255) * 32; S_ = w_in + (size_t)(64 * kb) * LDW_IN + proj_src_col(d0); D_ = WIN + (size_t)d0 * D + 64 * kb; LW_ = LDW_IN; LK_ = D; } \
            else if ((r_ -= I_IN) < 3 * I_SQ) { const int w = r_ / I_SQ, rr = r_ % I_SQ, kb = rr >> 5, d0 = (rr & 31) * 32; S_ = (w == 0 ? w_conv_out : w == 1 ? w_att_out : w_out) + (size_t)(64 * kb) * D + d0; D_ = (w == 0 ? WC : w == 1 ? WA : WO) + (size_t)d0 * D + 64 * kb; LW_ = D; LK_ = D; } \
            else if ((r_ -= 3 * I_SQ) < I_E1) { const int e = r_ >> 9, rr = r_ & 511, kb = rr >> 5, d0 = (rr & 31) * 32, pn = d0 >> 8, xx = d0 & 255; \
                S_ = (xx < 128 ? w_eg : w_eu) + (size_t)e * D * DE + (size_t)(64 * kb) * DE + 128 * pn + (xx & 127); D_ = WE1 + (size_t)e * 1024 * D + (size_t)d0 * D + 64 * kb; LW_ = DE; LK_ = D; GS_ = g_ffn + 64 * kb; } \
            else { r_ -= I_E1; const int e = r_ >> 8, rr = r_ & 255, kb = rr >> 5, d0 = (rr & 31) * 32; S_ = w_ed + (size_t)e * DE * D + (size_t)(64 * kb) * D + d0; D_ = WE2 + (size_t)e * 1024 * DE + (size_t)d0 * DE + 64 * kb; LW_ = D; LK_ = DE; } } while (0)
#define P0_ITEM_LOAD(v_, S_, LW_, GS_) do { _Pragma("unroll") for (int i_ = 0; i_ < 32; ++i_) v_[i_] = S_[(size_t)(2 * i_ + (lane >> 5)) * LW_ + (lane & 31)]; \
            if (GS_) { _Pragma("unroll") for (int i_ = 0; i_ < 32; ++i_) v_[i_] *= GS_[2 * i_ + (lane >> 5)]; } } while (0)
#define P0_ITEM_FINISH(v_, D_, LK_, scr_) do { _Pragma("unroll") for (int i_ = 0; i_ < 32; ++i_) scr_[(2 * i_ + (lane >> 5)) * 33 + (lane & 31)] = v_[i_]; \
            LDS_WAIT(); asm volatile("" ::: "memory"); const int c_ = lane & 7; \
            _Pragma("unroll") for (int j_ = 0; j_ < 4; ++j_) { const int n_ = (lane >> 3) + 8 * j_; const LAS float* s_ = scr_ + (8 * c_) * 33 + n_; \
                v4u o_; o_.x = pk2(s_[0 * 33], s_[1 * 33]); o_.y = pk2(s_[2 * 33], s_[3 * 33]); o_.z = pk2(s_[4 * 33], s_[5 * 33]); o_.w = pk2(s_[6 * 33], s_[7 * 33]); \
                *(GAS v4u*)(D_ + (size_t)n_ * LK_ + 8 * c_) = o_; } \
            LDS_WAIT(); asm volatile("" ::: "memory"); } while (0)
        for (int i = bx * (NWAVES * 64) + tid; i < 48 * D; i += G * NWAVES * 64) { const int e = i >> 10, k = i & 1023;
            const float w = (e < 4 ? w_rg[k * 4 + e] : e < NLOG ? w_re[(size_t)((e - 4) >> 3) * D * 8 + k * 8 + ((e - 4) & 7)] : 0.f) * g_ffn[k]; const unsigned hi = f2bf(w); WRH[i] = (bf16)hi; WRL[i] = (bf16)f2bf(w - __uint_as_float(hi << 16)); }
        LAS float* wfT = (LAS float*)(L + RING_OFF);
        LAS float* scrA = (LAS float*)(L + RING_OFF + 65536 + wave * 8448); LAS float* scrB = scrA;
        static_assert(65536 + NWAVES * 8448 <= LDSCTL_OFF, "P0 LDS map");
#pragma unroll
        for (int i = 0; i < 2; ++i) { const int k = tid + 512 * i; const GAS f32x4* src = (const GAS f32x4*)(w_in + (size_t)k * LDW_IN + FCOL0);
#pragma unroll
            for (int q = 0; q < 4; ++q) { const f32x4 v = src[q]; wfT[(4 * q + 0) * 1024 + k] = v.x; wfT[(4 * q + 1) * 1024 + k] = v.y; wfT[(4 * q + 2) * 1024 + k] = v.z; wfT[(4 * q + 3) * 1024 + k] = v.w; } }
        __syncthreads();
        f32x4 gv[4];
#pragma unroll
        for (int j = 0; j < 4; ++j) gv[j] = ((const GAS f32x4*)g_mix)[lane + 64 * j];
        f32x4 nx[4][4];
#define P0_LOAD(i_) do { _Pragma("unroll") for (int r = 0; r < 4; ++r) { const GAS f32x4* xr_ = (const GAS f32x4*)(x + (size_t)(gw + ((i_) + r) * NGW) * D) + lane; _Pragma("unroll") for (int j = 0; j < 4; ++j) nx[r][j] = xr_[64 * j]; } } while (0)
        const int nrow = T / NGW;
        for (int i = 0; i + 4 <= nrow; i += 4) {
            P0_LOAD(i);
            const int itA = gw + (i >> 1) * NGW, itB = itA + NGW; const bool hasA = itA < NITEMS, hasB = itB < NITEMS;
            const float* sA = nullptr; const float* sB = nullptr; bf16* dA = nullptr; bf16* dB = nullptr; const float* gA = nullptr; const float* gB = nullptr; int lwA = 0, lwB = 0, lkA = 0, lkB = 0; float ia[32], ib[32];
            if (hasA) { P0_DESC(itA, sA, dA, lwA, lkA, gA); P0_ITEM_LOAD(ia, sA, lwA, gA); }
            if (hasB) { P0_DESC(itB, sB, dB, lwB, lkB, gB); P0_ITEM_LOAD(ib, sB, lwB, gB); }
            f32x4 (&v)[4][4] = nx;
            float s2[4];
#pragma unroll
            for (int r = 0; r < 4; ++r) s2[r] = (dot4(v[r][0], v[r][0]) + dot4(v[r][1], v[r][1])) + (dot4(v[r][2], v[r][2]) + dot4(v[r][3], v[r][3]));
#pragma unroll
            for (int r = 0; r < 4; ++r) { const float rinv_ = sqrtf(wave_total(s2[r]) * (1.f / D) + RMS_EPS), rstd = 1.0f / rinv_; const int m = gw + (i + r) * NGW; if (lane == 0) RINV[m] = rinv_;
                GAS unsigned long long* o8 = (GAS unsigned long long*)(XN + (size_t)m * D) + lane;
#pragma unroll
                for (int j = 0; j < 4; ++j) { v[r][j] = (v[r][j] * rstd) * gv[j]; o8[64 * j] = (unsigned long long)pk2(v[r][j].x, v[r][j].y) | ((unsigned long long)pk2(v[r][j].z, v[r][j].w) << 32); } }
            row_logits4<16>(v, (const LAS f32x4*)wfT, lane, FLOG + (size_t)(gw + (i + (lane & 3)) * NGW) * 16);
            if (hasA) P0_ITEM_FINISH(ia, dA, lkA, scrA);
            if (hasB) P0_ITEM_FINISH(ib, dB, lkB, scrB);
        }
    }
    xcd_barrier(bar);

    if constexpr (PH(1)) _Pragma("unroll") for (int rep_ = 0; rep_ < NREP(1); ++rep_) {
        KP_PHASE(); PHASE_IDS(); unsigned char* const ws = KWS(); const float* const b_forget = KIN(5); float* const out = KOUT();
        float* const FLOG = WSP(float, WS_FLOG); u32x2* const REC = WSP(u32x2, WS_REC); bf16* const XN = WSP(bf16, WS_XN); bf16* const WIN = WSP(bf16, WS_WIN);
        bf16* const ZB = WSP(bf16, WS_Z); bf16* const BB = WSP(bf16, WS_B); bf16* const QO = WSP(bf16, WS_Q); bf16* const KB = WSP(bf16, WS_K); bf16* const VB = WSP(bf16, WS_V);
        bf16* const SGC = (bf16*)out; bf16* const SGA = (bf16*)((unsigned char*)out + (size_t)T * D);
        LAS float* red = (LAS float*)(L + RING_OFF);
        for (int bh = bx; bh < NB * NH; bh += G) {
            const int b = bh >> 4, h = bh & 15; const float bf = b_forget[h];
            float c[4];
#pragma unroll
            for (int i = 0; i < 4; ++i) { const float xv = FLOG[((size_t)b * SEQ + 4 * tid + i) * 16 + h] + bf; const float ls = fminf(xv, 0.f) - log1pf(expf(-fabsf(xv))); c[i] = ls * LOG2E; }
            c[1] += c[0]; c[2] += c[1]; c[3] += c[2];
            const float tot = c[3]; float sc = tot;
#pragma unroll
            for (int o = 1; o < 64; o <<= 1) { const float tv = __shfl_up(sc, o); if (lane >= o) sc += tv; }
            if (lane == 63) red[wave] = sc;
            __syncthreads();
            float off = 0.f;
            for (int w = 0; w < wave; ++w) off += red[w];
            const float excl = off + (sc - tot);
            unsigned rw[8];
#pragma unroll
            for (int i = 0; i < 4; ++i) { const float bias = -(excl + c[i]);
                const unsigned h1 = f2bf(bias); const float r1 = bias - __uint_as_float(h1 << 16); const unsigned h2 = f2bf(r1); const float r2 = r1 - __uint_as_float(h2 << 16); const unsigned h3 = f2bf(r2);
                rw[2 * i] = h1 | (h2 << 16); rw[2 * i + 1] = h3 | (0x3f80u << 16); }
            GAS v4u* dst = (GAS v4u*)(REC + (size_t)bh * SEQ + 4 * tid);
            dst[0] = (v4u){rw[0], rw[1], rw[2], rw[3]}; dst[1] = (v4u){rw[4], rw[5], rw[6], rw[7]};
            __syncthreads();
        }
                pg8::StaticOrder S; S.init(XN, WIN, T, NPROJ, D, G, bx, P1_WGM);
        pg8::EpiProj E{ZB, BB, QO, KB, VB, SGC, SGA, attn_body::C2, L + TAB_OFF + wave * 4096};
        XCD_STAGGER(STG_P1);
        pg8::gemm_phase<pg8::EpiProj, pg8::StaticOrder, true, false>(L + RING_OFF, D, S, E, ws + WS_DUMP);
#ifdef HOT_UNITS
        { VM_WAIT(); __syncthreads(); const pg8::HotOrder HS{XN, WIN, D, HOT_UNITS, bx, HOT_PN};
#if HOT_STORE
          bf16* const dmp = WSP(bf16, WS_LIST); pg8::EpiProj HE{dmp, dmp, dmp, dmp, dmp, dmp, dmp, 1.0f, L + TAB_OFF + wave * 4096}; pg8::gemm_phase<pg8::EpiProj, pg8::HotOrder, true, false>(L + RING_OFF, D, HS, HE);
#else
          pg8::EpiNull HE{WSP(float, WS_LIST)}; pg8::gemm_phase<pg8::EpiNull, pg8::HotOrder, true, false>(L + RING_OFF, D, HS, HE);
#endif
        }
#endif
    }
    xcd_barrier(bar);

    if constexpr (PH(2)) _Pragma("unroll") for (int rep_ = 0; rep_ < NREP(2); ++rep_) {
        KP_PHASE(); PHASE_IDS(); unsigned char* const ws = KWS(); const float* const conv_w = KIN(3); const float* const conv_b = KIN(4);
        bf16* const ZB = WSP(bf16, WS_Z); bf16* const BB = WSP(bf16, WS_B); bf16* const QO = WSP(bf16, WS_Q); bf16* const KB = WSP(bf16, WS_K); bf16* const VB = WSP(bf16, WS_V); u32x2* const REC = WSP(u32x2, WS_REC);
        const bool dummy_ = (rep_ + 1 < NREP(2)); bf16* const CO = dummy_ ? WSP(bf16, WS_XN) : BB; bf16* const AO = dummy_ ? WSP(bf16, WS_XN) : QO;
        const attn_body::AttnTensors AT{(const attn_body::bf16*)QO, (const attn_body::bf16*)KB, (const attn_body::bf16*)VB, (attn_body::bf16*)AO, (const attn_body::u32x2_t*)REC};
        const attn_body::StaticOrder S(G, bx);
        if (G == NB * SEQ / 256 && !dummy_) {
            for (int u = tid; u < 1024; u += NWAVES * 64) ((LAS f32x4*)(L + RING_OFF + attn_body::LDS_CW))[u] = u < 768 ? ((const GAS f32x4*)conv_w)[u] : ((const GAS f32x4*)conv_b)[u - 768];
            if (tid < 256) { const int rr = tid >> 7, c = tid & 127; v4u v = (v4u){0u, 0u, 0u, 0u};
                if ((bx & (SEQ / 256 - 1)) != 0) v = *(const GAS v4u*)(ZB + ((size_t)256 * bx - 2 + rr) * D + 8 * c);
                *(LAS v4u*)(L + RING_OFF + attn_body::LDS_ZR + (16 + rr) * 2048 + c * 16) = v; }
            __syncthreads();
            const attn_body::ConvSide CS{(const attn_body::bf16*)ZB, (attn_body::bf16*)BB, 256 * bx};
            attn_body::attn_phase<attn_body::StaticOrder, 40, true>((char*)lds + RING_OFF, AT, S, CS);
        } else {
        const int cg = tid & 127;
        float w0[8], w1[8], w2[8], cb[8];
#pragma unroll
        for (int j = 0; j < 8; ++j) { w0[j] = conv_w[8 * cg + j]; w1[j] = conv_w[D + 8 * cg + j]; w2[j] = conv_w[2 * D + 8 * cg + j]; cb[j] = conv_b[8 * cg + j]; }
        for (int task = bx * (NWAVES * 64) + tid; task < (T / 32) * 128; task += G * NWAVES * 64) {
            const int t0 = (task >> 7) * 32;
            float z1[8], z2[8];
            if ((t0 & (SEQ - 1)) == 0) {
#pragma unroll
                for (int j = 0; j < 8; ++j) { z1[j] = 0.f; z2[j] = 0.f; }
            } else {
                const v4u a = *(const GAS v4u*)(ZB + (size_t)(t0 - 2) * D + 8 * cg), bq = *(const GAS v4u*)(ZB + (size_t)(t0 - 1) * D + 8 * cg);
                z2[0] = pg8::bf_lo(a.x); z2[1] = pg8::bf_hi(a.x); z2[2] = pg8::bf_lo(a.y); z2[3] = pg8::bf_hi(a.y); z2[4] = pg8::bf_lo(a.z); z2[5] = pg8::bf_hi(a.z); z2[6] = pg8::bf_lo(a.w); z2[7] = pg8::bf_hi(a.w);
                z1[0] = pg8::bf_lo(bq.x); z1[1] = pg8::bf_hi(bq.x); z1[2] = pg8::bf_lo(bq.y); z1[3] = pg8::bf_hi(bq.y); z1[4] = pg8::bf_lo(bq.z); z1[5] = pg8::bf_hi(bq.z); z1[6] = pg8::bf_lo(bq.w); z1[7] = pg8::bf_hi(bq.w);
            }
#pragma unroll 4
            for (int r = 0; r < 32; ++r) {
                const size_t off = (size_t)(t0 + r) * D + 8 * cg;
                const v4u zc = *(const GAS v4u*)(ZB + off), bv = *(const GAS v4u*)(BB + off);
                float z0[8], bb[8], y[8];
                z0[0] = pg8::bf_lo(zc.x); z0[1] = pg8::bf_hi(zc.x); z0[2] = pg8::bf_lo(zc.y); z0[3] = pg8::bf_hi(zc.y); z0[4] = pg8::bf_lo(zc.z); z0[5] = pg8::bf_hi(zc.z); z0[6] = pg8::bf_lo(zc.w); z0[7] = pg8::bf_hi(zc.w);
                bb[0] = pg8::bf_lo(bv.x); bb[1] = pg8::bf_hi(bv.x); bb[2] = pg8::bf_lo(bv.y); bb[3] = pg8::bf_hi(bv.y); bb[4] = pg8::bf_lo(bv.z); bb[5] = pg8::bf_hi(bv.z); bb[6] = pg8::bf_lo(bv.w); bb[7] = pg8::bf_hi(bv.w);
#pragma unroll
                for (int j = 0; j < 8; ++j) { y[j] = bb[j] * (cb[j] + w0[j] * z2[j] + w1[j] * z1[j] + w2[j] * z0[j]); z2[j] = z1[j]; z1[j] = z0[j]; }
                *(GAS v4u*)(CO + off) = (v4u){pk2(y[0], y[1]), pk2(y[2], y[3]), pk2(y[4], y[5]), pk2(y[6], y[7])};
            }
        }
        VM_WAIT(); __syncthreads();
        attn_body::attn_phase<attn_body::StaticOrder, 40, false>((char*)lds + RING_OFF, AT, S);
        }
    }
    xcd_barrier(bar);

    if constexpr (PH(3)) _Pragma("unroll") for (int rep_ = 0; rep_ < NREP(3); ++rep_) {
        KP_PHASE(); PHASE_IDS(); unsigned char* const ws = KWS(); float* const out = KOUT();
        bf16* const BB = WSP(bf16, WS_B); bf16* const QO = WSP(bf16, WS_Q); bf16* const MB = WSP(bf16, WS_Z); bf16* const WC = WSP(bf16, WS_WC); bf16* const WA = WSP(bf16, WS_WA);
        const unsigned char* const SGC = (const unsigned char*)out; const unsigned char* const SGA = (const unsigned char*)out + (size_t)T * D;
        XCD_STAGGER(STG_P3);
        { pg8::DualSrcOrder S; S.init2(BB, WC, QO, WA, T, D, D, G, bx, P3_WGM); pg8::EpiGateFused E{SGC, SGA, MB, L + TAB_OFF + wave * 4096};
          pg8::gemm_phase<pg8::EpiGateFused, pg8::DualSrcOrder, true, false, true>(L + RING_OFF, D, S, E, ws + WS_DUMP); }
    }
    xcd_barrier(bar);

    if constexpr (PH(4)) _Pragma("unroll") for (int rep_ = 0; rep_ < NREP(4); ++rep_) {
        KP_PHASE(); PHASE_IDS(); unsigned char* const ws = KWS(); float* const out = KOUT(); const float* const x = KIN(0); const float* const g_mix = KIN(1); bf16* const MB = WSP(bf16, WS_Z); bf16* const WO = WSP(bf16, WS_WO); bf16* const XM = WSP(bf16, WS_K); (void)out;
        pg8::StaticOrder S; S.init(MB, WO, T, D, D, G, bx);
        bool gok = true;
#pragma unroll
        for (int j = 0; j < 4; ++j) { const f32x4 gq = ((const GAS f32x4*)g_mix)[lane + 64 * j];
#pragma unroll
            for (int c = 0; c < 4; ++c) { const float a = fabsf(gq[c]); gok = gok && (a >= 1e-18f) && (a <= 1e18f); } }
        const bool use_xn = __builtin_amdgcn_ballot_w64(!gok) == 0ull;
        if (use_xn) { pg8::EpiResXN E{WSP(bf16, WS_XN), WSP(float, WS_RINV), g_mix, XM, L + TAB_OFF + wave * 4096}; pg8::gemm_phase<pg8::EpiResXN, pg8::StaticOrder, true, false>(L + RING_OFF, D, S, E, ws + WS_DUMP); }
        else { pg8::EpiRes E{x, XM, L + TAB_OFF + wave * 4096}; pg8::gemm_phase<pg8::EpiRes, pg8::StaticOrder, true, false>(L + RING_OFF, D, S, E, ws + WS_DUMP); }
    }
    xcd_barrier(bar);

    if constexpr (PH(5)) _Pragma("unroll") for (int rep_ = 0; rep_ < NREP(5); ++rep_) {
        KP_PHASE(); PHASE_IDS(); unsigned char* const ws = KWS();
        const bf16* const WRH = WSP(bf16, WS_WRT); const bf16* const WRL = WRH + 48 * D; const bf16* const XM = WSP(bf16, WS_K); float* const LOGITS = WSP(float, WS_FLOG); float* const RSTD = WSP(float, WS_RSTD); unsigned* const LIST = WSP(unsigned, WS_LIST); float* const LWT = WSP(float, WS_LWT);
        LAS int* lcnt = (LAS int*)(L + P5_LCNT); LAS int* lbase = (LAS int*)(L + P5_LBASE);
        if (tid < 32) lcnt[tid] = 0;
        __syncthreads();
        if (wave >= 4 && rep_ + 1 == NREP(5)) {
            const float* const w_in = KIN(2); const float* const w_conv_out = KIN(6); const float* const w_att_out = KIN(7); const float* const w_out = KIN(8);
            const float* const g_ffn = KIN(9); const float* const w_eg = KIN(12); const float* const w_eu = KIN(13); const float* const w_ed = KIN(14);
            bf16* const WIN = WSP(bf16, WS_WIN); bf16* const WC = WSP(bf16, WS_WC); bf16* const WA = WSP(bf16, WS_WA); bf16* const WO = WSP(bf16, WS_WO); bf16* const WE1 = WSP(bf16, WS_WE1); bf16* const WE2 = WSP(bf16, WS_WE2);
            LAS float* scr = (LAS float*)(L + RING_OFF + 65536 + wave * 8448);
            const int iw = vcu * 4 + (wave - 4), NIW = G * 4;
            for (int r = iw; r < NITEMS_E; r += 4 * NIW) {
                const int it0 = NITEMS + r; const bool h1 = r + NIW < NITEMS_E, h2 = r + 2 * NIW < NITEMS_E, h3 = r + 3 * NIW < NITEMS_E;
                const float *sq0 = nullptr, *sq1 = nullptr, *sq2 = nullptr, *sq3 = nullptr, *gq0 = nullptr, *gq1 = nullptr, *gq2 = nullptr, *gq3 = nullptr; bf16 *dq0 = nullptr, *dq1 = nullptr, *dq2 = nullptr, *dq3 = nullptr;
                int lw0 = 0, lw1 = 0, lw2 = 0, lw3 = 0, lk0 = 0, lk1 = 0, lk2 = 0, lk3 = 0; float iq0[32], iq1[32], iq2[32], iq3[32];
                P0_DESC(it0, sq0, dq0, lw0, lk0, gq0); P0_ITEM_LOAD(iq0, sq0, lw0, gq0);
                if (h1) { P0_DESC(it0 + NIW, sq1, dq1, lw1, lk1, gq1); P0_ITEM_LOAD(iq1, sq1, lw1, gq1); }
                if (h2) { P0_DESC(it0 + 2 * NIW, sq2, dq2, lw2, lk2, gq2); P0_ITEM_LOAD(iq2, sq2, lw2, gq2); }
                if (h3) { P0_DESC(it0 + 3 * NIW, sq3, dq3, lw3, lk3, gq3); P0_ITEM_LOAD(iq3, sq3, lw3, gq3); }
                P0_ITEM_FINISH(iq0, dq0, lk0, scr);
                if (h1) P0_ITEM_FINISH(iq1, dq1, lk1, scr);
                if (h2) P0_ITEM_FINISH(iq2, dq2, lk2, scr);
                if (h3) P0_ITEM_FINISH(iq3, dq3, lk3, scr);
            }
        }
        for (int rb = bx; rb < T / 256; rb += G) {
          if (wave < 4)
#pragma unroll 1
          for (int pass = 0; pass < 2; ++pass) {
            const int mbase = rb * 256 + wave * 64 + pass * 32, fr = lane & 15, fq = lane >> 4;
            const GAS bf16x8* ap0 = (const GAS bf16x8*)(XM + (size_t)(mbase + fr) * D + 8 * fq); const GAS bf16x8* ap1 = (const GAS bf16x8*)(XM + (size_t)(mbase + 16 + fr) * D + 8 * fq);
            const GAS bf16x8* bh = (const GAS bf16x8*)(WRH + (size_t)fr * D + 8 * fq); const GAS bf16x8* bl = (const GAS bf16x8*)(WRL + (size_t)fr * D + 8 * fq);
            f32x4 acc[2][3]; float ss0 = 0.f, ss1 = 0.f;
#pragma unroll
            for (int mt = 0; mt < 2; ++mt)
#pragma unroll
                for (int nt = 0; nt < 3; ++nt) acc[mt][nt] = (f32x4){0.f, 0.f, 0.f, 0.f};
#pragma unroll 4
            for (int s = 0; s < D / 32; ++s) {
                const bf16x8 a0 = ap0[4 * s], a1 = ap1[4 * s];
                bf16x8 wh[3], wl[3];
#pragma unroll
                for (int nt = 0; nt < 3; ++nt) { wh[nt] = bh[4 * s + nt * 2048]; wl[nt] = bl[4 * s + nt * 2048]; }
#pragma unroll
                for (int nt = 0; nt < 3; ++nt) { acc[0][nt] = __builtin_amdgcn_mfma_f32_16x16x32_bf16(a0, wh[nt], acc[0][nt], 0, 0, 0); acc[1][nt] = __builtin_amdgcn_mfma_f32_16x16x32_bf16(a1, wh[nt], acc[1][nt], 0, 0, 0);
                    acc[0][nt] = __builtin_amdgcn_mfma_f32_16x16x32_bf16(a0, wl[nt], acc[0][nt], 0, 0, 0); acc[1][nt] = __builtin_amdgcn_mfma_f32_16x16x32_bf16(a1, wl[nt], acc[1][nt], 0, 0, 0); }
#pragma unroll
                for (int j = 0; j < 8; ++j) { const float x0 = __uint_as_float((unsigned)(unsigned short)a0[j] << 16), x1 = __uint_as_float((unsigned)(unsigned short)a1[j] << 16); ss0 += x0 * x0; ss1 += x1 * x1; }
            }
            ss0 += __builtin_bit_cast(float, __builtin_amdgcn_ds_swizzle(__builtin_bit_cast(int, ss0), 0x401F)); ss1 += __builtin_bit_cast(float, __builtin_amdgcn_ds_swizzle(__builtin_bit_cast(int, ss1), 0x401F));
            { auto r0 = __builtin_amdgcn_permlane32_swap(__float_as_uint(ss0), __float_as_uint(ss0), false, false); ss0 = __uint_as_float(r0[0]) + __uint_as_float(r0[1]);
              auto r1 = __builtin_amdgcn_permlane32_swap(__float_as_uint(ss1), __float_as_uint(ss1), false, false); ss1 = __uint_as_float(r1[0]) + __uint_as_float(r1[1]); }
            if (fq == 0) { RSTD[mbase + fr] = 1.0f / sqrtf(ss0 * (1.f / D) + RMS_EPS); RSTD[mbase + 16 + fr] = 1.0f / sqrtf(ss1 * (1.f / D) + RMS_EPS); }
#pragma unroll
            for (int mt = 0; mt < 2; ++mt)
#pragma unroll
                for (int nt = 0; nt < 3; ++nt) { const int col = 16 * nt + fr;
                    if (col < NLOG) {
#pragma unroll
                        for (int i = 0; i < 4; ++i) LOGITS[(size_t)(mbase + 16 * mt + 4 * fq + i) * NLOG + col] = acc[mt][nt][i]; } }
          }
            VM_WAIT();
            __syncthreads();
            if (rep_ + 1 < NREP(5)) continue;
            i32x4 rt = (i32x4){0, 0, 0, 0}; int rk1 = 0, rk2 = 0;
            if (tid < 256) {
                const GAS f32x4* lp = (const GAS f32x4*)(LOGITS + (size_t)(rb * 256 + tid) * NLOG); float lg[NLOG];
                const float rs = RSTD[rb * 256 + tid];
#pragma unroll
                for (int q = 0; q < NLOG / 4; ++q) { const f32x4 t4 = lp[q] * rs; lg[4 * q] = t4.x; lg[4 * q + 1] = t4.y; lg[4 * q + 2] = t4.z; lg[4 * q + 3] = t4.w; }
                int g = 0; float mg = lg[0];
#pragma unroll
                for (int i = 1; i < 4; ++i) if (lg[i] > mg) { mg = lg[i]; g = i; }
                float sg = 0.f;
#pragma unroll
                for (int i = 0; i < 4; ++i) sg += expf(lg[i] - mg);
                const float gval = 1.0f / sg;
                float le[8];
#pragma unroll
                for (int j = 0; j < 8; ++j) le[j] = g == 0 ? lg[4 + j] : g == 1 ? lg[12 + j] : g == 2 ? lg[20 + j] : lg[28 + j];
                int i1 = 0; float m1 = le[0];
#pragma unroll
                for (int j = 1; j < 8; ++j) if (le[j] > m1) { m1 = le[j]; i1 = j; }
                int i2 = 0; float m2 = -INFINITY;
#pragma unroll
                for (int j = 0; j < 8; ++j) if (j != i1 && le[j] > m2) { m2 = le[j]; i2 = j; }
                const float e2 = expf(m2 - m1), v1 = 1.0f / (1.0f + e2), v2 = e2 / (1.0f + e2);
                rt = (i32x4){8 * g + i1, 8 * g + i2, (int)__float_as_uint(gval * v1), (int)__float_as_uint(gval * v2)}; }
            if (tid < 256) { rk1 = __hip_atomic_fetch_add(lcnt + rt.x, 1, __ATOMIC_RELAXED, __HIP_MEMORY_SCOPE_WORKGROUP); rk2 = __hip_atomic_fetch_add(lcnt + rt.y, 1, __ATOMIC_RELAXED, __HIP_MEMORY_SCOPE_WORKGROUP); }
            __syncthreads();
            if (tid < 32) lbase[tid] = (int)__hip_atomic_fetch_add(ctl + CW_CNT + 64 * tid, (unsigned)lcnt[tid], RLX_AGENT);
            __syncthreads();
            if (tid < 256) { const unsigned tok = (unsigned)(rb * 256 + tid);
                const size_t p1 = (size_t)rt.x * LCAP + (size_t)(lbase[rt.x] + rk1), p2 = (size_t)rt.y * LCAP + (size_t)(lbase[rt.y] + rk2);
                LIST[p1] = 2u * tok; LWT[p1] = __uint_as_float((unsigned)rt.z); LIST[p2] = 2u * tok + 1u; LWT[p2] = __uint_as_float((unsigned)rt.w); }
            __syncthreads();
            if (tid < 32) lcnt[tid] = 0;
            __syncthreads();
        }
    }
    xcd_barrier(bar);

    LAS int* tcnt = (LAS int*)(L + TAB_CNT); LAS int* tstart = (LAS int*)(L + TAB_TSTART); LAS int* rstart = (LAS int*)(L + TAB_RSTART);
    LAS i32x4* desc = (LAS i32x4*)(L + TAB_DESC); LAS unsigned* tidx = (LAS unsigned*)(L + TAB_IDX); LAS float* twt = (LAS float*)(L + TAB_WT); LAS float* trs = (LAS float*)(L + TAB_RS);
    if constexpr (PH(6)) {
        KP_PHASE(); PHASE_IDS(); unsigned char* const ws = KWS(); unsigned* const LIST = WSP(unsigned, WS_LIST); float* const LWT = WSP(float, WS_LWT); const float* const RSTD = WSP(float, WS_RSTD); unsigned* const SLOTOF = WSP(unsigned, WS_SLOTOF);
        if (tid < 32) tcnt[tid] = (int)__hip_atomic_load(ctl + CW_CNT + 64 * tid, RLX_AGENT);
        __syncthreads();
        if (tid == 0) { int ts = 0, rs = 0; for (int e = 0; e < NEXP; ++e) { tstart[e] = ts; rstart[e] = rs; ts += (tcnt[e] + 255) >> 8; rs += tcnt[e]; } tstart[NEXP] = ts; rstart[NEXP] = rs; }
        __syncthreads();
        if (tid < pg8::MOE_SLOTS) {
            const int nU = 4 * tstart[NEXP], chunk = (nU + 7) >> 3, per = (G + 7) / 8, s = tid * per + (bx >> 3), U = (bx & 7) * chunk + s;
            i32x4 d = (i32x4){0, 0, 0, 0};
            if (s < chunk && U < nU) { const int rowtile = U >> 2; int e = 0; while (e < NEXP - 1 && tstart[e + 1] <= rowtile) ++e; const int rt = rowtile - tstart[e]; int nv = tcnt[e] - 256 * rt; nv = nv > 256 ? 256 : nv; d = (i32x4){e, rt, U & 3, nv}; }
            desc[tid] = d;
        }
        __syncthreads();
        { static_assert(pg8::MOE_SLOTS * 256 % (NWAVES * 64) == 0, "table fill");
            constexpr int NE = pg8::MOE_SLOTS * 256 / (NWAVES * 64); unsigned ent[NE]; float w[NE], rs[NE];
#pragma unroll
            for (int k = 0; k < NE; ++k) { const int e = tid + k * (NWAVES * 64), slot = e >> 8, r = e & 255; const i32x4 d = desc[slot]; ent[k] = 0u; w[k] = 0.f;
                if (r < d.w) { const size_t p = (size_t)d.x * LCAP + (size_t)(256 * d.y + r); ent[k] = LIST[p]; w[k] = LWT[p]; } }
#pragma unroll
            for (int k = 0; k < NE; ++k) { const int e = tid + k * (NWAVES * 64), slot = e >> 8, r = e & 255; const i32x4 d = desc[slot]; rs[k] = (r < d.w) ? RSTD[ent[k] >> 1] : 0.f; }
#pragma unroll
            for (int k = 0; k < NE; ++k) { const int e = tid + k * (NWAVES * 64), slot = e >> 8, r = e & 255; const i32x4 d = desc[slot]; tidx[e] = ent[k]; twt[e] = w[k]; trs[e] = rs[k];
                if (d.z == 0 && r < d.w) SLOTOF[ent[k]] = (unsigned)(rstart[d.x] + 256 * d.y + r); } }
        __syncthreads();
    }
    if constexpr (PH(6)) _Pragma("unroll") for (int rep_ = 0; rep_ < NREP(6); ++rep_) {
        KP_PHASE(); PHASE_IDS(); unsigned char* const ws = KWS(); bf16* const XM = WSP(bf16, WS_K); bf16* const WE1 = WSP(bf16, WS_WE1); bf16* const ACT = WSP(bf16, WS_Q);
        pg8::MoeOrder S{XM, WE1, D, (size_t)1024 * D * 2, desc, rstart, tidx, true}; pg8::EpiSilu E{ACT, rstart, trs};
        pg8::gemm_phase<pg8::EpiSilu, pg8::MoeOrder, true, true>(L + RING_OFF, D, S, E);
    }
    xcd_barrier(bar);
    if constexpr (PH(7)) _Pragma("unroll") for (int rep_ = 0; rep_ < NREP(7); ++rep_) {
        KP_PHASE(); PHASE_IDS(); unsigned char* const ws = KWS(); bf16* const ACT = WSP(bf16, WS_Q); bf16* const WE2 = WSP(bf16, WS_WE2); bf16* const YB = WSP(bf16, WS_XN);
        pg8::MoeOrder S{ACT, WE2, DE, (size_t)1024 * DE * 2, desc, rstart, tidx, false}; pg8::EpiDown E{YB, rstart, twt, L + (wave < 4 ? TAB_IDX + wave * 2304 : TAB_RS + (wave - 4) * 2304)};
        pg8::gemm_phase<pg8::EpiDown, pg8::MoeOrder, true, false>(L + RING_OFF, DE, S, E);
    }
    xcd_barrier(bar);

    if constexpr (PH(8)) _Pragma("unroll") for (int rep_ = 0; rep_ < NREP(8); ++rep_) {
        KP_PHASE(); PHASE_IDS(); unsigned char* const ws = KWS(); float* const out = KOUT(); const float* const g_fin = KIN(15); const bf16* const YB = WSP(bf16, WS_XN); const bf16* const XM = WSP(bf16, WS_K); const unsigned* const SLOTOF = WSP(unsigned, WS_SLOTOF);
        f32x4 gv[4];
#pragma unroll
        for (int j = 0; j < 4; ++j) gv[j] = ((const GAS f32x4*)g_fin)[lane + 64 * j];
        u32x2 nx[4], na[4], nb[4]; unsigned ns0 = 0u, ns1 = 0u;
#define P8_SLOTS(mm) do { ns0 = (unsigned)__builtin_amdgcn_readfirstlane((int)SLOTOF[2 * (mm)]); ns1 = (unsigned)__builtin_amdgcn_readfirstlane((int)SLOTOF[2 * (mm) + 1]); } while (0)
#define P8_LOAD(mm) do { const GAS u32x2* xr_ = (const GAS u32x2*)(XM + (size_t)(mm) * D) + lane; const GAS u32x2* y0_ = (const GAS u32x2*)(YB + (size_t)ns0 * D) + lane; const GAS u32x2* y1_ = (const GAS u32x2*)(YB + (size_t)ns1 * D) + lane; \
            _Pragma("unroll") for (int j = 0; j < 4; ++j) { nx[j] = xr_[64 * j]; na[j] = y0_[64 * j]; nb[j] = y1_[64 * j]; } } while (0)
        if (gw < T) { P8_SLOTS(gw); P8_LOAD(gw); if (gw + NGW < T) P8_SLOTS(gw + NGW); }
        for (int m = gw; m < T; m += NGW) {
            GAS f32x4* xw = (rep_ + 1 < NREP(8)) ? (GAS f32x4*)(WSP(float, WS_Z) + (size_t)m * D) + lane : (GAS f32x4*)(out + (size_t)m * D) + lane;
            f32x4 v[4]; u32x2 ya[4], yb[4]; float s2 = 0.f;
#pragma unroll
            for (int j = 0; j < 4; ++j) { v[j] = (f32x4){pg8::bf_lo(nx[j].x), pg8::bf_hi(nx[j].x), pg8::bf_lo(nx[j].y), pg8::bf_hi(nx[j].y)}; ya[j] = na[j]; yb[j] = nb[j]; }
            if (m + NGW < T) { P8_LOAD(m + NGW); if (m + 2 * NGW < T) P8_SLOTS(m + 2 * NGW); }
#pragma unroll
            for (int j = 0; j < 4; ++j) { const u32x2 a = ya[j], b = yb[j];
                v[j].x += pg8::bf_lo(a.x) + pg8::bf_lo(b.x); v[j].y += pg8::bf_hi(a.x) + pg8::bf_hi(b.x); v[j].z += pg8::bf_lo(a.y) + pg8::bf_lo(b.y); v[j].w += pg8::bf_hi(a.y) + pg8::bf_hi(b.y);
                s2 += dot4(v[j], v[j]); }
            const float rstd = 1.0f / sqrtf(wave_total(s2) * (1.f / D) + RMS_EPS);
#pragma unroll
            for (int j = 0; j < 4; ++j) xw[64 * j] = (v[j] * rstd) * gv[j];
        }
    }
}

extern "C" void kernel_launch(void* const* d_in, const int* in_sizes, int n_in, void* d_out, int out_size, void* d_ws, size_t ws_size, hipStream_t stream) {
    static int grid = 0;
    if (grid == 0) {
        if (n_in != 16 || in_sizes[0] != T * D || out_size != T * D || ws_size < WS_END) { fprintf(stderr, "kernel_launch: built for 16 inputs, x/out of %d floats, >= %zu bytes of workspace; got n_in %d, in0 %d, out %d, ws %zu; nothing launched\n", T * D, (size_t)WS_END, n_in, n_in > 0 ? in_sizes[0] : -1, out_size, ws_size); grid = -1; return; }
        int dev = 0, cus = 0, per_cu = 0;
        if (hipGetDevice(&dev) != hipSuccess || hipDeviceGetAttribute(&cus, hipDeviceAttributeMultiprocessorCount, dev) != hipSuccess) { fprintf(stderr, "kernel_launch: hipGetDevice / hipDeviceGetAttribute failed; nothing launched\n"); grid = -1; return; }
        if (hipFuncSetAttribute((const void*)fox_moe_fwd, hipFuncAttributeMaxDynamicSharedMemorySize, LDS_BYTES) != hipSuccess) { fprintf(stderr, "kernel_launch: hipFuncSetAttribute(%d B LDS) failed; nothing launched\n", LDS_BYTES); grid = -1; return; }
        if (hipOccupancyMaxActiveBlocksPerMultiprocessor(&per_cu, (const void*)fox_moe_fwd, NWAVES * 64, LDS_BYTES) != hipSuccess || per_cu < 1)
            fprintf(stderr, "kernel_launch: note: the occupancy query reports %d workgroups per CU\n", per_cu);
        (void)hipGetLastError();
        grid = cus;
        if (grid != T / 256) { fprintf(stderr, "kernel_launch: %d CUs, but this kernel deals one 256-row panel per workgroup and needs exactly %d resident workgroups; nothing launched\n", cus, T / 256); grid = -1; return; }
        if (grid % 8 != 0 || grid < 8) { fprintf(stderr, "kernel_launch: %d CUs: this kernel wants a multiple of 8\n", grid); grid = (grid / 8) * 8; if (grid == 0) { grid = -1; return; } }
    }
    if (grid < 0) return;
    if (hipMemsetAsync((char*)d_ws + WS_CTL, 0, CTL_ZERO_BYTES, stream) != hipSuccess) { fprintf(stderr, "kernel_launch: hipMemsetAsync of the control words failed; nothing launched\n"); return; }
    Args a{};
    for (int i = 0; i < 16; ++i) a.in[i] = (const float*)d_in[i];
    a.out = (float*)d_out; a.ws = (unsigned char*)d_ws;
    hipLaunchKernelGGL(fox_moe_fwd, dim3(grid), dim3(NWAVES * 64), LDS_BYTES, stream, a);
    const hipError_t le = hipPeekAtLastError();
    if (le != hipSuccess) fprintf(stderr, "kernel_launch: launch failed: %s (grid %d x %d threads, %d B LDS)\n", hipGetErrorName(le), grid, NWAVES * 64, LDS_BYTES);
}
```

```cpp
#include <hip/hip_runtime.h>
#include <hip/hip_bf16.h>
#include <cstdio>
#include <cstdint>
#include <cmath>
namespace pg8 {
#define PG8_LAS __attribute__((address_space(3)))
typedef unsigned short bf16_t;
typedef short bf16x8 __attribute__((ext_vector_type(8)));
typedef float f32x4 __attribute__((ext_vector_type(4)));
typedef unsigned u32x4 __attribute__((ext_vector_type(4)));
typedef unsigned u32x2 __attribute__((ext_vector_type(2)));
typedef int i32x4 __attribute__((ext_vector_type(4)));
constexpr int BM = 256, BK = 64, HALF = 128, HTB = HALF * BK * 2  , STAGE_BYTES = 8 * HTB, NXCD = 8, WGM = 8;

__host__ __device__ __forceinline__ int lds_byte(int r, int c) { const int st = (r >> 4) * 2 + (c >> 5), rr = r & 15, cc = c & 31, ob = rr * 64 + cc * 2; return st * 1024 + (ob ^ (((ob >> 9) & 1) << 5)); }
__host__ __device__ __forceinline__ void stage_rc(int b, int& R, int& C) { const int st = b / 1024, sb = b % 1024, swz = sb ^ (((sb >> 9) & 1) << 5); R = (st >> 1) * 16 + swz / 64; C = (st & 1) * 32 + (swz % 64) / 2; }
__host__ __device__ __forceinline__ int perm32(int rho) { const int n = rho >> 4, i = rho & 15; return 8 * (i >> 2) + 4 * n + (i & 3); }

struct Unit { int pm, pn, e, rt, slot, nvalid; };

struct StaticOrder {
    const bf16_t* A; const bf16_t* Bt; int K;
    int nM, nN, nwg, G, c, wgm;
    __device__ __forceinline__ void init(const bf16_t* A_, const bf16_t* Bt_, int M, int N, int K_, int G_, int c_, int wgm_ = WGM) { A = A_; Bt = Bt_; K = K_; nM = M / BM; nN = N / BM; nwg = nM * nN; G = G_; c = c_; wgm = wgm_; }
    __device__ __forceinline__ bool next(int i, Unit& u) const {
        const long L = (long)i * G + c; if (L >= nwg) return false;
        int wgid = (int)L; { const int q = nwg / NXCD, r = nwg % NXCD, xcd = wgid % NXCD, off = wgid / NXCD; wgid = (xcd < r ? xcd * (q + 1) : r * (q + 1) + (xcd - r) * q) + off; }
        const int nig = wgm * nN, gid = wgid / nig, fm = gid * wgm, gsz = (nM - fm) < wgm ? (nM - fm) : wgm;
        u.pm = fm + ((wgid % nig) % gsz); u.pn = (wgid % nig) / gsz; u.e = 0; u.rt = 0; u.slot = i; u.nvalid = BM; return true;
    }
    __device__ __forceinline__ const char* a_tile(const Unit& u) const { return (const char*)A + (size_t)u.pm * ((size_t)BM * K * 2); }
    __device__ __forceinline__ const char* b_tile(const Unit& u) const { return (const char*)Bt + (size_t)u.pn * ((size_t)BM * K * 2); }
    __device__ __forceinline__ void a_rows(int, const int (&)[2], const int (&)[2], unsigned (&)[2][2]) const {}
};

struct DualSrcOrder : StaticOrder {
    const bf16_t* A2; const bf16_t* B2;
    __device__ __forceinline__ void init2(const bf16_t* A1, const bf16_t* B1, const bf16_t* A2_, const bf16_t* B2_, int M, int N, int K_, int G_, int c_, int wgm_) { init(A1, B1, M, N, K_, G_, c_, wgm_); A2 = A2_; B2 = B2_; }
    __device__ __forceinline__ const char* a_tile2(const Unit& u) const { return (const char*)A2 + (size_t)u.pm * ((size_t)BM * K * 2); }
    __device__ __forceinline__ const char* b_tile2(const Unit& u) const { return (const char*)B2 + (size_t)u.pn * ((size_t)BM * K * 2); }
};

struct PanelOrder {
    const bf16_t* A; const bf16_t* Bt; int K; int nN, c;
    __device__ __forceinline__ bool next(int i, Unit& u) const { if (i >= nN) return false; u.pm = c; u.pn = i; u.e = 0; u.rt = 0; u.slot = i; u.nvalid = BM; return true; }
    __device__ __forceinline__ const char* a_tile(const Unit& u) const { return (const char*)A + (size_t)u.pm * ((size_t)BM * K * 2); }
    __device__ __forceinline__ const char* b_tile(const Unit& u) const { return (const char*)Bt + (size_t)u.pn * ((size_t)BM * K * 2); }
    __device__ __forceinline__ void a_rows(int, const int (&)[2], const int (&)[2], unsigned (&)[2][2]) const {}
};

struct HotOrder {
    const bf16_t* A; const bf16_t* Bt; int K; int n, c, pn;
    __device__ __forceinline__ bool next(int i, Unit& u) const { if (i >= n) return false; u.pm = c & 7; u.pn = pn; u.e = 0; u.rt = 0; u.slot = i; u.nvalid = BM; return true; }
    __device__ __forceinline__ const char* a_tile(const Unit& u) const { return (const char*)A + (size_t)u.pm * ((size_t)BM * K * 2); }
    __device__ __forceinline__ const char* b_tile(const Unit& u) const { return (const char*)Bt + (size_t)u.pn * ((size_t)BM * K * 2); }
    __device__ __forceinline__ void a_rows(int, const int (&)[2], const int (&)[2], unsigned (&)[2][2]) const {}
};
struct EpiNull {
    static constexpr bool PERM = true, AFTER_DRAIN = false; static constexpr int BMAP = 1;
    float* dump;
    static constexpr int NST = 0;
    __device__ __forceinline__ void operator()(f32x4 (&acc)[2][2][4][2], const Unit& u, int wr, int wc, int fr, int fq) const {
        f32x4 s = (f32x4){0.f, 0.f, 0.f, 0.f};
#pragma unroll
        for (int ai = 0; ai < 2; ++ai)
#pragma unroll
            for (int bj = 0; bj < 2; ++bj)
#pragma unroll
                for (int m = 0; m < 4; ++m)
#pragma unroll
                    for (int n = 0; n < 2; ++n) s += acc[ai][bj][m][n];
        *(f32x4*)(dump + (size_t)(blockIdx.x * 512 + threadIdx.x) * 4) = s;
#pragma unroll
        for (int ai = 0; ai < 2; ++ai)
#pragma unroll
            for (int bj = 0; bj < 2; ++bj)
#pragma unroll
                for (int m = 0; m < 4; ++m) { acc[ai][bj][m][0] = (f32x4){0.f, 0.f, 0.f, 0.f}; acc[ai][bj][m][1] = (f32x4){0.f, 0.f, 0.f, 0.f}; }
    }
};

constexpr int MOE_SLOTS = 10;
struct MoeOrder {
    const bf16_t* A; const bf16_t* Bt; int K; size_t bexp;
    const PG8_LAS i32x4* desc; const PG8_LAS int* rstart; const PG8_LAS unsigned* idx; bool gather;
    __device__ __forceinline__ bool next(int i, Unit& u) const {
        if (i >= MOE_SLOTS) return false;
        const i32x4 d = desc[i]; const int nv = __builtin_amdgcn_readfirstlane(d.w); if (nv <= 0) return false;
        u.e = __builtin_amdgcn_readfirstlane(d.x); u.rt = __builtin_amdgcn_readfirstlane(d.y); u.pn = __builtin_amdgcn_readfirstlane(d.z); u.nvalid = nv; u.slot = i; u.pm = 0; return true;
    }
    __device__ __forceinline__ const char* a_tile(const Unit& u) const {
        if (gather) return (const char*)A;
        const int r0 = __builtin_amdgcn_readfirstlane(rstart[u.e]) + BM * u.rt; return (const char*)A + (size_t)r0 * ((size_t)K * 2); }
    __device__ __forceinline__ const char* b_tile(const Unit& u) const { return (const char*)Bt + (size_t)u.e * bexp + (size_t)u.pn * ((size_t)BM * K * 2); }
    __device__ __forceinline__ void a_rows(int slot, const int (&Rp)[2], const int (&Cp)[2], unsigned (&voff)[2][2]) const {
#pragma unroll
        for (int h = 0; h < 2; ++h)
#pragma unroll
            for (int p = 0; p < 2; ++p) { const unsigned ent = idx[slot * BM + h * HALF + Rp[p]]; voff[h][p] = (ent >> 1) * (unsigned)(K * 2) + (unsigned)(Cp[p] * 2); }
    }
};

__device__ __forceinline__ unsigned cvt_pk_bf16(float lo, float hi) { unsigned r; asm volatile("v_cvt_pk_bf16_f32 %0, %1, %2" : "=v"(r) : "v"(lo), "v"(hi)); return r; }
__device__ __forceinline__ float bf_lo(unsigned w) { return __uint_as_float(w << 16); }
__device__ __forceinline__ float bf_hi(unsigned w) { return __uint_as_float(w & 0xffff0000u); }
__device__ __forceinline__ float sigmoid_f(float x) { return __builtin_amdgcn_rcpf(1.0f + __builtin_amdgcn_exp2f(-1.4426950408889634f * x)); }
__device__ __forceinline__ u32x4 pack8(const f32x4 v0, const f32x4 v1) { u32x4 w; w.x = cvt_pk_bf16(v0[0], v0[1]); w.y = cvt_pk_bf16(v0[2], v0[3]); w.z = cvt_pk_bf16(v1[0], v1[1]); w.w = cvt_pk_bf16(v1[2], v1[3]); return w; }

__device__ __forceinline__ unsigned gate_q(float x) { return __float_as_uint(__builtin_fmaf(sigmoid_f(x), 255.0f, 8388608.0f)); }
__device__ __forceinline__ unsigned gate_pack4(unsigned t0, unsigned t1, unsigned t2, unsigned t3) { return __builtin_amdgcn_perm(t1, t0, 0x0c0c0400u) | __builtin_amdgcn_perm(t3, t2, 0x04000c0cu); }
__device__ __forceinline__ float gate_f(unsigned w, int b) { return (float)((w >> (8 * b)) & 0xffu) * (1.0f / 255.0f); }
struct EpiProj {
    static constexpr bool PERM = true, AFTER_DRAIN = false; static constexpr int BMAP = 2;
    static constexpr int NST = 0;
    bf16_t *Z, *Bb, *Q, *Kk, *V, *SGC, *SGA; float qscale; PG8_LAS unsigned char* stg;
    __device__ __forceinline__ void operator()(f32x4 (&acc)[2][2][4][2], const Unit& u, int wr, int wc, int fr, int fq) const {
        if (u.pn < 8) {
            const int row0 = u.pm * BM + wr * 64 + fr, col0 = u.pn * HALF + wc * 32 + 8 * fq;
#pragma unroll
            for (int ai = 0; ai < 2; ++ai)
#pragma unroll
                for (int m = 0; m < 4; ++m) { bf16_t* rowp = Z + (size_t)(row0 + ai * HALF + m * 16) * 1024 + col0;
                    *(u32x4*)rowp = pack8(acc[ai][0][m][0] * acc[ai][1][m][0], acc[ai][0][m][1] * acc[ai][1][m][1]);
                    acc[ai][0][m][0] = (f32x4){0.f, 0.f, 0.f, 0.f}; acc[ai][0][m][1] = (f32x4){0.f, 0.f, 0.f, 0.f}; acc[ai][1][m][0] = (f32x4){0.f, 0.f, 0.f, 0.f}; acc[ai][1][m][1] = (f32x4){0.f, 0.f, 0.f, 0.f}; }
        } else if (u.pn >= 24) {
            unsigned char* base = (unsigned char*)(u.pn < 28 ? SGC : SGA); const int lane = fq * 16 + fr;
            PG8_LAS unsigned char* wp = stg + fr * 80 + fq * 8;
            const PG8_LAS unsigned char* rp = stg + (lane >> 2) * 80 + (lane & 3) * 16;
            unsigned char* gp = base + (size_t)(u.pm * BM + wr * 64 + (lane >> 2)) * 1024 + (u.pn & 3) * BM + wc * 64 + (lane & 3) * 16;
#pragma unroll
            for (int ai = 0; ai < 2; ++ai)
#pragma unroll
                for (int m = 0; m < 4; ++m) {
#pragma unroll
                    for (int bj = 0; bj < 2; ++bj) { const f32x4 v0 = acc[ai][bj][m][0], v1 = acc[ai][bj][m][1]; u32x2 w;
                        w.x = gate_pack4(gate_q(v0[0]), gate_q(v0[1]), gate_q(v0[2]), gate_q(v0[3])); w.y = gate_pack4(gate_q(v1[0]), gate_q(v1[1]), gate_q(v1[2]), gate_q(v1[3]));
                        *(PG8_LAS u32x2*)(wp + bj * 32) = w; acc[ai][bj][m][0] = (f32x4){0.f, 0.f, 0.f, 0.f}; acc[ai][bj][m][1] = (f32x4){0.f, 0.f, 0.f, 0.f}; }
                    const u32x4 r0 = *(const PG8_LAS u32x4*)rp;
                    *(u32x4*)(gp + (size_t)(ai * HALF + m * 16) * 1024) = r0; }
        } else {
            const int t = (u.pn - 8) >> 2; bf16_t* base = Bb + (t ? (Q - Bb) + (long)(t - 1) * (Kk - Q) : 0L);
            const float sc = (t == 1) ? qscale : 1.0f; const int lane = fq * 16 + fr;
            PG8_LAS unsigned char* wp = stg + fr * 144 + fq * 16;
            const PG8_LAS unsigned char* rp = stg + (lane >> 3) * 144 + (lane & 7) * 16;
            bf16_t* gp = base + (size_t)(u.pm * BM + wr * 64 + (lane >> 3)) * 1024 + ((u.pn - 8) & 3) * BM + wc * 64 + (lane & 7) * 8;
#pragma unroll
            for (int ai = 0; ai < 2; ++ai)
#pragma unroll
                for (int m = 0; m < 4; ++m) {
#pragma unroll
                    for (int bj = 0; bj < 2; ++bj) { f32x4 v0 = acc[ai][bj][m][0], v1 = acc[ai][bj][m][1];
                        v0 = v0 * sc; v1 = v1 * sc;
                        *(PG8_LAS u32x4*)(wp + bj * 64) = pack8(v0, v1); acc[ai][bj][m][0] = (f32x4){0.f, 0.f, 0.f, 0.f}; acc[ai][bj][m][1] = (f32x4){0.f, 0.f, 0.f, 0.f}; }
                    const u32x4 r0 = *(const PG8_LAS u32x4*)rp, r1 = *(const PG8_LAS u32x4*)(rp + 8 * 144);
                    bf16_t* g0 = gp + (size_t)(ai * HALF + m * 16) * 1024;
                    *(u32x4*)g0 = r0; *(u32x4*)(g0 + 8 * 1024) = r1; }
        }
    }
};
template <bool ADD> struct EpiGate {
    static constexpr bool PERM = true, AFTER_DRAIN = false; static constexpr int BMAP = 2;
    const unsigned char* G; bf16_t* Mo; PG8_LAS unsigned char* stg;
    static constexpr int NST = 0;
    __device__ __forceinline__ void operator()(f32x4 (&acc)[2][2][4][2], const Unit& u, int wr, int wc, int fr, int fq) const {
        const int row0 = u.pm * BM + wr * 64 + fr, col0 = u.pn * BM + wc * 64 + 8 * fq, lane = fq * 16 + fr;
        PG8_LAS unsigned char* wp = stg + fr * 144 + fq * 16; const PG8_LAS unsigned char* rp = stg + (lane >> 3) * 144 + (lane & 7) * 16;
        bf16_t* gp = Mo + (size_t)(u.pm * BM + wr * 64 + (lane >> 3)) * 1024 + u.pn * BM + wc * 64 + (lane & 7) * 8;
        u32x2 ga[2][4][2];
#pragma unroll
        for (int ai = 0; ai < 2; ++ai)
#pragma unroll
            for (int m = 0; m < 4; ++m)
#pragma unroll
                for (int bj = 0; bj < 2; ++bj) ga[ai][m][bj] = *(const u32x2*)(G + (size_t)(row0 + ai * HALF + m * 16) * 1024 + col0 + bj * 32);
#pragma unroll
        for (int ai = 0; ai < 2; ++ai) {
            u32x4 o[4][2];
            if (ADD) {
#pragma unroll
                for (int m = 0; m < 4; ++m)
#pragma unroll
                    for (int bj = 0; bj < 2; ++bj) o[m][bj] = *(const u32x4*)(Mo + (size_t)(row0 + ai * HALF + m * 16) * 1024 + col0 + bj * 32); }
            u32x2 (&g)[4][2] = ga[ai];
#pragma unroll
            for (int m = 0; m < 4; ++m) {
#pragma unroll
                for (int bj = 0; bj < 2; ++bj) { const u32x2 gg = g[m][bj]; f32x4 v0 = acc[ai][bj][m][0], v1 = acc[ai][bj][m][1];
                    v0[0] *= gate_f(gg.x, 0); v0[1] *= gate_f(gg.x, 1); v0[2] *= gate_f(gg.x, 2); v0[3] *= gate_f(gg.x, 3); v1[0] *= gate_f(gg.y, 0); v1[1] *= gate_f(gg.y, 1); v1[2] *= gate_f(gg.y, 2); v1[3] *= gate_f(gg.y, 3);
                    if (ADD) { const u32x4 oo = o[m][bj];
                        v0[0] += bf_lo(oo.x); v0[1] += bf_hi(oo.x); v0[2] += bf_lo(oo.y); v0[3] += bf_hi(oo.y); v1[0] += bf_lo(oo.z); v1[1] += bf_hi(oo.z); v1[2] += bf_lo(oo.w); v1[3] += bf_hi(oo.w); }
                    *(PG8_LAS u32x4*)(wp + bj * 64) = pack8(v0, v1); acc[ai][bj][m][0] = (f32x4){0.f, 0.f, 0.f, 0.f}; acc[ai][bj][m][1] = (f32x4){0.f, 0.f, 0.f, 0.f}; }
                const u32x4 r0 = *(const PG8_LAS u32x4*)rp, r1 = *(const PG8_LAS u32x4*)(rp + 8 * 144);
                bf16_t* g0 = gp + (size_t)(ai * HALF + m * 16) * 1024;
                *(u32x4*)g0 = r0; *(u32x4*)(g0 + 8 * 1024) = r1; }
        }
    }
};
struct EpiGateFused {
    static constexpr bool PERM = true, AFTER_DRAIN = false; static constexpr int BMAP = 2;
    const unsigned char* GC; const unsigned char* GA; bf16_t* Mo; PG8_LAS unsigned char* stg;
    static constexpr int NST = 0;
    static __device__ __forceinline__ float qf(unsigned w, int b) { return (float)((w >> (8 * b)) & 0xffu); }
    static __device__ __forceinline__ float qa_eff(unsigned w, int b) { return __builtin_fmaxf(qf(w, b), 9.5367431640625e-07f); }
    __device__ __forceinline__ void mid(f32x4 (&acc)[2][2][4][2], const Unit& u, int wr, int wc, int fr, int fq) const {
        int row0 = u.pm * BM + wr * 64 + fr, col0 = u.pn * BM + wc * 64 + 8 * fq;
        asm volatile("" : "+v"(row0), "+v"(col0));
        u32x2 ca[2][4][2], aa[2][4][2];
#pragma unroll
        for (int ai = 0; ai < 2; ++ai)
#pragma unroll
            for (int m = 0; m < 4; ++m)
#pragma unroll
                for (int bj = 0; bj < 2; ++bj) { const unsigned off = (unsigned)((row0 + ai * HALF + m * 16) * 1024 + col0 + bj * 32); ca[ai][m][bj] = *(const u32x2*)(GC + off); aa[ai][m][bj] = *(const u32x2*)(GA + off); }
#pragma unroll
        for (int ai = 0; ai < 2; ++ai) {
            u32x2 (&c)[4][2] = ca[ai]; u32x2 (&a)[4][2] = aa[ai];
#pragma unroll
            for (int m = 0; m < 4; ++m)
#pragma unroll
                for (int bj = 0; bj < 2; ++bj)
#pragma unroll
                    for (int j = 0; j < 4; ++j) { acc[ai][bj][m][0][j] *= qf(c[m][bj].x, j) * __builtin_amdgcn_rcpf(qa_eff(a[m][bj].x, j)); acc[ai][bj][m][1][j] *= qf(c[m][bj].y, j) * __builtin_amdgcn_rcpf(qa_eff(a[m][bj].y, j)); }
        }
    }
    __device__ __forceinline__ void operator()(f32x4 (&acc)[2][2][4][2], const Unit& u, int wr, int wc, int fr, int fq) const {
        const int row0 = u.pm * BM + wr * 64 + fr, col0 = u.pn * BM + wc * 64 + 8 * fq, lane = fq * 16 + fr;
        PG8_LAS unsigned char* wp = stg + fr * 144 + fq * 16; const PG8_LAS unsigned char* rp = stg + (lane >> 3) * 144 + (lane & 7) * 16;
        bf16_t* gp = Mo + (size_t)(u.pm * BM + wr * 64 + (lane >> 3)) * 1024 + u.pn * BM + wc * 64 + (lane & 7) * 8;
        u32x2 ga[2][4][2];
#pragma unroll
        for (int ai = 0; ai < 2; ++ai)
#pragma unroll
            for (int m = 0; m < 4; ++m)
#pragma unroll
                for (int bj = 0; bj < 2; ++bj) ga[ai][m][bj] = *(const u32x2*)(GA + (unsigned)((row0 + ai * HALF + m * 16) * 1024 + col0 + bj * 32));
#pragma unroll
        for (int ai = 0; ai < 2; ++ai)
#pragma unroll
            for (int m = 0; m < 4; ++m) {
#pragma unroll
                for (int bj = 0; bj < 2; ++bj) { const u32x2 gg = ga[ai][m][bj]; f32x4 v0 = acc[ai][bj][m][0], v1 = acc[ai][bj][m][1];
#pragma unroll
                    for (int j = 0; j < 4; ++j) { v0[j] *= qa_eff(gg.x, j) * (1.0f / 255.0f); v1[j] *= qa_eff(gg.y, j) * (1.0f / 255.0f); }
                    *(PG8_LAS u32x4*)(wp + bj * 64) = pack8(v0, v1); acc[ai][bj][m][0] = (f32x4){0.f, 0.f, 0.f, 0.f}; acc[ai][bj][m][1] = (f32x4){0.f, 0.f, 0.f, 0.f}; }
                const u32x4 r0 = *(const PG8_LAS u32x4*)rp, r1 = *(const PG8_LAS u32x4*)(rp + 8 * 144);
                bf16_t* g0 = gp + (size_t)(ai * HALF + m * 16) * 1024;
                *(u32x4*)g0 = r0; *(u32x4*)(g0 + 8 * 1024) = r1; }
    }
};
struct EpiRes {
    static constexpr bool PERM = true, AFTER_DRAIN = false; static constexpr int BMAP = 2;
    const float* R; bf16_t* C; PG8_LAS unsigned char* stg;
    static constexpr int NST = 0;
    __device__ __forceinline__ void operator()(f32x4 (&acc)[2][2][4][2], const Unit& u, int wr, int wc, int fr, int fq) const {
        const int row0 = u.pm * BM + wr * 64 + fr, col0 = u.pn * BM + wc * 64 + 8 * fq, lane = fq * 16 + fr;
        PG8_LAS unsigned char* wp = stg + fr * 144 + fq * 16; const PG8_LAS unsigned char* rp = stg + (lane >> 3) * 144 + (lane & 7) * 16;
        bf16_t* gp = C + (size_t)(u.pm * BM + wr * 64 + (lane >> 3)) * 1024 + u.pn * BM + wc * 64 + (lane & 7) * 8;
#pragma unroll
        for (int ai = 0; ai < 2; ++ai) {
            f32x4 r[4][2][2];
#pragma unroll
            for (int m = 0; m < 4; ++m)
#pragma unroll
                for (int bj = 0; bj < 2; ++bj)
#pragma unroll
                    for (int n = 0; n < 2; ++n) r[m][bj][n] = *(const f32x4*)(R + (size_t)(row0 + ai * HALF + m * 16) * 1024 + col0 + bj * 32 + n * 4);
#pragma unroll
            for (int m = 0; m < 4; ++m) {
#pragma unroll
                for (int bj = 0; bj < 2; ++bj) { *(PG8_LAS u32x4*)(wp + bj * 64) = pack8(r[m][bj][0] + acc[ai][bj][m][0], r[m][bj][1] + acc[ai][bj][m][1]); acc[ai][bj][m][0] = (f32x4){0.f, 0.f, 0.f, 0.f}; acc[ai][bj][m][1] = (f32x4){0.f, 0.f, 0.f, 0.f}; }
                const u32x4 q0 = *(const PG8_LAS u32x4*)rp, q1 = *(const PG8_LAS u32x4*)(rp + 8 * 144);
                bf16_t* g0 = gp + (size_t)(ai * HALF + m * 16) * 1024;
                *(u32x4*)g0 = q0; *(u32x4*)(g0 + 8 * 1024) = q1; }
        }
    }
};
struct EpiResXN {
    static constexpr bool PERM = true, AFTER_DRAIN = false; static constexpr int BMAP = 2;
    const bf16_t* XNp; const float* RINV; const float* gain; bf16_t* C; PG8_LAS unsigned char* stg;
    static constexpr int NST = 0;
    __device__ __forceinline__ void operator()(f32x4 (&acc)[2][2][4][2], const Unit& u, int wr, int wc, int fr, int fq) const {
        const int row0 = u.pm * BM + wr * 64 + fr, col0 = u.pn * BM + wc * 64 + 8 * fq, lane = fq * 16 + fr;
        PG8_LAS unsigned char* wp = stg + fr * 144 + fq * 16; const PG8_LAS unsigned char* rp = stg + (lane >> 3) * 144 + (lane & 7) * 16;
        bf16_t* gp = C + (size_t)(u.pm * BM + wr * 64 + (lane >> 3)) * 1024 + u.pn * BM + wc * 64 + (lane & 7) * 8;
        f32x4 gi[2][2];
#pragma unroll
        for (int bj = 0; bj < 2; ++bj)
#pragma unroll
            for (int n = 0; n < 2; ++n) { const f32x4 gv = *(const f32x4*)(gain + col0 + bj * 32 + n * 4); gi[bj][n] = (f32x4){1.0f / gv[0], 1.0f / gv[1], 1.0f / gv[2], 1.0f / gv[3]}; }
#pragma unroll
        for (int ai = 0; ai < 2; ++ai) {
            u32x4 xn[4][2]; float ri[4];
#pragma unroll
            for (int m = 0; m < 4; ++m) { ri[m] = RINV[row0 + ai * HALF + m * 16];
#pragma unroll
                for (int bj = 0; bj < 2; ++bj) xn[m][bj] = *(const u32x4*)(XNp + (size_t)(row0 + ai * HALF + m * 16) * 1024 + col0 + bj * 32); }
#pragma unroll
            for (int m = 0; m < 4; ++m) {
#pragma unroll
                for (int bj = 0; bj < 2; ++bj) { const u32x4 q = xn[m][bj]; const float r = ri[m]; f32x4 v0 = acc[ai][bj][m][0], v1 = acc[ai][bj][m][1];
                    v0[0] += bf_lo(q.x) * r * gi[bj][0][0]; v0[1] += bf_hi(q.x) * r * gi[bj][0][1]; v0[2] += bf_lo(q.y) * r * gi[bj][0][2]; v0[3] += bf_hi(q.y) * r * gi[bj][0][3];
                    v1[0] += bf_lo(q.z) * r * gi[bj][1][0]; v1[1] += bf_hi(q.z) * r * gi[bj][1][1]; v1[2] += bf_lo(q.w) * r * gi[bj][1][2]; v1[3] += bf_hi(q.w) * r * gi[bj][1][3];
                    *(PG8_LAS u32x4*)(wp + bj * 64) = pack8(v0, v1); acc[ai][bj][m][0] = (f32x4){0.f, 0.f, 0.f, 0.f}; acc[ai][bj][m][1] = (f32x4){0.f, 0.f, 0.f, 0.f}; }
                const u32x4 q0 = *(const PG8_LAS u32x4*)rp, q1 = *(const PG8_LAS u32x4*)(rp + 8 * 144);
                bf16_t* g0 = gp + (size_t)(ai * HALF + m * 16) * 1024;
                *(u32x4*)g0 = q0; *(u32x4*)(g0 + 8 * 1024) = q1; }
        }
    }
};
struct EpiSilu {
    static constexpr bool PERM = true, AFTER_DRAIN = false; static constexpr int BMAP = 1;
    static constexpr int NST = 0;
    bf16_t* ACT; const PG8_LAS int* rstart; const PG8_LAS float* rs;
    __device__ __forceinline__ void operator()(f32x4 (&acc)[2][2][4][2], const Unit& u, int wr, int wc, int fr, int fq) const {
        const int rbase = __builtin_amdgcn_readfirstlane(rstart[u.e]) + BM * u.rt, col0 = u.pn * HALF + wc * 32 + 8 * fq;
#pragma unroll
        for (int ai = 0; ai < 2; ++ai)
#pragma unroll
            for (int m = 0; m < 4; ++m) { const int r = ai * HALF + wr * 64 + m * 16 + fr;
                if (r < u.nvalid) { f32x4 v0, v1; const float s = rs[u.slot * BM + r];
#pragma unroll
                    for (int j = 0; j < 4; ++j) { const float a0 = s * acc[ai][0][m][0][j], a1 = s * acc[ai][0][m][1][j]; v0[j] = a0 * sigmoid_f(a0) * (s * acc[ai][1][m][0][j]); v1[j] = a1 * sigmoid_f(a1) * (s * acc[ai][1][m][1][j]); }
                    *(u32x4*)(ACT + (size_t)(rbase + r) * 512 + col0) = pack8(v0, v1); }
                acc[ai][0][m][0] = (f32x4){0.f, 0.f, 0.f, 0.f}; acc[ai][0][m][1] = (f32x4){0.f, 0.f, 0.f, 0.f}; acc[ai][1][m][0] = (f32x4){0.f, 0.f, 0.f, 0.f}; acc[ai][1][m][1] = (f32x4){0.f, 0.f, 0.f, 0.f}; }
    }
};
struct EpiDown {
    static constexpr bool PERM = true, AFTER_DRAIN = false; static constexpr int BMAP = 2;
    bf16_t* Y; const PG8_LAS int* rstart; const PG8_LAS float* wt; PG8_LAS unsigned char* stg;
    static constexpr int NST = 0;
    __device__ __forceinline__ void operator()(f32x4 (&acc)[2][2][4][2], const Unit& u, int wr, int wc, int fr, int fq) const {
        const int rbase = __builtin_amdgcn_readfirstlane(rstart[u.e]) + BM * u.rt, lane = fq * 16 + fr;
        PG8_LAS unsigned char* wp = stg + fr * 144 + fq * 16;
        const PG8_LAS unsigned char* rp = stg + (lane >> 3) * 144 + (lane & 7) * 16;
        bf16_t* gp = Y + (size_t)(rbase + wr * 64 + (lane >> 3)) * 1024 + u.pn * BM + wc * 64 + (lane & 7) * 8;
#pragma unroll
        for (int ai = 0; ai < 2; ++ai)
#pragma unroll
            for (int m = 0; m < 4; ++m) { const int r = ai * HALF + wr * 64 + m * 16 + fr; const float w = wt[u.slot * BM + r];
#pragma unroll
                for (int bj = 0; bj < 2; ++bj) { *(PG8_LAS u32x4*)(wp + bj * 64) = pack8(acc[ai][bj][m][0] * w, acc[ai][bj][m][1] * w); acc[ai][bj][m][0] = (f32x4){0.f, 0.f, 0.f, 0.f}; acc[ai][bj][m][1] = (f32x4){0.f, 0.f, 0.f, 0.f}; }
                const u32x4 r0 = *(const PG8_LAS u32x4*)rp, r1 = *(const PG8_LAS u32x4*)(rp + 8 * 144);
                const int rs = ai * HALF + wr * 64 + m * 16 + (lane >> 3); bf16_t* g0 = gp + (size_t)(ai * HALF + m * 16) * 1024;
                const bf16_t* g1 = g0 + 8 * 1024;
                if (rs < u.nvalid) asm volatile("global_store_dwordx4 %0, %1, off nt" :: "v"(g0), "v"(r0) : "memory");
                if (rs + 8 < u.nvalid) asm volatile("global_store_dwordx4 %0, %1, off nt" :: "v"(g1), "v"(r1) : "memory"); }
    }
};

template <class Epi, class Sched, bool ALIGN_EPI, bool GATHER, bool DUAL = false>
__device__ __forceinline__ void gemm_phase(PG8_LAS unsigned char* lds, const int K, const Sched& S, const Epi& E, unsigned char* dump = nullptr) {
    int tid_ = threadIdx.x; asm volatile("" : "+v"(tid_));
    const int tid = tid_, wid = __builtin_amdgcn_readfirstlane(tid >> 6), lane = tid & 63, wr = wid >> 2, wc = wid & 3, fr = lane & 15, fq = lane >> 4;
    const int nth = K / BK, nt = DUAL ? 2 * nth : nth;
    unsigned voffB[2][2], voffC[2][2], voffN[2][2]; int Rp[2], Cp[2];
#pragma unroll
    for (int i = 0; i < 2; ++i) { int R, C; stage_rc(tid * 16 + i * 8192, R, C); Rp[i] = R; Cp[i] = C;
#pragma unroll
        for (int hh = 0; hh < 2; ++hh) { const int Rb = Epi::BMAP == 2 ? (64 * (R >> 5) + 32 * hh + perm32(R & 31)) : (HALF * hh + (Epi::PERM ? ((R & ~31) + perm32(R & 31)) : R)); voffB[hh][i] = (unsigned)(Rb * K + C) * 2u; }
        voffC[0][i] = (unsigned)(R * K + C) * 2u; voffC[1][i] = (unsigned)((R + HALF) * K + C) * 2u; voffN[0][i] = voffC[0][i]; voffN[1][i] = voffC[1][i]; }
    const size_t kstep = (size_t)(BK * 2);
    const unsigned ldsw = (unsigned)wid * 1024u;
    const int aoff = lds_byte(wr * 64 + fr, fq * 8), boff = lds_byte(wc * 32 + fr, fq * 8);
#define PG8_SA(b, h) (((b) * 2 + (h)) * HTB)
#define PG8_SB(b, h) ((4 + (b) * 2 + (h)) * HTB)
#define PG8_STAGE(bufoff, gbase, voff) do { _Pragma("unroll") for (int _i = 0; _i < 2; ++_i) \
        __builtin_amdgcn_global_load_lds((const unsigned*)((const char*)(gbase) + (voff)[_i]), (PG8_LAS unsigned*)(lds + (bufoff) + ldsw + _i * 8192), 16, 0, 0); } while (0)
#define PG8_LDA(dst, b, h) do { _Pragma("unroll") for (int m = 0; m < 4; ++m) _Pragma("unroll") for (int k = 0; k < 2; ++k) dst[m][k] = *(const PG8_LAS bf16x8*)(lds + PG8_SA(b, h) + aoff + m * 2048 + k * 1024); } while (0)
#define PG8_LDB(dst, b, h) do { _Pragma("unroll") for (int n = 0; n < 2; ++n) _Pragma("unroll") for (int k = 0; k < 2; ++k) dst[n][k] = *(const PG8_LAS bf16x8*)(lds + PG8_SB(b, h) + boff + n * 2048 + k * 1024); } while (0)
#define PG8_MMA(ai, bj, At, Bt) do { __builtin_amdgcn_s_setprio(1); _Pragma("unroll") for (int m = 0; m < 4; ++m) _Pragma("unroll") for (int n = 0; n < 2; ++n) _Pragma("unroll") for (int k = 0; k < 2; ++k) \
        acc[ai][bj][m][n] = __builtin_amdgcn_mfma_f32_16x16x32_bf16(Bt[n][k], At[m][k], acc[ai][bj][m][n], 0, 0, 0); __builtin_amdgcn_s_setprio(0); } while (0)
#define PG8_WAIT_V(n) asm volatile("s_waitcnt vmcnt(" #n ")" ::: "memory")
#define PG8_WAIT_VR(rlx) do { if constexpr (Epi::NST == 16) asm volatile("s_waitcnt vmcnt(24)\n\ts_cmp_lg_u32 %0, 0\n\ts_cbranch_scc1 .Lrlx_%=\n\ts_waitcnt vmcnt(8)\n.Lrlx_%=:" :: "s"(rlx) : "memory", "scc"); \
        else if constexpr (Epi::NST == 8) asm volatile("s_waitcnt vmcnt(16)\n\ts_cmp_lg_u32 %0, 0\n\ts_cbranch_scc1 .Lrlx_%=\n\ts_waitcnt vmcnt(8)\n.Lrlx_%=:" :: "s"(rlx) : "memory", "scc"); else PG8_WAIT_V(8); } while (0)
#define PG8_WAIT_L(n) asm volatile("s_waitcnt lgkmcnt(" #n ")" ::: "memory")
#define PG8_BAR __builtin_amdgcn_s_barrier()
#define PG8_SCHED __builtin_amdgcn_sched_barrier(0)
    Unit cur, nxt; int ui = 0;
    if (!S.next(0, cur)) return;
    if constexpr (GATHER) S.a_rows(0, Rp, Cp, voffC);
    f32x4 acc[2][2][4][2];
#pragma unroll
    for (int a = 0; a < 2; ++a)
#pragma unroll
        for (int b = 0; b < 2; ++b)
#pragma unroll
            for (int m = 0; m < 4; ++m)
#pragma unroll
                for (int n = 0; n < 2; ++n) acc[a][b][m][n] = (f32x4){0.f, 0.f, 0.f, 0.f};
    bf16x8 At[4][2], B0[2][2], B1[2][2];
    const char* cA = S.a_tile(cur); const char* cB = S.b_tile(cur);
    const char* cA2 = cA; const char* cB2 = cB;
    if constexpr (DUAL) { cA2 = S.a_tile2(cur) - (size_t)nth * (size_t)(BK * 2); cB2 = S.b_tile2(cur) - (size_t)nth * (size_t)(BK * 2); }
    PG8_STAGE(PG8_SB(0, 0), cB, voffB[0]); PG8_STAGE(PG8_SB(0, 1), cB, voffB[1]); PG8_STAGE(PG8_SA(0, 0), cA, voffC[0]); PG8_STAGE(PG8_SA(0, 1), cA, voffC[1]);
    if (wr == 1) PG8_BAR;
    PG8_WAIT_V(2); PG8_BAR;
    PG8_STAGE(PG8_SB(1, 0), cB + kstep, voffB[0]); PG8_STAGE(PG8_SA(1, 0), cA + kstep, voffC[0]); PG8_STAGE(PG8_SB(1, 1), cB + kstep, voffB[1]);
    PG8_WAIT_V(6); PG8_BAR;
    (void)dump;
    for (;;) {
        const bool has_next = S.next(ui + 1, nxt);
        const char* nA = has_next ? S.a_tile(nxt) : cA; const char* nB = has_next ? S.b_tile(nxt) : cB;
        if constexpr (GATHER) { if (has_next) S.a_rows(ui + 1, Rp, Cp, voffN); else {
#pragma unroll
                for (int h = 0; h < 2; ++h)
#pragma unroll
                    for (int p = 0; p < 2; ++p) voffN[h][p] = voffC[h][p]; } }
#define PG8_KTRIP(FIRST_) do { \
            const bool last = (t == nt - 2); \
            const char* a1 = ((DUAL && t >= nth) ? cA2 : cA) + (size_t)(t + 1) * kstep; \
            const char* a2 = last ? nA : ((DUAL && t + 2 >= nth) ? cA2 : cA) + (size_t)(t + 2) * kstep; const char* b2 = last ? nB : ((DUAL && t + 2 >= nth) ? cB2 : cB) + (size_t)(t + 2) * kstep; \
            const char* a3 = a2 + kstep; const char* b3 = b2 + kstep; \
            unsigned vo2[2][2]; \
            _Pragma("unroll") \
            for (int h = 0; h < 2; ++h) \
            _Pragma("unroll") \
                for (int p = 0; p < 2; ++p) vo2[h][p] = (GATHER && last) ? voffN[h][p] : voffC[h][p]; \
            PG8_LDB(B0, 0, 0); PG8_LDB(B1, 0, 1); PG8_SCHED; PG8_LDA(At, 0, 0); PG8_STAGE(PG8_SA(1, 1), a1, voffC[1]); \
            PG8_WAIT_VR(FIRST_); PG8_WAIT_L(0); PG8_BAR; PG8_MMA(0, 0, At, B0); PG8_MMA(0, 1, At, B1); PG8_BAR; PG8_SCHED; \
            PG8_LDA(At, 0, 1); PG8_STAGE(PG8_SB(0, 0), b2, voffB[0]); PG8_STAGE(PG8_SB(0, 1), b2, voffB[1]); PG8_STAGE(PG8_SA(0, 0), a2, vo2[0]); \
            PG8_WAIT_VR(FIRST_); PG8_WAIT_L(0); PG8_BAR; PG8_MMA(1, 0, At, B0); PG8_MMA(1, 1, At, B1); PG8_BAR; PG8_SCHED; \
            PG8_LDB(B0, 1, 0); PG8_LDB(B1, 1, 1); PG8_SCHED; PG8_LDA(At, 1, 0); PG8_STAGE(PG8_SA(0, 1), a2, vo2[1]); \
            PG8_WAIT_V(8); PG8_WAIT_L(0); PG8_BAR; PG8_MMA(0, 0, At, B0); PG8_MMA(0, 1, At, B1); PG8_BAR; PG8_SCHED; \
            PG8_LDA(At, 1, 1); PG8_STAGE(PG8_SB(1, 0), b3, voffB[0]); PG8_STAGE(PG8_SB(1, 1), b3, voffB[1]); PG8_STAGE(PG8_SA(1, 0), a3, vo2[0]); \
            PG8_WAIT_V(8); PG8_WAIT_L(0); PG8_BAR; PG8_MMA(1, 0, At, B0); PG8_MMA(1, 1, At, B1); PG8_BAR; PG8_SCHED; \
        } while (0)
        for (int t = 0; t < nt; t += 2) { const int rlx = __builtin_amdgcn_readfirstlane((t == 0 && ui > 0) ? 1 : 0); if constexpr (DUAL) { if (t == nth) E.mid(acc, cur, wr, wc, fr, fq); } PG8_KTRIP(rlx); }
#undef PG8_KTRIP
        if constexpr (ALIGN_EPI) { if (wr == 0) PG8_BAR; }
        E(acc, cur, wr, wc, fr, fq);
        if (!has_next) break;
        cur = nxt; cA = nA; cB = nB; ++ui;
        if constexpr (DUAL) { cA2 = S.a_tile2(cur) - (size_t)nth * (size_t)(BK * 2); cB2 = S.b_tile2(cur) - (size_t)nth * (size_t)(BK * 2); }
        if constexpr (GATHER) {
#pragma unroll
            for (int h = 0; h < 2; ++h)
#pragma unroll
                for (int p = 0; p < 2; ++p) voffC[h][p] = voffN[h][p]; }
        if constexpr (ALIGN_EPI) { if (wr == 1) PG8_BAR; }
    }
    PG8_WAIT_V(0);
    if constexpr (!ALIGN_EPI) { if (wr == 0) PG8_BAR; }
    PG8_BAR;
#undef PG8_SA
#undef PG8_SB
#undef PG8_STAGE
#undef PG8_LDA
#undef PG8_LDB
#undef PG8_MMA
#undef PG8_WAIT_V
#undef PG8_WAIT_VR
#undef PG8_WAIT_L
#undef PG8_BAR
#undef PG8_SCHED
}
}

#include <hip/hip_bf16.h>
#include <cmath>
namespace attn_body {
using bf16=__hip_bfloat16;
using bf16x8=__attribute__((ext_vector_type(8)))short;
using s16x4=__attribute__((ext_vector_type(4)))short;
using f32x16=__attribute__((ext_vector_type(16)))float;
using u32x4=__attribute__((ext_vector_type(4)))unsigned;
using f32x4_t=__attribute__((ext_vector_type(4)))float;
constexpr int BATCH=32,NHEAD=16,SEQ=2048,D=64,DM=NHEAD*D;
constexpr int NW=8,QBLK=32,QB=QBLK*NW,KVBLK=64,NQB=SEQ/QB;
constexpr int ATTN_PITCH=DM, ATTN_UNIT_ROWS=QB;
__device__ __forceinline__ int crow(int r,int hi){return (r&3)+8*(r>>2)+4*hi;}
#define SBAR() __builtin_amdgcn_sched_barrier(0)
__device__ __forceinline__ void cmask(f32x16&p0,f32x16&p1,int jb,int qrel,int hi){
  const float NEG=-INFINITY; int kb=64*jb+4*hi;
  #pragma unroll
  for(int r=0;r<16;++r){int kv=kb+(r&3)+8*(r>>2); if(kv>qrel)p0[r]=NEG; if(kv+32>qrel)p1[r]=NEG;}
}

constexpr int NSLOT=3, SLOTB=8192;
constexpr int LDS_K=0, LDS_V=NSLOT*SLOTB, LDS_WS=2*NSLOT*SLOTB, LDS_OST=LDS_WS+NW*64*4, LDS_REC=LDS_OST+NW*4096, LDS_BYTES=LDS_REC+SEQ*8, LDS_ZR=LDS_BYTES, ZR_ROWS=18, LDS_CW=LDS_ZR+ZR_ROWS*2048, LDS_SIDE_END=LDS_CW+16384;
constexpr float C2=0.125f*1.4426950408889634f;
__device__ __forceinline__ void glds16(const void*gsrc,unsigned lds_dst){unsigned keep;
  asm volatile("s_mov_b32 %0, m0\n\ts_mov_b32 m0, %2\n\ts_nop 0\n\tglobal_load_lds_dwordx4 %1, off\n\ts_mov_b32 m0, %0":"=&s"(keep):"v"(gsrc),"s"(lds_dst):"memory");}
__device__ __forceinline__ float max3f(float a,float b,float c){float r;asm("v_max3_f32 %0, %1, %2, %3":"=v"(r):"v"(a),"v"(b),"v"(c));return r;}
__device__ __forceinline__ float max2f(float a,float b){float r;asm("v_max_f32_e32 %0, %1, %2":"=v"(r):"v"(a),"v"(b));return r;}
__device__ __forceinline__ float fadd_s(float a,float b){float r;asm("v_add_f32_e32 %0, %1, %2":"=v"(r):"v"(a),"v"(b));return r;}
__device__ __forceinline__ float fsub_s(float a,float b){float r;asm("v_sub_f32_e32 %0, %1, %2":"=v"(r):"v"(a),"v"(b));return r;}
typedef float f32x2_t __attribute__((ext_vector_type(2))); typedef __bf16 bf16x2_t __attribute__((ext_vector_type(2)));
__device__ __forceinline__ unsigned cvtpk_s(float lo,float hi){f32x2_t v={lo,hi};bf16x2_t b=__builtin_convertvector(v,bf16x2_t);return __builtin_bit_cast(unsigned,b);}
#define WAIT_BAR(N) asm volatile("s_waitcnt vmcnt(" #N ") lgkmcnt(0)\n\ts_barrier":::"memory")

__device__ __forceinline__ void qkt(f32x16&p0,f32x16&p1,const char*Kslot,const bf16x8*qr,bf16x8 ab0,bf16x8 ab1,bf16x8 bq,int r32,int hi){
  const char*kb=Kslot+hi*1024+r32*16;
  p0=__builtin_amdgcn_mfma_f32_32x32x16_bf16(ab0,bq,f32x16{},0,0,0);p1=__builtin_amdgcn_mfma_f32_32x32x16_bf16(ab1,bq,f32x16{},0,0,0);
  #pragma unroll
  for(int d0=0;d0<4;++d0){
    const bf16x8 b0=*reinterpret_cast<const bf16x8*>(kb+d0*2048);
    const bf16x8 b1=*reinterpret_cast<const bf16x8*>(kb+d0*2048+512);
    p0=__builtin_amdgcn_mfma_f32_32x32x16_bf16(b0,qr[d0],p0,0,0,0);p1=__builtin_amdgcn_mfma_f32_32x32x16_bf16(b1,qr[d0],p1,0,0,0);}
}
__device__ __forceinline__ u32x4 make_bq(float mhat,int hi){
  const float nm=-mhat; const unsigned h1=cvtpk_s(nm,0.f)&0xffffu; const float r1=nm-__uint_as_float(h1<<16);
  const unsigned h2=cvtpk_s(r1,0.f)&0xffffu; const float r2=r1-__uint_as_float(h2<<16); const unsigned h3=cvtpk_s(r2,0.f)&0xffffu;
  u32x4 b; b.x=hi?0u:0x3f803f80u; b.y=hi?0u:(0x3f80u|(h1<<16)); b.z=hi?0u:(h2|(h3<<16)); b.w=0u; return b;
}
typedef unsigned u32x2_t __attribute__((ext_vector_type(2)));
#define ABF(rc) __builtin_bit_cast(bf16x8,(u32x4){(rc).x,(rc).y,0x3f803f80u,0u})
typedef __attribute__((address_space(3))) const char* lds_cptr;
typedef short v4i16_t __attribute__((ext_vector_type(4)));
__device__ __forceinline__ void kload8(bf16x8*kf,lds_cptr kp){
  kf[0]=*(const __attribute__((address_space(3))) bf16x8*)(kp);      kf[1]=*(const __attribute__((address_space(3))) bf16x8*)(kp+512);
  kf[2]=*(const __attribute__((address_space(3))) bf16x8*)(kp+2048); kf[3]=*(const __attribute__((address_space(3))) bf16x8*)(kp+2560);
  kf[4]=*(const __attribute__((address_space(3))) bf16x8*)(kp+4096); kf[5]=*(const __attribute__((address_space(3))) bf16x8*)(kp+4608);
  kf[6]=*(const __attribute__((address_space(3))) bf16x8*)(kp+6144); kf[7]=*(const __attribute__((address_space(3))) bf16x8*)(kp+6656);
}
__device__ __forceinline__ void kload2(bf16x8*kf,lds_cptr kp,int j){ kf[2*j]=*(const __attribute__((address_space(3))) bf16x8*)(kp+j*2048); kf[2*j+1]=*(const __attribute__((address_space(3))) bf16x8*)(kp+j*2048+512); }
__device__ __forceinline__ s16x4 vtr(lds_cptr p){ return __builtin_bit_cast(s16x4,__builtin_amdgcn_ds_read_tr16_b64_v4i16((__attribute__((address_space(3))) v4i16_t*)p)); }
__device__ __forceinline__ float rowmax(const f32x16&p0,const f32x16&p1){
  float a=max3f(p0[0],p0[1],p1[0]),b=max3f(p0[2],p0[3],p1[1]);a=max3f(a,p1[2],p1[3]);
  #pragma unroll
  for(int r=4;r<16;r+=4){a=max3f(a,p0[r],p0[r+1]);b=max3f(b,p0[r+2],p0[r+3]);a=max3f(a,p1[r],p1[r+1]);b=max3f(b,p1[r+2],p1[r+3]);}
  const float m=max2f(a,b);
  auto rr=__builtin_amdgcn_permlane32_swap(__float_as_uint(m),__float_as_uint(m),false,false);
  return max2f(__uint_as_float(rr[0]),__uint_as_float(rr[1]));
}
__device__ __forceinline__ void pv(f32x16*o,int vb,bf16x8 pa0,bf16x8 pa1,bf16x8 pa2,bf16x8 pa3){
  #pragma unroll
  for(int d0=0;d0<2;++d0){s16x4 lo[4],hi[4];
    #pragma unroll
    for(int ks=0;ks<4;++ks){
      asm volatile("ds_read_b64_tr_b16 %0,%1 offset:%c2":"=&v"(lo[ks]):"v"(vb),"i"(d0*4096+ks*1024):"memory");
      asm volatile("ds_read_b64_tr_b16 %0,%1 offset:%c2":"=&v"(hi[ks]):"v"(vb),"i"(d0*4096+ks*1024+512):"memory");}
    asm volatile("s_waitcnt lgkmcnt(0)":::"memory");SBAR();
    #define PK(k) (bf16x8){lo[k][0],lo[k][1],lo[k][2],lo[k][3],hi[k][0],hi[k][1],hi[k][2],hi[k][3]}
    o[d0]=__builtin_amdgcn_mfma_f32_32x32x16_bf16(pa0,PK(0),o[d0],0,0,0);
    o[d0]=__builtin_amdgcn_mfma_f32_32x32x16_bf16(pa1,PK(1),o[d0],0,0,0);
    o[d0]=__builtin_amdgcn_mfma_f32_32x32x16_bf16(pa2,PK(2),o[d0],0,0,0);
    o[d0]=__builtin_amdgcn_mfma_f32_32x32x16_bf16(pa3,PK(3),o[d0],0,0,0);
    #undef PK
  }
}

#ifndef ATTN_STORE16
#define ATTN_STORE16(p,v) (*(u32x4*)(p)=(v))
#endif
struct ConvSide { const bf16* Z; bf16* B; int row0; };
template<int THRL,bool SIDE> __device__ __forceinline__ void attn_unit(int b,int h,int qb,const bf16*Q,const bf16*__restrict__ K,const bf16*__restrict__ V,bf16*O,const u32x2_t*__restrict__ REC,char*shm,const ConvSide&cs,int ci){
  int tid_=threadIdx.x; asm volatile("":"+v"(tid_)); const int tid=tid_,lane=tid&63,r32=lane&31,hi=lane>>5; const int wid=__builtin_amdgcn_readfirstlane(tid>>6);
  const long rowbase=(long)b*SEQ; const int q0=qb*QB;
  const bf16*Qw=Q+(rowbase+q0+wid*QBLK)*DM+h*D;
  const bf16*Kh=K+rowbase*DM+h*D,*Vh=V+rowbase*DM+h*D;
  const unsigned lds0=(unsigned)(uintptr_t)shm;
  float*wsf=(float*)(shm+LDS_WS)+wid*64;
  const bf16*ksrc=Kh+(long)lane*DM+wid*8;
  const bf16*vsrc=Vh+(long)(16*(wid&3)+(lane>>2))*DM+(wid>>2)*32+(lane&3)*8;
  const unsigned kdst=lds0+LDS_K+wid*1024, vdst=lds0+LDS_V+wid*1024;
  #define DMA_K(t,slot) glds16(ksrc+(long)(t)*KVBLK*DM,(unsigned)__builtin_amdgcn_readfirstlane(kdst+(slot)))
  #define DMA_V(t,slot) glds16(vsrc+(long)(t)*KVBLK*DM,(unsigned)__builtin_amdgcn_readfirstlane(vdst+(slot)))
  const int vb0=(int)(lds0+LDS_V)+((lane>>4)&1)*32+(lane&3)*8+(4*hi+((lane&15)>>2))*64;
  const char*Kbase=shm+LDS_K; bf16x8 kf[8];
  const lds_cptr shm3=(lds_cptr)shm; const lds_cptr kp0=shm3+LDS_K+hi*1024+r32*16; const lds_cptr vp0=shm3+LDS_V+((lane>>4)&1)*32+(lane&3)*8+(4*hi+((lane&15)>>2))*64;
  const int NT=(q0+QB)/KVBLK;
  const u32x2_t*RECh=REC+(long)(b*NHEAD+h)*SEQ; const int nkeys=q0+QB; const int rk=2*tid;
  u32x4 rv0=u32x4{},rv1=u32x4{};
  if(rk<nkeys)rv0=*reinterpret_cast<const u32x4*>(RECh+rk);
  if(rk+1024<nkeys)rv1=*reinterpret_cast<const u32x4*>(RECh+rk+1024);
  const lds_cptr recp=(lds_cptr)shm+LDS_REC+r32*8;
  DMA_K(0,0);DMA_V(0,0);DMA_K(1,SLOTB);
  bf16x8 qr[4];
  #pragma unroll
  for(int d0=0;d0<4;++d0)qr[d0]=*reinterpret_cast<const bf16x8*>(&Qw[(long)r32*DM+d0*16+hi*8]);
  float l_reg=0.f;f32x16 o[2];o[0]=f32x16{};o[1]=f32x16{};
  { __attribute__((address_space(3))) u32x4*rl=(__attribute__((address_space(3))) u32x4*)((lds_cptr)shm+LDS_REC);
    if(rk<nkeys)rl[tid]=rv0; if(rk+1024<nkeys)rl[tid+512]=rv1; }
  u32x4 bq;
  u32x2_t rcA,rcB;
  #define RECLD(t_) do{ rcA=*(const __attribute__((address_space(3))) u32x2_t*)(recp+(t_)*512); rcB=*(const __attribute__((address_space(3))) u32x2_t*)(recp+(t_)*512+256); }while(0)
  const int qrel=wid*QBLK+r32;
  #define CMASK(P0,P1,t) do{int jb_=(t)-(NT-4); if(jb_>=0)cmask(P0,P1,jb_,qrel,hi);}while(0)
  #define START(P0,P1) do{ _Pragma("unroll") for(int r=0;r<16;++r)P0[r]=__builtin_amdgcn_exp2f(P0[r]); }while(0)
  #define RESC() do{}while(0)
  f32x16 pA0,pA1,pB0,pB1;
  int sl_prev=0,sl_cur=0,sl_next=SLOTB;
  #define ROT() do{sl_prev=sl_cur;sl_cur=sl_next;sl_next=(sl_next==(NSLOT-1)*SLOTB)?0:sl_next+SLOTB;}while(0)
  if constexpr(SIDE) asm volatile(""::"v"(qr[0]),"v"(qr[1]),"v"(qr[2]),"v"(qr[3]));
  DMA_K(2,2*SLOTB);
  if constexpr(SIDE){
    const int r0=16*ci+2*wid; const char*zg=(const char*)cs.Z+((long)cs.row0+r0)*2048+lane*16; const char*bg=(const char*)cs.B+((long)cs.row0+r0)*2048+lane*16;
    #pragma unroll
    for(int rr=0;rr<2;++rr){ const int slot=(r0+rr)%ZR_ROWS;
      #pragma unroll
      for(int hf=0;hf<2;++hf){ glds16(zg+rr*2048+hf*1024,(unsigned)__builtin_amdgcn_readfirstlane(lds0+LDS_ZR+slot*2048+hf*1024)); glds16(bg+rr*2048+hf*1024,(unsigned)__builtin_amdgcn_readfirstlane(lds0+LDS_OST+wid*4096+rr*2048+hf*1024)); } }
    WAIT_BAR(9);
  } else
  WAIT_BAR(3);
  { const u32x2_t rq=*(const __attribute__((address_space(3))) u32x2_t*)((lds_cptr)shm+LDS_REC+(q0+qrel)*8);
    const unsigned n1=(rq.x&0xffffu)^0x8000u, n2=(rq.x>>16)^0x8000u, n3=(rq.y&0xffffu)^0x8000u;
    bq.x=hi?0u:0x3f803f80u; bq.y=hi?0u:(0x3f80u|(n1<<16)); bq.z=hi?0u:(n2|(n3<<16)); bq.w=0u; }
  RECLD(0);
  qkt(pA0,pA1,Kbase,qr,ABF(rcA),ABF(rcB),__builtin_bit_cast(bf16x8,bq),r32,hi);asm volatile("s_nop 15\n\ts_nop 7":"+v"(pA0),"+v"(pA1));CMASK(pA0,pA1,0);
  START(pA0,pA1);
  _Pragma("unroll") for(int r=0;r<16;++r)pA1[r]=__builtin_amdgcn_exp2f(pA1[r]);
  if constexpr(SIDE){ WAIT_BAR(8); } else
  WAIT_BAR(0);
  DMA_K(3,0);DMA_V(1,SLOTB);
  ROT();
  kload8(kf,kp0+sl_cur);
  RECLD(1);
  if constexpr(SIDE){ WAIT_BAR(10); } else
  WAIT_BAR(2);
  s16x4 vlo[8],vhi[8]; u32x4 pw0,pw1,pw2,pw3;
  #define PKW(P,B) cvtpk_s(P[B],P[B+1])
  #define PAF(k) __builtin_bit_cast(bf16x8,pw##k)
  #define VFR(i) (bf16x8){vlo[i][0],vlo[i][1],vlo[i][2],vlo[i][3],vhi[i][0],vhi[i][1],vhi[i][2],vhi[i][3]}
  #define PIN(x) asm volatile("":"+v"(x))
  #define MX3(a,b,c) __builtin_fmaxf(__builtin_fmaxf((a),(b)),(c))
  #define GAPA(MF,A0,A1,A2,A3,W0,W1,PW) do{ MF; sacc+=A0; sacc+=A1; sacc+=A2; sacc+=A3; PIN(sacc); W0; W1; PIN(PW); SBAR(); }while(0)
  #define EX(v) __builtin_amdgcn_exp2f(v)
  #define GAPB(MF,X,B) do{ MF; X[B]=EX(X[B]); X[B+1]=EX(X[B+1]); X[B+2]=EX(X[B+2]); X[B+3]=EX(X[B+3]); PIN(X); SBAR(); }while(0)
  #define VRD(i) do{ vlo[i]=vtr(vp_+(((i)>>2)*4096+((i)&3)*1024)); vhi[i]=vtr(vp_+(((i)>>2)*4096+((i)&3)*1024+512)); }while(0)
  #define KRD(G,j) do{ if(G){ kload2(kf,kp0+sl_next,j); SBAR(); } }while(0)
  #define STEP(C0,C1,P0,P1,t,GK,GV,GL) do{ SBAR(); \
    const lds_cptr vp_=vp0+sl_prev; \
    VRD(0); SBAR(); float sacc=(P0[0]+P0[1]); \
    C0=__builtin_amdgcn_mfma_f32_32x32x16_bf16(ABF(rcA),__builtin_bit_cast(bf16x8,bq),f32x16{},0,0,0); C1=__builtin_amdgcn_mfma_f32_32x32x16_bf16(ABF(rcB),__builtin_bit_cast(bf16x8,bq),f32x16{},0,0,0); SBAR(); \
    GAPA(C0=__builtin_amdgcn_mfma_f32_32x32x16_bf16(kf[0],qr[0],C0,0,0,0), P0[2],P0[3],P0[4],P0[5],     pw0[0]=PKW(P0,0), pw0[1]=PKW(P0,2), pw0); \
    VRD(4); SBAR(); GAPA(C1=__builtin_amdgcn_mfma_f32_32x32x16_bf16(kf[1],qr[0],C1,0,0,0), P0[6],P0[7],P0[8],P0[9],     pw0[2]=PKW(P0,4), pw0[3]=PKW(P0,6), pw0); \
    VRD(1); SBAR(); GAPA(C0=__builtin_amdgcn_mfma_f32_32x32x16_bf16(kf[2],qr[1],C0,0,0,0),   P0[10],P0[11],P0[12],P0[13], pw1[0]=PKW(P0,8), pw1[1]=PKW(P0,10), pw1); \
    VRD(5); SBAR(); GAPA(C1=__builtin_amdgcn_mfma_f32_32x32x16_bf16(kf[3],qr[1],C1,0,0,0),   P0[14],P0[15],P1[0],P1[1],   pw1[2]=PKW(P0,12),pw1[3]=PKW(P0,14), pw1); \
    VRD(2); SBAR(); GAPA(C0=__builtin_amdgcn_mfma_f32_32x32x16_bf16(kf[4],qr[2],C0,0,0,0),   P1[2],P1[3],P1[4],P1[5],     pw2[0]=PKW(P1,0), pw2[1]=PKW(P1,2), pw2); \
    VRD(6); SBAR(); GAPA(C1=__builtin_amdgcn_mfma_f32_32x32x16_bf16(kf[5],qr[2],C1,0,0,0),   P1[6],P1[7],P1[8],P1[9],     pw2[2]=PKW(P1,4), pw2[3]=PKW(P1,6), pw2); \
    VRD(3); SBAR(); GAPA(C0=__builtin_amdgcn_mfma_f32_32x32x16_bf16(kf[6],qr[3],C0,0,0,0),   P1[10],P1[11],P1[12],P1[13], pw3[0]=PKW(P1,8), pw3[1]=PKW(P1,10), pw3); \
    VRD(7); SBAR(); GAPA(C1=__builtin_amdgcn_mfma_f32_32x32x16_bf16(kf[7],qr[3],C1,0,0,0),   P1[14],P1[15],0.f,0.f,       pw3[2]=PKW(P1,12),pw3[3]=PKW(P1,14), pw3); \
    l_reg+=sacc; \
    if(GK){DMA_K((t)+3,sl_cur);} if(GV){DMA_V((t)+1,sl_next);} \
    CMASK(C0,C1,t); \
    SBAR(); \
    GAPB(o[0]=__builtin_amdgcn_mfma_f32_32x32x16_bf16(PAF(0),VFR(0),o[0],0,0,0), C0,0); \
    GAPB(o[1]=__builtin_amdgcn_mfma_f32_32x32x16_bf16(PAF(0),VFR(4),o[1],0,0,0), C0,4); \
    if(GL){ RECLD((t)+1); SBAR(); } \
    KRD(GL,0); GAPB(o[0]=__builtin_amdgcn_mfma_f32_32x32x16_bf16(PAF(1),VFR(1),o[0],0,0,0), C0,8); \
    KRD(GL,1); GAPB(o[1]=__builtin_amdgcn_mfma_f32_32x32x16_bf16(PAF(1),VFR(5),o[1],0,0,0), C0,12); \
    KRD(GL,2); GAPB(o[0]=__builtin_amdgcn_mfma_f32_32x32x16_bf16(PAF(2),VFR(2),o[0],0,0,0), C1,0); \
    KRD(GL,3); GAPB(o[1]=__builtin_amdgcn_mfma_f32_32x32x16_bf16(PAF(2),VFR(6),o[1],0,0,0), C1,4); \
    GAPB(o[0]=__builtin_amdgcn_mfma_f32_32x32x16_bf16(PAF(3),VFR(3),o[0],0,0,0), C1,8); \
    GAPB(o[1]=__builtin_amdgcn_mfma_f32_32x32x16_bf16(PAF(3),VFR(7),o[1],0,0,0), C1,12); \
    }while(0)
  int t=1;
  #undef CMASK
  #define CMASK(P0,P1,t) do{}while(0)
  for(;t+5<NT;t+=2){
    STEP(pB0,pB1,pA0,pA1,t,true,true,true);     WAIT_BAR(2); RESC(); ROT();
    STEP(pA0,pA1,pB0,pB1,t+1,true,true,true);   WAIT_BAR(2); RESC(); ROT();
  }
  #undef CMASK
  #define CMASK(P0,P1,t) do{int jb_=(t)-(NT-4); if(jb_>=0)cmask(P0,P1,jb_,qrel,hi);}while(0)
  #define ENDW(tt) do{ if((tt)+3<NT){WAIT_BAR(2);} else if((tt)+2<NT){WAIT_BAR(1);} else {WAIT_BAR(0);} }while(0)
  for(;t+1<NT;t+=2){
    STEP(pB0,pB1,pA0,pA1,t,(t+3<NT),(t+1<NT),(t+1<NT));       ENDW(t);   RESC(); ROT();
    STEP(pA0,pA1,pB0,pB1,t+1,(t+4<NT),(t+2<NT),(t+2<NT));     ENDW(t+1); RESC(); ROT();
  }
  STEP(pB0,pB1,pA0,pA1,NT-1,false,false,false); RESC();
  { float sacc=pB0[0]+pB0[1]; _Pragma("unroll") for(int r=2;r<16;++r)sacc+=pB0[r]; _Pragma("unroll") for(int r=0;r<16;++r)sacc+=pB1[r]; l_reg+=sacc;
    pw0=(u32x4){PKW(pB0,0),PKW(pB0,2),PKW(pB0,4),PKW(pB0,6)};pw1=(u32x4){PKW(pB0,8),PKW(pB0,10),PKW(pB0,12),PKW(pB0,14)};pw2=(u32x4){PKW(pB1,0),PKW(pB1,2),PKW(pB1,4),PKW(pB1,6)};pw3=(u32x4){PKW(pB1,8),PKW(pB1,10),PKW(pB1,12),PKW(pB1,14)};
    SBAR(); pv(o,vb0+sl_cur,PAF(0),PAF(1),PAF(2),PAF(3)); }
  #undef PKW
  #undef PAF
  #undef VFR
  #undef PIN
  #undef MX3
  #undef GAPA
  #undef GAPB
  #undef EX
  #undef VRD
  #undef KRD
  #undef STEP
  #undef ENDW
  if constexpr(SIDE){
    const int cg=tid&127,rq=wid>>1; const lds_cptr zr=(lds_cptr)shm+LDS_ZR+cg*16, br=(lds_cptr)shm+LDS_OST+(4*rq)*2048+cg*16, cw=(lds_cptr)shm+LDS_CW+cg*32;
    typedef __attribute__((address_space(3))) const u32x4* lq_t; typedef __attribute__((address_space(3))) const f32x4_t* lf_t;
    int sl=(16*ci+4*rq+ZR_ROWS-2)%ZR_ROWS; u32x4 zz[6],bb[4];
    #pragma unroll
    for(int k=0;k<6;++k){ zz[k]=*(lq_t)(zr+sl*2048); sl=(sl+1==ZR_ROWS)?0:sl+1; }
    #pragma unroll
    for(int k=0;k<4;++k)bb[k]=*(lq_t)(br+k*2048);
    f32x4_t w[4][2];
    #pragma unroll
    for(int p_=0;p_<4;++p_){ w[p_][0]=*(lf_t)(cw+p_*4096); w[p_][1]=*(lf_t)(cw+p_*4096+16); }
    bf16*yb=cs.B+((long)cs.row0+16*ci+4*rq)*DM+cg*8;
    #define UP2(x) ((f32x2_t){__uint_as_float((x)<<16),__uint_as_float((x)&0xffff0000u)})
    #define W2(p_,n_,h_) __builtin_shufflevector(w[p_][n_],w[p_][n_],2*(h_),2*(h_)+1)
    #pragma unroll
    for(int k=0;k<4;++k){ const u32x4 z2=zz[k],z1=zz[k+1],z0=zz[k+2],bv=bb[k]; u32x4 y;
      #define CV(n_,h_,ZW) ({ const f32x2_t r_=UP2(bv.ZW)*(W2(3,n_,h_)+W2(0,n_,h_)*UP2(z2.ZW)+W2(1,n_,h_)*UP2(z1.ZW)+W2(2,n_,h_)*UP2(z0.ZW)); cvtpk_s(r_.x,r_.y); })
      y.x=CV(0,0,x); y.y=CV(0,1,y); y.z=CV(1,0,z); y.w=CV(1,1,w);
      #undef CV
      *(u32x4*)(yb+(long)k*DM)=y; }
    #undef UP2
    #undef W2
    asm volatile("s_waitcnt lgkmcnt(0)\n\ts_barrier":::"memory");
  }
  {auto rr=__builtin_amdgcn_permlane32_swap(__float_as_uint(l_reg),__float_as_uint(l_reg),false,false);l_reg=__uint_as_float(rr[0])+__uint_as_float(rr[1]);}
  if(hi==0)wsf[32+r32]=l_reg;asm volatile("s_waitcnt lgkmcnt(0)":::"memory");
  float rli[16];
  #pragma unroll
  for(int r=0;r<16;++r)rli[r]=__builtin_amdgcn_rcpf(wsf[32+crow(r,hi)]);
  bf16*Ow=O+(rowbase+q0+wid*QBLK)*DM+h*D;
  { bf16*stg=(bf16*)(shm+LDS_OST)+wid*2048;
    #pragma unroll
    for(int r=0;r<16;++r){const int orow=crow(r,hi);
      #pragma unroll
      for(int d0=0;d0<2;++d0)stg[orow*64+d0*32+r32]=__float2bfloat16(o[d0][r]*rli[r]);}
    asm volatile("s_waitcnt lgkmcnt(0)":::"memory");
    #pragma unroll
    for(int i=0;i<4;++i){const int row=i*8+(lane>>3),ch=lane&7; const u32x4 v=*(const u32x4*)(stg+row*64+ch*8); ATTN_STORE16(Ow+(long)row*DM+ch*8,v);} }
  asm volatile("s_waitcnt lgkmcnt(0)\n\ts_barrier":::"memory");
  #undef DMA_K
  #undef DMA_V
  #undef RECLD
  #undef CMASK
  #undef START
  #undef RESC
  #undef ROT
}
constexpr int ATTN_LDS_BYTES=LDS_SIDE_END;
struct AttnTensors { const bf16* Q; const bf16* K; const bf16* V; bf16* O; const u32x2_t* REC; };
struct AttnUnit { int bh; int qb; };
struct StaticOrder {
  int vcu,ngrp;
  __device__ __forceinline__ explicit StaticOrder(int grid,int block):vcu((grid%8==0)?(block%8)*(grid/8)+block/8:block),ngrp(grid/8){}
  __device__ __forceinline__ bool next(int i,AttnUnit&u)const{ const int per=(BATCH*NHEAD+ngrp-1)/ngrp; if(i>=per)return false; const int s=vcu&7,g=vcu>>3; u.bh=g*per+i; if(u.bh>=BATCH*NHEAD)return false; u.qb=(i&1)?7-s:s; return true; }
  __device__ __forceinline__ void a_ready(const AttnUnit&)const{}
  __device__ __forceinline__ void done(const AttnUnit&)const{}
};
template<class Sched,int THRL=8,bool SIDE=false> __device__ __forceinline__ void attn_phase(char*lds,const AttnTensors&T,const Sched&S,const ConvSide&cs=ConvSide{nullptr,nullptr,0}){
  AttnUnit u;
  for(int i=0;S.next(i,u);++i){ S.a_ready(u); attn_unit<THRL,SIDE>(u.bh/NHEAD,u.bh%NHEAD,u.qb,T.Q,T.K,T.V,T.O,T.REC,lds,cs,i); S.done(u); }
}
#undef SBAR
#undef WAIT_BAR
}
#define GAS __attribute__((address_space(1)))
#define LAS __attribute__((address_space(3)))
typedef unsigned short bf16;
typedef unsigned v4u __attribute__((ext_vector_type(4)));
typedef float f32x4 __attribute__((ext_vector_type(4)));
typedef short bf16x8 __attribute__((ext_vector_type(8)));
typedef GAS unsigned gu32;
typedef GAS unsigned long long gu64;
#define RLX_AGENT __ATOMIC_RELAXED, __HIP_MEMORY_SCOPE_AGENT
#define LDS_WAIT() asm volatile("s_waitcnt lgkmcnt(0)" ::: "memory")
#define VM_WAIT() asm volatile("s_waitcnt vmcnt(0)" ::: "memory")
__device__ __forceinline__ unsigned long long rt() { return __builtin_amdgcn_s_memrealtime(); }
__device__ __forceinline__ unsigned f2bf(float f) { unsigned u = __builtin_bit_cast(unsigned, f); return (u + 0x7fffu + ((u >> 16) & 1u)) >> 16; }
__device__ __forceinline__ unsigned pk2(float lo, float hi) { return f2bf(lo) | (f2bf(hi) << 16); }

#define XB_TMO      128
#define XB_XCNT(j)  (256  + 64 * (j))
#define XB_XSUB(j)  (1280 + 64 * (j))
#define XB_XGEN(j)  (2304 + 64 * (j))
#define XB_TOP      3328
#define XB_TOPGEN   3392
#define XCD_BAR_WORDS 3456
#define XB_SPIN_CAP (1u << 18)

__device__ __forceinline__ unsigned xb_ld(unsigned* p)              { return __hip_atomic_load(p, __ATOMIC_RELAXED, __HIP_MEMORY_SCOPE_AGENT); }
__device__ __forceinline__ unsigned xb_add(unsigned* p, unsigned v) { return __hip_atomic_fetch_add(p, v, __ATOMIC_RELAXED, __HIP_MEMORY_SCOPE_AGENT); }
__device__ __forceinline__ unsigned xb_xcc_id() { return (unsigned)__builtin_amdgcn_s_getreg((3 << 11) | 20) & 0xFu; }
#define XB_SPIN(cond, bar) do { unsigned _sp = 0; while (cond) { __builtin_amdgcn_s_sleep(1); \
    if ((++_sp & 255u) == 0u) { if (xb_ld(&(bar)[XB_TMO])) break; if (_sp > XB_SPIN_CAP) { atomicAdd(&(bar)[XB_TMO], 1u); break; } } } } while (0)

struct XcdBarrier {
    unsigned* bar; unsigned x;
    volatile LAS unsigned* st;
};

__device__ __forceinline__ XcdBarrier xcd_barrier_post(unsigned* bar, volatile LAS unsigned* st) {
    XcdBarrier b; b.bar = bar; b.x = xb_xcc_id(); b.st = st;
    if (threadIdx.x == 0) (void)xb_add(&bar[XB_XCNT(b.x)], 1u);
    return b;
}
__device__ __forceinline__ void xcd_barrier_complete(unsigned* bar, unsigned x, unsigned& nloc, unsigned& nx) {
    const unsigned G = gridDim.x * gridDim.y * gridDim.z;
    unsigned sum, cnt, mine, sp = 0u;
    for (;;) {
        sum = 0u; cnt = 0u; mine = 0u;
#pragma unroll
        for (unsigned j = 0; j < 16; ++j) { const unsigned c = xb_ld(&bar[XB_XCNT(j)]); sum += c; cnt += (c > 0u) ? 1u : 0u; mine = (j == x) ? c : mine; }
        if (sum == G) break;
        __builtin_amdgcn_s_sleep(1);
        if ((++sp & 255u) == 0u) { if (xb_ld(&bar[XB_TMO])) break; if (sp > XB_SPIN_CAP) { atomicAdd(&bar[XB_TMO], 1u); break; } }
    }
    nloc = mine > 0u ? mine : 1u; nx = cnt > 0u ? cnt : 1u;
}

__device__ __forceinline__ void xcd_barrier(const XcdBarrier& b) {
    asm volatile("s_waitcnt vmcnt(0)" ::: "memory");
    __syncthreads();
    if (threadIdx.x == 0) {
        unsigned* bar = b.bar;
        __builtin_amdgcn_s_waitcnt(0);
        unsigned nloc = b.st[0], nx = b.st[1];
        if (nloc == 0u) { xcd_barrier_complete(bar, b.x, nloc, nx); b.st[0] = nloc; b.st[1] = nx; }
        const unsigned old = xb_add(&bar[XB_XSUB(b.x)], 1u);
        const unsigned gen = old / nloc;
        if (old + 1u == (gen + 1u) * nloc) {
            __builtin_amdgcn_fence(__ATOMIC_RELEASE, "agent");
            asm volatile("s_waitcnt vmcnt(0)" ::: "memory");
            const unsigned og = xb_add(&bar[XB_TOP], 1u);
            const unsigned tg = og / nx;
            if (og + 1u == (tg + 1u) * nx) xb_add(&bar[XB_TOPGEN], 1u);
            else XB_SPIN(xb_ld(&bar[XB_TOPGEN]) == tg, bar);
            __builtin_amdgcn_fence(__ATOMIC_ACQUIRE, "agent");
            xb_add(&bar[XB_XGEN(b.x)], 1u);
            asm volatile("s_waitcnt vmcnt(0)" ::: "memory");
        } else {
            XB_SPIN(xb_ld(&bar[XB_XGEN(b.x)]) == gen, bar);
            __builtin_amdgcn_fence(__ATOMIC_ACQUIRE, "agent");
            asm volatile("s_waitcnt vmcnt(0)" ::: "memory");
        }
    }
    __syncthreads();
}

constexpr int NWAVES = 8;
constexpr int NB = 32, SEQ = 2048, D = 1024, NH = 16, T = NB * SEQ;
constexpr int NPROJ = 8192, LDW_IN = 8208, FCOL0 = 6144;
constexpr int NEXP = 32, DE = 512, NLOG = 36, LCAP = 65536;
constexpr float RMS_EPS = 1e-6f, LOG2E = 1.4426950408889634f;
constexpr size_t MiB = 1u << 20;
constexpr size_t WS_CTL = 0, CTL_ZERO_BYTES = 64 * 1024;
constexpr size_t WS_FLOG = 1 * MiB;
constexpr size_t WS_REC = 5 * MiB;
constexpr size_t WS_LIST = 13 * MiB;
constexpr size_t WS_LWT = 21 * MiB;
constexpr size_t WS_WRT = 29 * MiB;
constexpr size_t WS_SLOTOF = 12 * MiB;
constexpr size_t WS_RSTD = 11 * MiB;
constexpr size_t WS_WIN = 32 * MiB;
constexpr size_t WS_WC = 48 * MiB, WS_WA = 50 * MiB, WS_WO = 52 * MiB;
constexpr size_t WS_WE1 = 56 * MiB;
constexpr size_t WS_WE2 = 120 * MiB;
constexpr size_t WS_XN = 160 * MiB;
constexpr size_t WS_B = 288 * MiB;
constexpr size_t WS_Z = 416 * MiB;
constexpr size_t WS_Q = 544 * MiB;
constexpr size_t WS_K = 672 * MiB, WS_V = 800 * MiB;
static_assert(WS_V - WS_K == WS_K - WS_Q, "EpiProj: q, k, v equally spaced");
constexpr size_t WS_RINV = 928 * MiB;
constexpr size_t WS_DUMP = 928 * MiB;
constexpr size_t WS_END = 930 * MiB;
constexpr int CW_BAR = 4096;
constexpr int CW_CNT = 8192;
static_assert((CW_CNT + 64 * NEXP) * 4 <= (int)CTL_ZERO_BYTES, "CTL words inside the memset region");
constexpr int RING_OFF = 0, RING_BYTES = 131072;
constexpr int TAB_OFF = 131072;
constexpr int TAB_CNT = TAB_OFF, TAB_TSTART = TAB_OFF + 128, TAB_RSTART = TAB_OFF + 384, TAB_DESC = TAB_OFF + 640, TAB_IDX = TAB_OFF + 1024, TAB_WT = TAB_IDX + pg8::MOE_SLOTS * 1024, TAB_RS = TAB_WT + pg8::MOE_SLOTS * 1024, TAB_END = TAB_RS + pg8::MOE_SLOTS * 1024;
constexpr int P5_LCNT = 0, P5_LBASE = 128, P5_END = 256;
constexpr int LDS_BYTES = 163840, LDSCTL_OFF = LDS_BYTES - 1024;
static_assert(TAB_END <= LDSCTL_OFF && P5_END <= LDSCTL_OFF && attn_body::ATTN_LDS_BYTES <= LDSCTL_OFF, "LDS map");

typedef unsigned u32x2 __attribute__((ext_vector_type(2)));
typedef int i32x4 __attribute__((ext_vector_type(4)));

__device__ __forceinline__ float wave_sum(float v) {
#pragma unroll
    for (int o = 1; o < 64; o <<= 1) v += __shfl_xor(v, o);
    return v;
}
__device__ __forceinline__ float dpp_row_shr(float v, int n) {
    const int iv = __builtin_bit_cast(int, v); int r;
    switch (n) { case 1: r = __builtin_amdgcn_update_dpp(0, iv, 0x111, 0xf, 0xf, true); break; case 2: r = __builtin_amdgcn_update_dpp(0, iv, 0x112, 0xf, 0xf, true); break;
                 case 4: r = __builtin_amdgcn_update_dpp(0, iv, 0x114, 0xf, 0xf, true); break; default: r = __builtin_amdgcn_update_dpp(0, iv, 0x118, 0xf, 0xf, true); break; }
    return __builtin_bit_cast(float, r);
}
__device__ __forceinline__ float wave_total(float v) {
    v += dpp_row_shr(v, 1); v += dpp_row_shr(v, 2); v += dpp_row_shr(v, 4); v += dpp_row_shr(v, 8);
    v += __builtin_bit_cast(float, __builtin_amdgcn_update_dpp(0, __builtin_bit_cast(int, v), 0x142, 0xa, 0xf, false));
    v += __builtin_bit_cast(float, __builtin_amdgcn_update_dpp(0, __builtin_bit_cast(int, v), 0x143, 0xc, 0xf, false));
    return __builtin_bit_cast(float, __builtin_amdgcn_readlane(__builtin_bit_cast(int, v), 63));
}
__device__ __forceinline__ float dot4(const f32x4 a, const f32x4 b) { return (a.x * b.x + a.y * b.y) + (a.z * b.z + a.w * b.w); }

#ifndef PH_MASK
#define PH_MASK 0x1ff
#endif
#define PH(k) (((PH_MASK) >> (k)) & 1)
#ifndef DBL_MASK
#define DBL_MASK 0
#endif
#define NREP(k) ((((DBL_MASK) >> (k)) & 1) ? 2 : 1)
typedef float f32x2 __attribute__((ext_vector_type(2)));
__device__ __forceinline__ float dpp_quad(float v, const int ctrl_is_b1) {
    const int iv = __builtin_bit_cast(int, v);
    return __builtin_bit_cast(float, ctrl_is_b1 ? __builtin_amdgcn_update_dpp(0, iv, 0x4E, 0xf, 0xf, false) : __builtin_amdgcn_update_dpp(0, iv, 0xB1, 0xf, 0xf, false));
}
__device__ __forceinline__ void reduce4_store(const float (&p)[4], int lane, float* dq, int e) {
    const bool b0 = (lane & 1) != 0, b1 = (lane & 2) != 0;
    float a = b0 ? p[1] : p[0]; const float sa = b0 ? p[0] : p[1]; a += dpp_quad(sa, 0);
    float c = b0 ? p[3] : p[2]; const float sc = b0 ? p[2] : p[3]; c += dpp_quad(sc, 0);
    float t = b1 ? c : a; const float st = b1 ? a : c; t += dpp_quad(st, 1);
    t += dpp_row_shr(t, 4); t += dpp_row_shr(t, 8);
    t += __builtin_bit_cast(float, __builtin_amdgcn_ds_swizzle(__builtin_bit_cast(int, t), 0x401F));
    { auto rr = __builtin_amdgcn_permlane32_swap(__float_as_uint(t), __float_as_uint(t), false, false); t = __uint_as_float(rr[0]) + __uint_as_float(rr[1]); }
    if ((lane & 60) == 12) dq[e] = t;
}
template <int NL> __device__ __forceinline__ void row_logits4(const f32x4 (&v)[4][4], const LAS f32x4* W4, int lane, float* dq) {
    f32x4 wa[4], wb[4];
#pragma unroll
    for (int j = 0; j < 4; ++j) wa[j] = W4[64 * j + lane];
#define RL4_DOT(w_) float p[4]; { f32x2 acc[4]; _Pragma("unroll") for (int r = 0; r < 4; ++r) acc[r] = (f32x2){0.f, 0.f}; \
        _Pragma("unroll") for (int j = 0; j < 4; ++j) { const f32x2 wlo = __builtin_shufflevector(w_[j], w_[j], 0, 1), whi = __builtin_shufflevector(w_[j], w_[j], 2, 3); \
            _Pragma("unroll") for (int r = 0; r < 4; ++r) acc[r] += __builtin_shufflevector(v[r][j], v[r][j], 0, 1) * wlo; \
            _Pragma("unroll") for (int r = 0; r < 4; ++r) acc[r] += __builtin_shufflevector(v[r][j], v[r][j], 2, 3) * whi; } \
        _Pragma("unroll") for (int r = 0; r < 4; ++r) p[r] = acc[r].x + acc[r].y; }
#pragma unroll 1
    for (int e = 0; e < NL; e += 2) {
#pragma unroll
        for (int j = 0; j < 4; ++j) wb[j] = W4[(e + 1) * 256 + 64 * j + lane];
        { RL4_DOT(wa); reduce4_store(p, lane, dq, e); }
        if (e + 2 < NL) {
#pragma unroll
            for (int j = 0; j < 4; ++j) wa[j] = W4[(e + 2) * 256 + 64 * j + lane]; }
        { RL4_DOT(wb); reduce4_store(p, lane, dq, e + 1); }
    }
#undef RL4_DOT
}
struct Args { const float* in[16]; float* out; unsigned char* ws; };

__device__ __forceinline__ void p0_transpose_item(const float* W, int ldw, int k0, int src_n0, bf16* WT, int ldk, int dst_row0, LAS float* scr, int lane) {
#pragma unroll
    for (int i = 0; i < 32; ++i) { const int kk = 2 * i + (lane >> 5); scr[kk * 33 + (lane & 31)] = W[(size_t)(k0 + kk) * ldw + src_n0 + (lane & 31)]; }
    LDS_WAIT(); asm volatile("" ::: "memory");
    const int c = lane & 7;
#pragma unroll
    for (int j = 0; j < 4; ++j) { const int n = (lane >> 3) + 8 * j; const LAS float* s = scr + (8 * c) * 33 + n;
        v4u o; o.x = pk2(s[0 * 33], s[1 * 33]); o.y = pk2(s[2 * 33], s[3 * 33]); o.z = pk2(s[4 * 33], s[5 * 33]); o.w = pk2(s[6 * 33], s[7 * 33]);
        *(GAS v4u*)(WT + (size_t)(dst_row0 + n) * ldk + k0 + 8 * c) = o; }
    LDS_WAIT(); asm volatile("" ::: "memory");
}
__device__ __forceinline__ int proj_src_col(int d) {
    if (d < 2048) { const int pn = d >> 8, y = d & 255, wcc = y >> 6, hb = (y >> 5) & 1, x = y & 31; return (hb ? 2048 : 1024) + 128 * pn + 32 * wcc + x; }
    if (d < 3072) return d - 2048;
    if (d < 6144) return d;
    return d + 16;
}

constexpr int I_IN = 16 * 256, I_SQ = 16 * 32, I_E1 = NEXP * 512, I_E2 = NEXP * 256, NITEMS = I_IN + 3 * I_SQ, NITEMS_E = I_E1 + I_E2;

__global__ void __launch_bounds__(NWAVES * 64, 2) fox_moe_fwd(Args args) {
    extern __shared__ __attribute__((aligned(16))) unsigned char lds[];
    LAS unsigned char* const L = (LAS unsigned char*)lds;
    const int tid0 = threadIdx.x, wave = __builtin_amdgcn_readfirstlane(tid0 >> 6);
#define PHASE_IDS() int tid_ = threadIdx.x; asm volatile("" : "+v"(tid_)); const int tid = tid_, lane = tid & 63; (void)lane
    const int G = gridDim.x, bx = blockIdx.x;
    const int vcu = (G % 8 == 0) ? (bx % 8) * (G / 8) + bx / 8 : bx;
    const int gw = vcu * NWAVES + wave, NGW = G * NWAVES;
    typedef __attribute__((address_space(4))) const unsigned char* kargp_t;
    kargp_t kp = (kargp_t)__builtin_amdgcn_kernarg_segment_ptr();
#define KP_PHASE() asm volatile("" : "+s"(kp))
#ifndef P1_WGM
#define P1_WGM 4
#endif
#ifndef P3_WGM
#define P3_WGM 8
#endif
#ifndef STG_P1
#define STG_P1 0
#endif
#ifndef STG_P3
#define STG_P3 0
#endif
#ifndef STG_P4
#define STG_P4 0
#endif
#define XCD_STAGGER(ticks) do { if ((ticks) > 0) { const unsigned long long t0_ = __builtin_amdgcn_s_memrealtime(); const unsigned long long dl_ = (unsigned long long)(((blockIdx.x >> 3) & 7) * (ticks)); while (__builtin_amdgcn_s_memrealtime() - t0_ < dl_) __builtin_amdgcn_s_sleep(8); } } while (0)
#define LOCAL_SEAM() do { VM_WAIT(); __syncthreads(); if (threadIdx.x == 0) { __builtin_amdgcn_fence(__ATOMIC_ACQUIRE, "agent"); VM_WAIT(); } __syncthreads(); } while (0)
#define KIN(i) (*(const float* const __attribute__((address_space(4)))*)(kp + 8 * (i)))
#define KOUT() (*(float* const __attribute__((address_space(4)))*)(kp + 128))
#define KWS() (*(unsigned char* const __attribute__((address_space(4)))*)(kp + 136))
#define WSP(T_, off) ((T_*)(ws + (off)))
    gu32* const ctl = (gu32*)(KWS() + WS_CTL);
    for (int u = tid0; u < (LDS_BYTES - LDSCTL_OFF) / 4; u += NWAVES * 64) ((LAS unsigned*)(L + LDSCTL_OFF))[u] = 0u;
    __syncthreads();
    XcdBarrier bar = xcd_barrier_post((unsigned*)(ctl + CW_BAR), (volatile LAS unsigned*)(L + LDSCTL_OFF) + 8);

    if constexpr (PH(0)) _Pragma("unroll") for (int rep_ = 0; rep_ < NREP(0); ++rep_) {
        KP_PHASE(); PHASE_IDS(); unsigned char* const ws = KWS();
        const float* const x = KIN(0); const float* const g_mix = KIN(1); const float* const w_in = KIN(2); const float* const w_conv_out = KIN(6); const float* const w_att_out = KIN(7); const float* const w_out = KIN(8);
        const float* const g_ffn = KIN(9); const float* const w_rg = KIN(10); const float* const w_re = KIN(11); const float* const w_eg = KIN(12); const float* const w_eu = KIN(13); const float* const w_ed = KIN(14);
        bf16* const WIN = WSP(bf16, WS_WIN); bf16* const WC = WSP(bf16, WS_WC); bf16* const WA = WSP(bf16, WS_WA); bf16* const WO = WSP(bf16, WS_WO); bf16* const WE1 = WSP(bf16, WS_WE1); bf16* const WE2 = WSP(bf16, WS_WE2);
        bf16* const WRH = WSP(bf16, WS_WRT); bf16* const WRL = WRH + 48 * D; bf16* const XN = WSP(bf16, WS_XN); float* const FLOG = WSP(float, WS_FLOG); float* const RINV = WSP(float, WS_RINV);
        static_assert(T % (NWAVES * 256 * 4) == 0 && (NITEMS + NWAVES * 256 - 1) / (NWAVES * 256) <= 2 * (T / (NWAVES * 256 * 4)), "four rows and up to two weight items per wave and trip");
#define P0_DESC(it_, S_, D_, LW_, LK_, GS_) do { int r_ = (it_); GS_ = nullptr; \
            if (r_ < I_IN) { const int kb = r_ >> 8, d0 = (r_ & 255) * 32; S_ = w_in + (size_t)(64 * kb) * LDW_IN + proj_src_col(d0); D_ = WIN + (size_t)d0 * D + 64 * kb; LW_ = LDW_IN; LK_ = D; } \
            else if ((r_ -= I_IN) < 3 * I_SQ) { const int w = r_ / I_SQ, rr = r_ % I_SQ, kb = rr >> 5, d0 = (rr & 31) * 32; S_ = (w == 0 ? w_conv_out : w == 1 ? w_att_out : w_out) + (size_t)(64 * kb) * D + d0; D_ = (w == 0 ? WC : w == 1 ? WA : WO) + (size_t)d0 * D + 64 * kb; LW_ = D; LK_ = D; } \
            else if ((r_ -= 3 * I_SQ) < I_E1) { const int e = r_ >> 9, rr = r_ & 511, kb = rr >> 5, d0 = (rr & 31) * 32, pn = d0 >> 8, xx = d0 & 255; \
                S_ = (xx < 128 ? w_eg : w_eu) + (size_t)e * D * DE + (size_t)(64 * kb) * DE + 128 * pn + (xx & 127); D_ = WE1 + (size_t)e * 1024 * D + (size_t)d0 * D + 64 * kb; LW_ = DE; LK_ = D; GS_ = g_ffn + 64 * kb; } \
            else { r_ -= I_E1; const int e = r_ >> 8, rr = r_ & 255, kb = rr >> 5, d0 = (rr & 31) * 32; S_ = w_ed + (size_t)e * DE * D + (size_t)(64 * kb) * D + d0; D_ = WE2 + (size_t)e * 1024 * DE + (size_t)d0 * DE + 64 * kb; LW_ = D; LK_ = DE; } } while (0)
#define P0_ITEM_LOAD(v_, S_, LW_, GS_) do { _Pragma("unroll") for (int i_ = 0; i_ < 32; ++i_) v_[i_] = S_[(size_t)(2 * i_ + (lane >> 5)) * LW_ + (lane & 31)]; \
            if (GS_) { _Pragma("unroll") for (int i_ = 0; i_ < 32; ++i_) v_[i_] *= GS_[2 * i_ + (lane >> 5)]; } } while (0)
#define P0_ITEM_FINISH(v_, D_, LK_, scr_) do { _Pragma("unroll") for (int i_ = 0; i_ < 32; ++i_) scr_[(2 * i_ + (lane >> 5)) * 33 + (lane & 31)] = v_[i_]; \
            LDS_WAIT(); asm volatile("" ::: "memory"); const int c_ = lane & 7; \
            _Pragma("unroll") for (int j_ = 0; j_ < 4; ++j_) { const int n_ = (lane >> 3) + 8 * j_; const LAS float* s_ = scr_ + (8 * c_) * 33 + n_; \
                v4u o_; o_.x = pk2(s_[0 * 33], s_[1 * 33]); o_.y = pk2(s_[2 * 33], s_[3 * 33]); o_.z = pk2(s_[4 * 33], s_[5 * 33]); o_.w = pk2(s_[6 * 33], s_[7 * 33]); \
                *(GAS v4u*)(D_ + (size_t)n_ * LK_ + 8 * c_) = o_; } \
            LDS_WAIT(); asm volatile("" ::: "memory"); } while (0)
        for (int i = bx * (NWAVES * 64) + tid; i < 48 * D; i += G * NWAVES * 64) { const int e = i >> 10, k = i & 1023;
            const float w = (e < 4 ? w_rg[k * 4 + e] : e < NLOG ? w_re[(size_t)((e - 4) >> 3) * D * 8 + k * 8 + ((e - 4) & 7)] : 0.f) * g_ffn[k]; const unsigned hi = f2bf(w); WRH[i] = (bf16)hi; WRL[i] = (bf16)f2bf(w - __uint_as_float(hi << 16)); }
        LAS float* wfT = (LAS float*)(L + RING_OFF);
        LAS float* scrA = (LAS float*)(L + RING_OFF + 65536 + wave * 8448); LAS float* scrB = scrA;
        static_assert(65536 + NWAVES * 8448 <= LDSCTL_OFF, "P0 LDS map");
#pragma unroll
        for (int i = 0; i < 2; ++i) { const int k = tid + 512 * i; const GAS f32x4* src = (const GAS f32x4*)(w_in + (size_t)k * LDW_IN + FCOL0);
#pragma unroll
            for (int q = 0; q < 4; ++q) { const f32x4 v = src[q]; wfT[(4 * q + 0) * 1024 + k] = v.x; wfT[(4 * q + 1) * 1024 + k] = v.y; wfT[(4 * q + 2) * 1024 + k] = v.z; wfT[(4 * q + 3) * 1024 + k] = v.w; } }
        __syncthreads();
        f32x4 gv[4];
#pragma unroll
        for (int j = 0; j < 4; ++j) gv[j] = ((const GAS f32x4*)g_mix)[lane + 64 * j];
        f32x4 nx[4][4];
#define P0_LOAD(i_) do { _Pragma("unroll") for (int r = 0; r < 4; ++r) { const GAS f32x4* xr_ = (const GAS f32x4*)(x + (size_t)(gw + ((i_) + r) * NGW) * D) + lane; _Pragma("unroll") for (int j = 0; j < 4; ++j) nx[r][j] = xr_[64 * j]; } } while (0)
        const int nrow = T / NGW;
        for (int i = 0; i + 4 <= nrow; i += 4) {
            P0_LOAD(i);
            const int itA = gw + (i >> 1) * NGW, itB = itA + NGW; const bool hasA = itA < NITEMS, hasB = itB < NITEMS;
            const float* sA = nullptr; const float* sB = nullptr; bf16* dA = nullptr; bf16* dB = nullptr; const float* gA = nullptr; const float* gB = nullptr; int lwA = 0, lwB = 0, lkA = 0, lkB = 0; float ia[32], ib[32];
            if (hasA) { P0_DESC(itA, sA, dA, lwA, lkA, gA); P0_ITEM_LOAD(ia, sA, lwA, gA); }
            if (hasB) { P0_DESC(itB, sB, dB, lwB, lkB, gB); P0_ITEM_LOAD(ib, sB, lwB, gB); }
            f32x4 (&v)[4][4] = nx;
            float s2[4];
#pragma unroll
            for (int r = 0; r < 4; ++r) s2[r] = (dot4(v[r][0], v[r][0]) + dot4(v[r][1], v[r][1])) + (dot4(v[r][2], v[r][2]) + dot4(v[r][3], v[r][3]));
#pragma unroll
            for (int r = 0; r < 4; ++r) { const float rinv_ = sqrtf(wave_total(s2[r]) * (1.f / D) + RMS_EPS), rstd = 1.0f / rinv_; const int m = gw + (i + r) * NGW; if (lane == 0) RINV[m] = rinv_;
                GAS unsigned long long* o8 = (GAS unsigned long long*)(XN + (size_t)m * D) + lane;
#pragma unroll
                for (int j = 0; j < 4; ++j) { v[r][j] = (v[r][j] * rstd) * gv[j]; o8[64 * j] = (unsigned long long)pk2(v[r][j].x, v[r][j].y) | ((unsigned long long)pk2(v[r][j].z, v[r][j].w) << 32); } }
            row_logits4<16>(v, (const LAS f32x4*)wfT, lane, FLOG + (size_t)(gw + (i + (lane & 3)) * NGW) * 16);
            if (hasA) P0_ITEM_FINISH(ia, dA, lkA, scrA);
            if (hasB) P0_ITEM_FINISH(ib, dB, lkB, scrB);
        }
    }
    xcd_barrier(bar);

    if constexpr (PH(1)) _Pragma("unroll") for (int rep_ = 0; rep_ < NREP(1); ++rep_) {
        KP_PHASE(); PHASE_IDS(); unsigned char* const ws = KWS(); const float* const b_forget = KIN(5); float* const out = KOUT();
        float* const FLOG = WSP(float, WS_FLOG); u32x2* const REC = WSP(u32x2, WS_REC); bf16* const XN = WSP(bf16, WS_XN); bf16* const WIN = WSP(bf16, WS_WIN);
        bf16* const ZB = WSP(bf16, WS_Z); bf16* const BB = WSP(bf16, WS_B); bf16* const QO = WSP(bf16, WS_Q); bf16* const KB = WSP(bf16, WS_K); bf16* const VB = WSP(bf16, WS_V);
        bf16* const SGC = (bf16*)out; bf16* const SGA = (bf16*)((unsigned char*)out + (size_t)T * D);
        LAS float* red = (LAS float*)(L + RING_OFF);
        for (int bh = bx; bh < NB * NH; bh += G) {
            const int b = bh >> 4, h = bh & 15; const float bf = b_forget[h];
            float c[4];
#pragma unroll
            for (int i = 0; i < 4; ++i) { const float xv = FLOG[((size_t)b * SEQ + 4 * tid + i) * 16 + h] + bf; const float ls = fminf(xv, 0.f) - log1pf(expf(-fabsf(xv))); c[i] = ls * LOG2E; }
            c[1] += c[0]; c[2] += c[1]; c[3] += c[2];
            const float tot = c[3]; float sc = tot;
#pragma unroll
            for (int o = 1; o < 64; o <<= 1) { const float tv = __shfl_up(sc, o); if (lane >= o) sc += tv; }
            if (lane == 63) red[wave] = sc;
            __syncthreads();
            float off = 0.f;
            for (int w = 0; w < wave; ++w) off += red[w];
            const float excl = off + (sc - tot);
            unsigned rw[8];
#pragma unroll
            for (int i = 0; i < 4; ++i) { const float bias = -(excl + c[i]);
                const unsigned h1 = f2bf(bias); const float r1 = bias - __uint_as_float(h1 << 16); const unsigned h2 = f2bf(r1); const float r2 = r1 - __uint_as_float(h2 << 16); const unsigned h3 = f2bf(r2);
                rw[2 * i] = h1 | (h2 << 16); rw[2 * i + 1] = h3 | (0x3f80u << 16); }
            GAS v4u* dst = (GAS v4u*)(REC + (size_t)bh * SEQ + 4 * tid);
            dst[0] = (v4u){rw[0], rw[1], rw[2], rw[3]}; dst[1] = (v4u){rw[4], rw[5], rw[6], rw[7]};
            __syncthreads();
        }
                pg8::StaticOrder S; S.init(XN, WIN, T, NPROJ, D, G, bx, P1_WGM);
        pg8::EpiProj E{ZB, BB, QO, KB, VB, SGC, SGA, attn_body::C2, L + TAB_OFF + wave * 4096};
        XCD_STAGGER(STG_P1);
        pg8::gemm_phase<pg8::EpiProj, pg8::StaticOrder, true, false>(L + RING_OFF, D, S, E, ws + WS_DUMP);
#ifdef HOT_UNITS
        { VM_WAIT(); __syncthreads(); const pg8::HotOrder HS{XN, WIN, D, HOT_UNITS, bx, HOT_PN};
#if HOT_STORE
          bf16* const dmp = WSP(bf16, WS_LIST); pg8::EpiProj HE{dmp, dmp, dmp, dmp, dmp, dmp, dmp, 1.0f, L + TAB_OFF + wave * 4096}; pg8::gemm_phase<pg8::EpiProj, pg8::HotOrder, true, false>(L + RING_OFF, D, HS, HE);
#else
          pg8::EpiNull HE{WSP(float, WS_LIST)}; pg8::gemm_phase<pg8::EpiNull, pg8::HotOrder, true, false>(L + RING_OFF, D, HS, HE);
#endif
        }
#endif
    }
    xcd_barrier(bar);

    if constexpr (PH(2)) _Pragma("unroll") for (int rep_ = 0; rep_ < NREP(2); ++rep_) {
        KP_PHASE(); PHASE_IDS(); unsigned char* const ws = KWS(); const float* const conv_w = KIN(3); const float* const conv_b = KIN(4);
        bf16* const ZB = WSP(bf16, WS_Z); bf16* const BB = WSP(bf16, WS_B); bf16* const QO = WSP(bf16, WS_Q); bf16* const KB = WSP(bf16, WS_K); bf16* const VB = WSP(bf16, WS_V); u32x2* const REC = WSP(u32x2, WS_REC);
        const bool dummy_ = (rep_ + 1 < NREP(2)); bf16* const CO = dummy_ ? WSP(bf16, WS_XN) : BB; bf16* const AO = dummy_ ? WSP(bf16, WS_XN) : QO;
        const attn_body::AttnTensors AT{(const attn_body::bf16*)QO, (const attn_body::bf16*)KB, (const attn_body::bf16*)VB, (attn_body::bf16*)AO, (const attn_body::u32x2_t*)REC};
        const attn_body::StaticOrder S(G, bx);
        if (G == NB * SEQ / 256 && !dummy_) {
            for (int u = tid; u < 1024; u += NWAVES * 64) ((LAS f32x4*)(L + RING_OFF + attn_body::LDS_CW))[u] = u < 768 ? ((const GAS f32x4*)conv_w)[u] : ((const GAS f32x4*)conv_b)[u - 768];
            if (tid < 256) { const int rr = tid >> 7, c = tid & 127; v4u v = (v4u){0u, 0u, 0u, 0u};
                if ((bx & (SEQ / 256 - 1)) != 0) v = *(const GAS v4u*)(ZB + ((size_t)256 * bx - 2 + rr) * D + 8 * c);
                *(LAS v4u*)(L + RING_OFF + attn_body::LDS_ZR + (16 + rr) * 2048 + c * 16) = v; }
            __syncthreads();
            const attn_body::ConvSide CS{(const attn_body::bf16*)ZB, (attn_body::bf16*)BB, 256 * bx};
            attn_body::attn_phase<attn_body::StaticOrder, 40, true>((char*)lds + RING_OFF, AT, S, CS);
        } else {
        const int cg = tid & 127;
        float w0[8], w1[8], w2[8], cb[8];
#pragma unroll
        for (int j = 0; j < 8; ++j) { w0[j] = conv_w[8 * cg + j]; w1[j] = conv_w[D + 8 * cg + j]; w2[j] = conv_w[2 * D + 8 * cg + j]; cb[j] = conv_b[8 * cg + j]; }
        for (int task = bx * (NWAVES * 64) + tid; task < (T / 32) * 128; task += G * NWAVES * 64) {
            const int t0 = (task >> 7) * 32;
            float z1[8], z2[8];
            if ((t0 & (SEQ - 1)) == 0) {
#pragma unroll
                for (int j = 0; j < 8; ++j) { z1[j] = 0.f; z2[j] = 0.f; }
            } else {
                const v4u a = *(const GAS v4u*)(ZB + (size_t)(t0 - 2) * D + 8 * cg), bq = *(const GAS v4u*)(ZB + (size_t)(t0 - 1) * D + 8 * cg);
                z2[0] = pg8::bf_lo(a.x); z2[1] = pg8::bf_hi(a.x); z2[2] = pg8::bf_lo(a.y); z2[3] = pg8::bf_hi(a.y); z2[4] = pg8::bf_lo(a.z); z2[5] = pg8::bf_hi(a.z); z2[6] = pg8::bf_lo(a.w); z2[7] = pg8::bf_hi(a.w);
                z1[0] = pg8::bf_lo(bq.x); z1[1] = pg8::bf_hi(bq.x); z1[2] = pg8::bf_lo(bq.y); z1[3] = pg8::bf_hi(bq.y); z1[4] = pg8::bf_lo(bq.z); z1[5] = pg8::bf_hi(bq.z); z1[6] = pg8::bf_lo(bq.w); z1[7] = pg8::bf_hi(bq.w);
            }
#pragma unroll 4
            for (int r = 0; r < 32; ++r) {
                const size_t off = (size_t)(t0 + r) * D + 8 * cg;
                const v4u zc = *(const GAS v4u*)(ZB + off), bv = *(const GAS v4u*)(BB + off);
                float z0[8], bb[8], y[8];
                z0[0] = pg8::bf_lo(zc.x); z0[1] = pg8::bf_hi(zc.x); z0[2] = pg8::bf_lo(zc.y); z0[3] = pg8::bf_hi(zc.y); z0[4] = pg8::bf_lo(zc.z); z0[5] = pg8::bf_hi(zc.z); z0[6] = pg8::bf_lo(zc.w); z0[7] = pg8::bf_hi(zc.w);
                bb[0] = pg8::bf_lo(bv.x); bb[1] = pg8::bf_hi(bv.x); bb[2] = pg8::bf_lo(bv.y); bb[3] = pg8::bf_hi(bv.y); bb[4] = pg8::bf_lo(bv.z); bb[5] = pg8::bf_hi(bv.z); bb[6] = pg8::bf_lo(bv.w); bb[7] = pg8::bf_hi(bv.w);
#pragma unroll
                for (int j = 0; j < 8; ++j) { y[j] = bb[j] * (cb[j] + w0[j] * z2[j] + w1[j] * z1[j] + w2[j] * z0[j]); z2[j] = z1[j]; z1[j] = z0[j]; }
                *(GAS v4u*)(CO + off) = (v4u){pk2(y[0], y[1]), pk2(y[2], y[3]), pk2(y[4], y[5]), pk2(y[6], y[7])};
            }
        }
        VM_WAIT(); __syncthreads();
        attn_body::attn_phase<attn_body::StaticOrder, 40, false>((char*)lds + RING_OFF, AT, S);
        }
    }
    xcd_barrier(bar);

    if constexpr (PH(3)) _Pragma("unroll") for (int rep_ = 0; rep_ < NREP(3); ++rep_) {
        KP_PHASE(); PHASE_IDS(); unsigned char* const ws = KWS(); float* const out = KOUT();
        bf16* const BB = WSP(bf16, WS_B); bf16* const QO = WSP(bf16, WS_Q); bf16* const MB = WSP(bf16, WS_Z); bf16* const WC = WSP(bf16, WS_WC); bf16* const WA = WSP(bf16, WS_WA);
        const unsigned char* const SGC = (const unsigned char*)out; const unsigned char* const SGA = (const unsigned char*)out + (size_t)T * D;
        XCD_STAGGER(STG_P3);
        { pg8::DualSrcOrder S; S.init2(BB, WC, QO, WA, T, D, D, G, bx, P3_WGM); pg8::EpiGateFused E{SGC, SGA, MB, L + TAB_OFF + wave * 4096};
          pg8::gemm_phase<pg8::EpiGateFused, pg8::DualSrcOrder, true, false, true>(L + RING_OFF, D, S, E, ws + WS_DUMP); }
    }
    xcd_barrier(bar);

    if constexpr (PH(4)) _Pragma("unroll") for (int rep_ = 0; rep_ < NREP(4); ++rep_) {
        KP_PHASE(); PHASE_IDS(); unsigned char* const ws = KWS(); float* const out = KOUT(); const float* const x = KIN(0); const float* const g_mix = KIN(1); bf16* const MB = WSP(bf16, WS_Z); bf16* const WO = WSP(bf16, WS_WO); bf16* const XM = WSP(bf16, WS_K); (void)out;
        pg8::StaticOrder S; S.init(MB, WO, T, D, D, G, bx);
        bool gok = true;
#pragma unroll
        for (int j = 0; j < 4; ++j) { const f32x4 gq = ((const GAS f32x4*)g_mix)[lane + 64 * j];
#pragma unroll
            for (int c = 0; c < 4; ++c) { const float a = fabsf(gq[c]); gok = gok && (a >= 1e-18f) && (a <= 1e18f); } }
        const bool use_xn = __builtin_amdgcn_ballot_w64(!gok) == 0ull;
        if (use_xn) { pg8::EpiResXN E{WSP(bf16, WS_XN), WSP(float, WS_RINV), g_mix, XM, L + TAB_OFF + wave * 4096}; pg8::gemm_phase<pg8::EpiResXN, pg8::StaticOrder, true, false>(L + RING_OFF, D, S, E, ws + WS_DUMP); }
        else { pg8::EpiRes E{x, XM, L + TAB_OFF + wave * 4096}; pg8::gemm_phase<pg8::EpiRes, pg8::StaticOrder, true, false>(L + RING_OFF, D, S, E, ws + WS_DUMP); }
    }
    xcd_barrier(bar);

    if constexpr (PH(5)) _Pragma("unroll") for (int rep_ = 0; rep_ < NREP(5); ++rep_) {
        KP_PHASE(); PHASE_IDS(); unsigned char* const ws = KWS();
        const bf16* const WRH = WSP(bf16, WS_WRT); const bf16* const WRL = WRH + 48 * D; const bf16* const XM = WSP(bf16, WS_K); float* const LOGITS = WSP(float, WS_FLOG); float* const RSTD = WSP(float, WS_RSTD); unsigned* const LIST = WSP(unsigned, WS_LIST); float* const LWT = WSP(float, WS_LWT);
        LAS int* lcnt = (LAS int*)(L + P5_LCNT); LAS int* lbase = (LAS int*)(L + P5_LBASE);
        if (tid < 32) lcnt[tid] = 0;
        __syncthreads();
        if (wave >= 4 && rep_ + 1 == NREP(5)) {
            const float* const w_in = KIN(2); const float* const w_conv_out = KIN(6); const float* const w_att_out = KIN(7); const float* const w_out = KIN(8);
            const float* const g_ffn = KIN(9); const float* const w_eg = KIN(12); const float* const w_eu = KIN(13); const float* const w_ed = KIN(14);
            bf16* const WIN = WSP(bf16, WS_WIN); bf16* const WC = WSP(bf16, WS_WC); bf16* const WA = WSP(bf16, WS_WA); bf16* const WO = WSP(bf16, WS_WO); bf16* const WE1 = WSP(bf16, WS_WE1); bf16* const WE2 = WSP(bf16, WS_WE2);
            LAS float* scr = (LAS float*)(L + RING_OFF + 65536 + wave * 8448);
            const int iw = vcu * 4 + (wave - 4), NIW = G * 4;
            for (int r = iw; r < NITEMS_E; r += 4 * NIW) {
                const int it0 = NITEMS + r; const bool h1 = r + NIW < NITEMS_E, h2 = r + 2 * NIW < NITEMS_E, h3 = r + 3 * NIW < NITEMS_E;
                const float *sq0 = nullptr, *sq1 = nullptr, *sq2 = nullptr, *sq3 = nullptr, *gq0 = nullptr, *gq1 = nullptr, *gq2 = nullptr, *gq3 = nullptr; bf16 *dq0 = nullptr, *dq1 = nullptr, *dq2 = nullptr, *dq3 = nullptr;
                int lw0 = 0, lw1 = 0, lw2 = 0, lw3 = 0, lk0 = 0, lk1 = 0, lk2 = 0, lk3 = 0; float iq0[32], iq1[32], iq2[32], iq3[32];
                P0_DESC(it0, sq0, dq0, lw0, lk0, gq0); P0_ITEM_LOAD(iq0, sq0, lw0, gq0);
                if (h1) { P0_DESC(it0 + NIW, sq1, dq1, lw1, lk1, gq1); P0_ITEM_LOAD(iq1, sq1, lw1, gq1); }
                if (h2) { P0_DESC(it0 + 2 * NIW, sq2, dq2, lw2, lk2, gq2); P0_ITEM_LOAD(iq2, sq2, lw2, gq2); }
                if (h3) { P0_DESC(it0 + 3 * NIW, sq3, dq3, lw3, lk3, gq3); P0_ITEM_LOAD(iq3, sq3, lw3, gq3); }
                P0_ITEM_FINISH(iq0, dq0, lk0, scr);
                if (h1) P0_ITEM_FINISH(iq1, dq1, lk1, scr);
                if (h2) P0_ITEM_FINISH(iq2, dq2, lk2, scr);
                if (h3) P0_ITEM_FINISH(iq3, dq3, lk3, scr);
            }
        }
        for (int rb = bx; rb < T / 256; rb += G) {
          if (wave < 4)
#pragma unroll 1
          for (int pass = 0; pass < 2; ++pass) {
            const int mbase = rb * 256 + wave * 64 + pass * 32, fr = lane & 15, fq = lane >> 4;
            const GAS bf16x8* ap0 = (const GAS bf16x8*)(XM + (size_t)(mbase + fr) * D + 8 * fq); const GAS bf16x8* ap1 = (const GAS bf16x8*)(XM + (size_t)(mbase + 16 + fr) * D + 8 * fq);
            const GAS bf16x8* bh = (const GAS bf16x8*)(WRH + (size_t)fr * D + 8 * fq); const GAS bf16x8* bl = (const GAS bf16x8*)(WRL + (size_t)fr * D + 8 * fq);
            f32x4 acc[2][3]; float ss0 = 0.f, ss1 = 0.f;
#pragma unroll
            for (int mt = 0; mt < 2; ++mt)
#pragma unroll
                for (int nt = 0; nt < 3; ++nt) acc[mt][nt] = (f32x4){0.f, 0.f, 0.f, 0.f};
#pragma unroll 4
            for (int s = 0; s < D / 32; ++s) {
                const bf16x8 a0 = ap0[4 * s], a1 = ap1[4 * s];
                bf16x8 wh[3], wl[3];
#pragma unroll
                for (int nt = 0; nt < 3; ++nt) { wh[nt] = bh[4 * s + nt * 2048]; wl[nt] = bl[4 * s + nt * 2048]; }
#pragma unroll
                for (int nt = 0; nt < 3; ++nt) { acc[0][nt] = __builtin_amdgcn_mfma_f32_16x16x32_bf16(a0, wh[nt], acc[0][nt], 0, 0, 0); acc[1][nt] = __builtin_amdgcn_mfma_f32_16x16x32_bf16(a1, wh[nt], acc[1][nt], 0, 0, 0);
                    acc[0][nt] = __builtin_amdgcn_mfma_f32_16x16x32_bf16(a0, wl[nt], acc[0][nt], 0, 0, 0); acc[1][nt] = __builtin_amdgcn_mfma_f32_16x16x32_bf16(a1, wl[nt], acc[1][nt], 0, 0, 0); }
#pragma unroll
                for (int j = 0; j < 8; ++j) { const float x0 = __uint_as_float((unsigned)(unsigned short)a0[j] << 16), x1 = __uint_as_float((unsigned)(unsigned short)a1[j] << 16); ss0 += x0 * x0; ss1 += x1 * x1; }
            }
            ss0 += __builtin_bit_cast(float, __builtin_amdgcn_ds_swizzle(__builtin_bit_cast(int, ss0), 0x401F)); ss1 += __builtin_bit_cast(float, __builtin_amdgcn_ds_swizzle(__builtin_bit_cast(int, ss1), 0x401F));
            { auto r0 = __builtin_amdgcn_permlane32_swap(__float_as_uint(ss0), __float_as_uint(ss0), false, false); ss0 = __uint_as_float(r0[0]) + __uint_as_float(r0[1]);
              auto r1 = __builtin_amdgcn_permlane32_swap(__float_as_uint(ss1), __float_as_uint(ss1), false, false); ss1 = __uint_as_float(r1[0]) + __uint_as_float(r1[1]); }
            if (fq == 0) { RSTD[mbase + fr] = 1.0f / sqrtf(ss0 * (1.f / D) + RMS_EPS); RSTD[mbase + 16 + fr] = 1.0f / sqrtf(ss1 * (1.f / D) + RMS_EPS); }
#pragma unroll
            for (int mt = 0; mt < 2; ++mt)
#pragma unroll
                for (int nt = 0; nt < 3; ++nt) { const int col = 16 * nt + fr;
                    if (col < NLOG) {
#pragma unroll
                        for (int i = 0; i < 4; ++i) LOGITS[(size_t)(mbase + 16 * mt + 4 * fq + i) * NLOG + col] = acc[mt][nt][i]; } }
          }
            VM_WAIT();
            __syncthreads();
            if (rep_ + 1 < NREP(5)) continue;
            i32x4 rt = (i32x4){0, 0, 0, 0}; int rk1 = 0, rk2 = 0;
            if (tid < 256) {
                const GAS f32x4* lp = (const GAS f32x4*)(LOGITS + (size_t)(rb * 256 + tid) * NLOG); float lg[NLOG];
                const float rs = RSTD[rb * 256 + tid];
#pragma unroll
                for (int q = 0; q < NLOG / 4; ++q) { const f32x4 t4 = lp[q] * rs; lg[4 * q] = t4.x; lg[4 * q + 1] = t4.y; lg[4 * q + 2] = t4.z; lg[4 * q + 3] = t4.w; }
                int g = 0; float mg = lg[0];
#pragma unroll
                for (int i = 1; i < 4; ++i) if (lg[i] > mg) { mg = lg[i]; g = i; }
                float sg = 0.f;
#pragma unroll
                for (int i = 0; i < 4; ++i) sg += expf(lg[i] - mg);
                const float gval = 1.0f / sg;
                float le[8];
#pragma unroll
                for (int j = 0; j < 8; ++j) le[j] = g == 0 ? lg[4 + j] : g == 1 ? lg[12 + j] : g == 2 ? lg[20 + j] : lg[28 + j];
                int i1 = 0; float m1 = le[0];
#pragma unroll
                for (int j = 1; j < 8; ++j) if (le[j] > m1) { m1 = le[j]; i1 = j; }
                int i2 = 0; float m2 = -INFINITY;
#pragma unroll
                for (int j = 0; j < 8; ++j) if (j != i1 && le[j] > m2) { m2 = le[j]; i2 = j; }
                const float e2 = expf(m2 - m1), v1 = 1.0f / (1.0f + e2), v2 = e2 / (1.0f + e2);
                rt = (i32x4){8 * g + i1, 8 * g + i2, (int)__float_as_uint(gval * v1), (int)__float_as_uint(gval * v2)}; }
            if (tid < 256) { rk1 = __hip_atomic_fetch_add(lcnt + rt.x, 1, __ATOMIC_RELAXED, __HIP_MEMORY_SCOPE_WORKGROUP); rk2 = __hip_atomic_fetch_add(lcnt + rt.y, 1, __ATOMIC_RELAXED, __HIP_MEMORY_SCOPE_WORKGROUP); }
            __syncthreads();
            if (tid < 32) lbase[tid] = (int)__hip_atomic_fetch_add(ctl + CW_CNT + 64 * tid, (unsigned)lcnt[tid], RLX_AGENT);
            __syncthreads();
            if (tid < 256) { const unsigned tok = (unsigned)(rb * 256 + tid);
                const size_t p1 = (size_t)rt.x * LCAP + (size_t)(lbase[rt.x] + rk1), p2 = (size_t)rt.y * LCAP + (size_t)(lbase[rt.y] + rk2);
                LIST[p1] = 2u * tok; LWT[p1] = __uint_as_float((unsigned)rt.z); LIST[p2] = 2u * tok + 1u; LWT[p2] = __uint_as_float((unsigned)rt.w); }
            __syncthreads();
            if (tid < 32) lcnt[tid] = 0;
            __syncthreads();
        }
    }
    xcd_barrier(bar);

    LAS int* tcnt = (LAS int*)(L + TAB_CNT); LAS int* tstart = (LAS int*)(L + TAB_TSTART); LAS int* rstart = (LAS int*)(L + TAB_RSTART);
    LAS i32x4* desc = (LAS i32x4*)(L + TAB_DESC); LAS unsigned* tidx = (LAS unsigned*)(L + TAB_IDX); LAS float* twt = (LAS float*)(L + TAB_WT); LAS float* trs = (LAS float*)(L + TAB_RS);
    if constexpr (PH(6)) {
        KP_PHASE(); PHASE_IDS(); unsigned char* const ws = KWS(); unsigned* const LIST = WSP(unsigned, WS_LIST); float* const LWT = WSP(float, WS_LWT); const float* const RSTD = WSP(float, WS_RSTD); unsigned* const SLOTOF = WSP(unsigned, WS_SLOTOF);
        if (tid < 32) tcnt[tid] = (int)__hip_atomic_load(ctl + CW_CNT + 64 * tid, RLX_AGENT);
        __syncthreads();
        if (tid == 0) { int ts = 0, rs = 0; for (int e = 0; e < NEXP; ++e) { tstart[e] = ts; rstart[e] = rs; ts += (tcnt[e] + 255) >> 8; rs += tcnt[e]; } tstart[NEXP] = ts; rstart[NEXP] = rs; }
        __syncthreads();
        if (tid < pg8::MOE_SLOTS) {
            const int nU = 4 * tstart[NEXP], chunk = (nU + 7) >> 3, per = (G + 7) / 8, s = tid * per + (bx >> 3), U = (bx & 7) * chunk + s;
            i32x4 d = (i32x4){0, 0, 0, 0};
            if (s < chunk && U < nU) { const int rowtile = U >> 2; int e = 0; while (e < NEXP - 1 && tstart[e + 1] <= rowtile) ++e; const int rt = rowtile - tstart[e]; int nv = tcnt[e] - 256 * rt; nv = nv > 256 ? 256 : nv; d = (i32x4){e, rt, U & 3, nv}; }
            desc[tid] = d;
        }
        __syncthreads();
        { static_assert(pg8::MOE_SLOTS * 256 % (NWAVES * 64) == 0, "table fill");
            constexpr int NE = pg8::MOE_SLOTS * 256 / (NWAVES * 64); unsigned ent[NE]; float w[NE], rs[NE];
#pragma unroll
            for (int k = 0; k < NE; ++k) { const int e = tid + k * (NWAVES * 64), slot = e >> 8, r = e & 255; const i32x4 d = desc[slot]; ent[k] = 0u; w[k] = 0.f;
                if (r < d.w) { const size_t p = (size_t)d.x * LCAP + (size_t)(256 * d.y + r); ent[k] = LIST[p]; w[k] = LWT[p]; } }
#pragma unroll
            for (int k = 0; k < NE; ++k) { const int e = tid + k * (NWAVES * 64), slot = e >> 8, r = e & 255; const i32x4 d = desc[slot]; rs[k] = (r < d.w) ? RSTD[ent[k] >> 1] : 0.f; }
#pragma unroll
            for (int k = 0; k < NE; ++k) { const int e = tid + k * (NWAVES * 64), slot = e >> 8, r = e & 255; const i32x4 d = desc[slot]; tidx[e] = ent[k]; twt[e] = w[k]; trs[e] = rs[k];
                if (d.z == 0 && r < d.w) SLOTOF[ent[k]] = (unsigned)(rstart[d.x] + 256 * d.y + r); } }
        __syncthreads();
    }
    if constexpr (PH(6)) _Pragma("unroll") for (int rep_ = 0; rep_ < NREP(6); ++rep_) {
        KP_PHASE(); PHASE_IDS(); unsigned char* const ws = KWS(); bf16* const XM = WSP(bf16, WS_K); bf16* const WE1 = WSP(bf16, WS_WE1); bf16* const ACT = WSP(bf16, WS_Q);
        pg8::MoeOrder S{XM, WE1, D, (size_t)1024 * D * 2, desc, rstart, tidx, true}; pg8::EpiSilu E{ACT, rstart, trs};
        pg8::gemm_phase<pg8::EpiSilu, pg8::MoeOrder, true, true>(L + RING_OFF, D, S, E);
    }
    xcd_barrier(bar);
    if constexpr (PH(7)) _Pragma("unroll") for (int rep_ = 0; rep_ < NREP(7); ++rep_) {
        KP_PHASE(); PHASE_IDS(); unsigned char* const ws = KWS(); bf16* const ACT = WSP(bf16, WS_Q); bf16* const WE2 = WSP(bf16, WS_WE2); bf16* const YB = WSP(bf16, WS_XN);
        pg8::MoeOrder S{ACT, WE2, DE, (size_t)1024 * DE * 2, desc, rstart, tidx, false}; pg8::EpiDown E{YB, rstart, twt, L + (wave < 4 ? TAB_IDX + wave * 2304 : TAB_RS + (wave - 4) * 2304)};
        pg8::gemm_phase<pg8::EpiDown, pg8::MoeOrder, true, false>(L + RING_OFF, DE, S, E);
    }
    xcd_barrier(bar);

    if constexpr (PH(8)) _Pragma("unroll") for (int rep_ = 0; rep_ < NREP(8); ++rep_) {
        KP_PHASE(); PHASE_IDS(); unsigned char* const ws = KWS(); float* const out = KOUT(); const float* const g_fin = KIN(15); const bf16* const YB = WSP(bf16, WS_XN); const bf16* const XM = WSP(bf16, WS_K); const unsigned* const SLOTOF = WSP(unsigned, WS_SLOTOF);
        f32x4 gv[4];
#pragma unroll
        for (int j = 0; j < 4; ++j) gv[j] = ((const GAS f32x4*)g_fin)[lane + 64 * j];
        u32x2 nx[4], na[4], nb[4]; unsigned ns0 = 0u, ns1 = 0u;
#define P8_SLOTS(mm) do { ns0 = (unsigned)__builtin_amdgcn_readfirstlane((int)SLOTOF[2 * (mm)]); ns1 = (unsigned)__builtin_amdgcn_readfirstlane((int)SLOTOF[2 * (mm) + 1]); } while (0)
#define P8_LOAD(mm) do { const GAS u32x2* xr_ = (const GAS u32x2*)(XM + (size_t)(mm) * D) + lane; const GAS u32x2* y0_ = (const GAS u32x2*)(YB + (size_t)ns0 * D) + lane; const GAS u32x2* y1_ = (const GAS u32x2*)(YB + (size_t)ns1 * D) + lane; \
            _Pragma("unroll") for (int j = 0; j < 4; ++j) { nx[j] = xr_[64 * j]; na[j] = y0_[64 * j]; nb[j] = y1_[64 * j]; } } while (0)
        if (gw < T) { P8_SLOTS(gw); P8_LOAD(gw); if (gw + NGW < T) P8_SLOTS(gw + NGW); }
        for (int m = gw; m < T; m += NGW) {
            GAS f32x4* xw = (rep_ + 1 < NREP(8)) ? (GAS f32x4*)(WSP(float, WS_Z) + (size_t)m * D) + lane : (GAS f32x4*)(out + (size_t)m * D) + lane;
            f32x4 v[4]; u32x2 ya[4], yb[4]; float s2 = 0.f;
#pragma unroll
            for (int j = 0; j < 4; ++j) { v[j] = (f32x4){pg8::bf_lo(nx[j].x), pg8::bf_hi(nx[j].x), pg8::bf_lo(nx[j].y), pg8::bf_hi(nx[j].y)}; ya[j] = na[j]; yb[j] = nb[j]; }
            if (m + NGW < T) { P8_LOAD(m + NGW); if (m + 2 * NGW < T) P8_SLOTS(m + 2 * NGW); }
#pragma unroll
            for (int j = 0; j < 4; ++j) { const u32x2 a = ya[j], b = yb[j];
                v[j].x += pg8::bf_lo(a.x) + pg8::bf_lo(b.x); v[j].y += pg8::bf_hi(a.x) + pg8::bf_hi(b.x); v[j].z += pg8::bf_lo(a.y) + pg8::bf_lo(b.y); v[j].w += pg8::bf_hi(a.y) + pg8::bf_hi(b.y);
                s2 += dot4(v[j], v[j]); }
            const float rstd = 1.0f / sqrtf(wave_total(s2) * (1.f / D) + RMS_EPS);
#pragma unroll
            for (int j = 0; j < 4; ++j) xw[64 * j] = (v[j] * rstd) * gv[j];
        }
    }
}

extern "C" void kernel_launch(void* const* d_in, const int* in_sizes, int n_in, void* d_out, int out_size, void* d_ws, size_t ws_size, hipStream_t stream) {
    static int grid = 0;
    if (grid == 0) {
        if (n_in != 16 || in_sizes[0] != T * D || out_size != T * D || ws_size < WS_END) { fprintf(stderr, "kernel_launch: built for 16 inputs, x/out of %d floats, >= %zu bytes of workspace; got n_in %d, in0 %d, out %d, ws %zu; nothing launched\n", T * D, (size_t)WS_END, n_in, n_in > 0 ? in_sizes[0] : -1, out_size, ws_size); grid = -1; return; }
        int dev = 0, cus = 0, per_cu = 0;
        if (hipGetDevice(&dev) != hipSuccess || hipDeviceGetAttribute(&cus, hipDeviceAttributeMultiprocessorCount, dev) != hipSuccess) { fprintf(stderr, "kernel_launch: hipGetDevice / hipDeviceGetAttribute failed; nothing launched\n"); grid = -1; return; }
        if (hipFuncSetAttribute((const void*)fox_moe_fwd, hipFuncAttributeMaxDynamicSharedMemorySize, LDS_BYTES) != hipSuccess) { fprintf(stderr, "kernel_launch: hipFuncSetAttribute(%d B LDS) failed; nothing launched\n", LDS_BYTES); grid = -1; return; }
        if (hipOccupancyMaxActiveBlocksPerMultiprocessor(&per_cu, (const void*)fox_moe_fwd, NWAVES * 64, LDS_BYTES) != hipSuccess || per_cu < 1)
            fprintf(stderr, "kernel_launch: note: the occupancy query reports %d workgroups per CU\n", per_cu);
        (void)hipGetLastError();
        grid = cus;
        if (grid != T / 256) { fprintf(stderr, "kernel_launch: %d CUs, but this kernel deals one 256-row panel per workgroup and needs exactly %d resident workgroups; nothing launched\n", cus, T / 256); grid = -1; return; }
        if (grid % 8 != 0 || grid < 8) { fprintf(stderr, "kernel_launch: %d CUs: this kernel wants a multiple of 8\n", grid); grid = (grid / 8) * 8; if (grid == 0) { grid = -1; return; } }
    }
    if (grid < 0) return;
    if (hipMemsetAsync((char*)d_ws + WS_CTL, 0, CTL_ZERO_BYTES, stream) != hipSuccess) { fprintf(stderr, "kernel_launch: hipMemsetAsync of the control words failed; nothing launched\n"); return; }
    Args a{};
    for (int i = 0; i < 16; ++i) a.in[i] = (const float*)d_in[i];
    a.out = (float*)d_out; a.ws = (unsigned char*)d_ws;
    hipLaunchKernelGGL(fox_moe_fwd, dim3(grid), dim3(NWAVES * 64), LDS_BYTES, stream, a);
    const hipError_t le = hipPeekAtLastError();
    if (le != hipSuccess) fprintf(stderr, "kernel_launch: launch failed: %s (grid %d x %d threads, %d B LDS)\n", hipGetErrorName(le), grid, NWAVES * 64, LDS_BYTES);
}
```
